# Optimizing an MI355X kernel written in HIP

```python
import jax, jax.numpy as jnp
from jax import lax
import numpy as np

D_MODEL = 2048
BATCH = 2
SEQ = 8192
DEPTH = 1

MLA_HEADS = 16
Q_LORA = 512
KV_LORA = 512
QK_NOPE = 128
QK_ROPE = 64
V_HEAD = 128
QK_HEAD = QK_NOPE + QK_ROPE
ROPE_THETA = 10000.0
Q_BLOCK = 128
SGU_WIDTH = D_MODEL
SGU_GROUPS = 8
SGU_GROUP_DIM = SGU_WIDTH // SGU_GROUPS
CHUNK = 128
PEER_HEADS = 8
N_KEYS = 128
N_EXPERTS = N_KEYS * N_KEYS
PEER_TOPK = 16
KEY_DIM = 128
TOKEN_BLOCK = 128
EPS = 1e-6

OFF_CQ = Q_LORA
OFF_CKV = OFF_CQ + KV_LORA
OFF_KPE = OFF_CKV + QK_ROPE
OFF_SGU = OFF_KPE + 2 * SGU_WIDTH
IN_COLS = OFF_SGU + 2 * D_MODEL

kernel_name = "hybrid_mla_sgu_peer_block"


def rmsnorm(x, g):
    xf = x.astype(jnp.float32)
    r = lax.rsqrt(jnp.mean(xf * xf, axis=-1, keepdims=True) + EPS)
    return (xf * r).astype(x.dtype) * g


def layernorm(x, g, b):
    xf = x.astype(jnp.float32)
    mu = jnp.mean(xf, axis=-1, keepdims=True)
    var = jnp.mean(jnp.square(xf - mu), axis=-1, keepdims=True)
    return ((xf - mu) * lax.rsqrt(var + EPS)).astype(x.dtype) * g + b


def rope(x, positions):
    d = x.shape[-1]
    freqs = ROPE_THETA ** (-jnp.arange(0, d, 2, dtype=jnp.float32) / d)
    ang = positions.astype(jnp.float32)[..., None] * freqs
    cos = jnp.cos(ang)[:, :, None, :].astype(x.dtype)
    sin = jnp.sin(ang)[:, :, None, :].astype(x.dtype)
    x1, x2 = x[..., : d // 2], x[..., d // 2 :]
    return jnp.concatenate([x1 * cos - x2 * sin, x1 * sin + x2 * cos], axis=-1)


def causal_block_attention(q, k, v):
    B, S, H, Dq = q.shape
    Dv = v.shape[-1]
    nb = S // Q_BLOCK
    qb = q.reshape(B, nb, Q_BLOCK, H, Dq).transpose(1, 0, 2, 3, 4)
    key_pos = jnp.arange(S)
    scale = Dq ** -0.5

    def one_block(args):
        q_blk, blk = args
        s = jnp.einsum("bqhd,bkhd->bhqk", q_blk, k).astype(jnp.float32) * scale
        q_pos = blk * Q_BLOCK + jnp.arange(Q_BLOCK)
        mask = q_pos[:, None] >= key_pos[None, :]
        s = jnp.where(mask[None, None], s, -jnp.inf)
        p = jax.nn.softmax(s, axis=-1).astype(v.dtype)
        return jnp.einsum("bhqk,bkhd->bqhd", p, v)

    o = lax.map(one_block, (qb, jnp.arange(nb)))
    return o.transpose(1, 0, 2, 3, 4).reshape(B, S, H * Dv)


def mla_branch(c_q, c_kv, k_pe, positions, g_q_a, w_uq, g_kv_a, w_ukv):
    B, S, _ = c_q.shape
    q = jnp.einsum("bsr,rhd->bshd", rmsnorm(c_q, g_q_a), w_uq)
    q = jnp.concatenate([q[..., :QK_NOPE], rope(q[..., QK_NOPE:], positions)], axis=-1)
    kv = jnp.einsum("bsr,rhd->bshd", rmsnorm(c_kv, g_kv_a), w_ukv)
    k_nope, v = kv[..., :QK_NOPE], kv[..., QK_NOPE:]
    k_pe = rope(k_pe[:, :, None, :], positions)
    k = jnp.concatenate([k_nope, jnp.broadcast_to(k_pe, (B, S, MLA_HEADS, QK_ROPE))], axis=-1)
    return causal_block_attention(q, k, v)


def sgu_branch(z, ln_g, ln_b, w_spatial, b_spatial):
    z = jax.nn.gelu(z)
    u, v = z[..., :SGU_WIDTH], z[..., SGU_WIDTH:]
    v = layernorm(v, ln_g, ln_b)
    B, S, _ = v.shape
    vg = v.reshape(B, S // CHUNK, CHUNK, SGU_GROUPS, SGU_GROUP_DIM)
    w = w_spatial * jnp.tril(jnp.ones((CHUNK, CHUNK), dtype=w_spatial.dtype))[None]
    mixed = jnp.einsum("gts,bcsgd->bctgd", w, vg) + b_spatial.T[None, None, :, :, None]
    return u * mixed.reshape(B, S, SGU_WIDTH)


def peer_ffn(h, w_pq, peer_keys, peer_u, peer_v):
    B, S, D = h.shape
    q = jnp.einsum("bsd,dhk->bshk", h, w_pq).reshape(B, S, PEER_HEADS, 2, KEY_DIM)
    sub = jnp.einsum("bshpk,hpnk->bshpn", q, peer_keys).astype(jnp.float32)
    s, i = lax.top_k(sub, PEER_TOPK)
    cand = (s[..., 0, :, None] + s[..., 1, None, :]).reshape(B, S, PEER_HEADS, PEER_TOPK * PEER_TOPK)
    cidx = (i[..., 0, :, None] * N_KEYS + i[..., 1, None, :]).reshape(B, S, PEER_HEADS, PEER_TOPK * PEER_TOPK)
    top_s, pos = lax.top_k(cand, PEER_TOPK)
    idx = jnp.take_along_axis(cidx, pos, axis=-1)
    gate = jax.nn.softmax(top_s, axis=-1).astype(h.dtype)
    nt = (B * S) // TOKEN_BLOCK
    hb = h.reshape(nt, TOKEN_BLOCK, D)
    ib = idx.reshape(nt, TOKEN_BLOCK, PEER_HEADS, PEER_TOPK)
    gb = gate.reshape(nt, TOKEN_BLOCK, PEER_HEADS, PEER_TOPK)

    def one_block(args):
        x_blk, i_blk, g_blk = args
        u = jnp.take(peer_u, i_blk, axis=0)
        a = jax.nn.gelu(jnp.einsum("td,thkd->thk", x_blk, u)) * g_blk
        v = jnp.take(peer_v, i_blk, axis=0)
        return jnp.einsum("thk,thkd->td", a, v)

    return lax.map(one_block, (hb, ib, gb)).reshape(B, S, D)


def setup_inputs(seed: int = 0) -> dict:
    key = jax.random.key(seed)
    ks = jax.random.split(key, 24)
    f32 = jnp.float32
    nrm = lambda k, shape, scale: jax.random.normal(k, shape, f32) * scale
    gain = lambda k, shape: 1.0 + 0.05 * jax.random.normal(k, shape, f32)
    L = DEPTH
    x = jax.random.normal(ks[0], (BATCH, SEQ, D_MODEL), f32)
    offsets = jax.random.randint(ks[1], (BATCH, 1), 0, 4096, dtype=jnp.int32)
    positions = offsets + jnp.arange(SEQ, dtype=jnp.int32)[None, :]
    return {
        "x": x,
        "positions": positions,
        "g_norm1": gain(ks[2], (L, D_MODEL)),
        "w_in": nrm(ks[3], (L, D_MODEL, IN_COLS), D_MODEL ** -0.5),
        "g_q_a": gain(ks[4], (L, Q_LORA)),
        "w_uq": nrm(ks[5], (L, Q_LORA, MLA_HEADS, QK_HEAD), Q_LORA ** -0.5),
        "g_kv_a": gain(ks[6], (L, KV_LORA)),
        "w_ukv": nrm(ks[7], (L, KV_LORA, MLA_HEADS, QK_NOPE + V_HEAD), KV_LORA ** -0.5),
        "sgu_ln_g": gain(ks[8], (L, SGU_WIDTH)),
        "sgu_ln_b": nrm(ks[9], (L, SGU_WIDTH), 0.02),
        "w_spatial": nrm(ks[10], (L, SGU_GROUPS, CHUNK, CHUNK), CHUNK ** -0.5),
        "b_spatial": gain(ks[11], (L, SGU_GROUPS, CHUNK)),
        "b_gate": nrm(ks[12], (L, 2 * D_MODEL), 0.01),
        "w_out": nrm(ks[13], (L, D_MODEL, D_MODEL), D_MODEL ** -0.5),
        "g_norm2": gain(ks[14], (L, D_MODEL)),
        "w_peer_q": nrm(ks[15], (L, D_MODEL, PEER_HEADS, 2 * KEY_DIM), D_MODEL ** -0.5),
        "peer_keys": nrm(ks[16], (L, PEER_HEADS, 2, N_KEYS, KEY_DIM), KEY_DIM ** -0.5),
        "peer_u": nrm(ks[17], (L, N_EXPERTS, D_MODEL), D_MODEL ** -0.5),
        "peer_v": nrm(ks[18], (L, N_EXPERTS, D_MODEL), PEER_HEADS ** -0.5),
        "g_final": gain(ks[19], (D_MODEL,)),
    }


def reference(x, positions, g_norm1, w_in, g_q_a, w_uq, g_kv_a, w_ukv, sgu_ln_g, sgu_ln_b,
              w_spatial, b_spatial, b_gate, w_out, g_norm2, w_peer_q, peer_keys, peer_u,
              peer_v, g_final):
    for l in range(DEPTH):
        h = rmsnorm(x, g_norm1[l])
        proj = h @ w_in[l]
        c_q = proj[..., :OFF_CQ]
        c_kv = proj[..., OFF_CQ:OFF_CKV]
        k_pe = proj[..., OFF_CKV:OFF_KPE]
        z_sgu = proj[..., OFF_KPE:OFF_SGU]
        gates = jax.nn.sigmoid(proj[..., OFF_SGU:] + b_gate[l])
        o_a = mla_branch(c_q, c_kv, k_pe, positions, g_q_a[l], w_uq[l], g_kv_a[l], w_ukv[l])
        o_b = sgu_branch(z_sgu, sgu_ln_g[l], sgu_ln_b[l], w_spatial[l], b_spatial[l])
        merged = gates[..., :D_MODEL] * o_a + gates[..., D_MODEL:] * o_b
        x = x + merged @ w_out[l]
        h2 = rmsnorm(x, g_norm2[l])
        x = x + peer_ffn(h2, w_peer_q[l], peer_keys[l], peer_u[l], peer_v[l])
    return rmsnorm(x, g_final)
```

```cpp
#include <hip/hip_runtime.h>
#include <hip/hip_bf16.h>
#include <cstdio>
#include <cstdint>


constexpr int D_MODEL = 2048, NB = 2, SEQL = 8192, MTOK = NB * SEQL;
constexpr int NHEAD = 16, QL = 512, DN = 128, DR = 64, DVH = 128, DQK = 192;
constexpr int IN_COLS = 9280, IN16_ROWS = 2048, IN8_ROWS = 9472;
constexpr float Q8_SCALE = 64.f, K8_SCALE = 8.f, V8_SCALE = 8.f;
constexpr float XN8_SCALE = 8.f, WIN8_SCALE = 64.f, IN8_DESCALE = 1.f / 512.f;
constexpr int NQ_COLS = NHEAD * DQK, NKV_COLS = NHEAD * (DN + DVH);
constexpr int PHEADS = 8, NKEYS = 128, TOPK = 16, KD = 128, NEXP = 16384;
constexpr float EPS = 1e-6f;
constexpr float FXS = 16777216.f, FXI = 1.f / 16777216.f;
constexpr float C2Q = 0.07216878364870322f * 1.4426950408889634f;

constexpr size_t MiB = 1u << 20;
constexpr size_t WS_CTL = 0, CTL_ZERO_BYTES = 32 * 1024;
constexpr size_t WS_KEYS = 1 * MiB, WS_WSP = 1 * MiB + 512 * 1024;
constexpr size_t WS_WUQ = 2 * MiB, WS_WUKV = 5 * MiB, WS_WOUT = 9 * MiB, WS_WPQ = 17 * MiB;
constexpr size_t WS_ROPE = 27 * MiB;
constexpr size_t WS_WIN8 = 46 * MiB;
constexpr size_t WS_XN8 = 66 * MiB;
constexpr size_t WS_Q = 32 * MiB;
constexpr size_t WS_CQKV = 128 * MiB;
constexpr size_t WS_U = 160 * MiB;
constexpr size_t WS_VG = 224 * MiB;
constexpr size_t WS_GA = 288 * MiB;
constexpr size_t WS_V = 352 * MiB;
constexpr size_t WS_K = 416 * MiB;
constexpr size_t WS_KR = 504 * MiB;
constexpr size_t WS_X2 = 288 * MiB;
constexpr size_t WS_X1B = 96 * MiB;
constexpr size_t WS_PU = 32 * MiB, WS_PV = 64 * MiB;
constexpr size_t WS_PART = 288 * MiB;
constexpr size_t WS_PSC = 31 * MiB;
constexpr size_t WS_QP = 224 * MiB;
constexpr size_t WS_TOPI = 480 * MiB, WS_TOPG = 488 * MiB;
constexpr size_t WS_END = 512 * MiB;
constexpr int CW_BAR = 4096;
constexpr size_t CTL_STATS = 128 * 1024;
constexpr int RING_OFF = 0, RING_BYTES = 131072;
constexpr int LDSCTL_OFF = RING_BYTES, MISC_OFF = LDSCTL_OFF + 320;
constexpr int LDS_BYTES = 147456;

#define GAS __attribute__((address_space(1)))
#define LAS __attribute__((address_space(3)))
typedef unsigned short bf16;
typedef unsigned v4u __attribute__((ext_vector_type(4)));
typedef unsigned v2u __attribute__((ext_vector_type(2)));
typedef float f32x4 __attribute__((ext_vector_type(4)));
typedef float f32x16 __attribute__((ext_vector_type(16)));
typedef short bf16x8 __attribute__((ext_vector_type(8)));
typedef short s16x4 __attribute__((ext_vector_type(4)));
typedef int v8i __attribute__((ext_vector_type(8)));
typedef unsigned long long u64;
#define LDS_WAIT() asm volatile("s_waitcnt lgkmcnt(0)" ::: "memory")
#define VM_WAIT() asm volatile("s_waitcnt vmcnt(0)" ::: "memory")
#define SBAR() __builtin_amdgcn_sched_barrier(0)

typedef float f32x2_t __attribute__((ext_vector_type(2))); typedef __bf16 bf16x2_t __attribute__((ext_vector_type(2)));
__device__ __forceinline__ unsigned cvt_pk_bf16(float lo, float hi) { f32x2_t v = {lo, hi}; bf16x2_t b = __builtin_convertvector(v, bf16x2_t); return __builtin_bit_cast(unsigned, b); }
__device__ __forceinline__ unsigned pack_fp8x4(f32x4 v) {
    v = __builtin_elementwise_min(__builtin_elementwise_max(v, (f32x4){-448.f, -448.f, -448.f, -448.f}), (f32x4){448.f, 448.f, 448.f, 448.f});
    int p = 0; p = __builtin_amdgcn_cvt_pk_fp8_f32(v[0], v[1], p, false); p = __builtin_amdgcn_cvt_pk_fp8_f32(v[2], v[3], p, true); return (unsigned)p; }
__device__ __forceinline__ float bf_lo(unsigned w) { return __uint_as_float(w << 16); }
__device__ __forceinline__ float bf_hi(unsigned w) { return __uint_as_float(w & 0xffff0000u); }
__device__ __forceinline__ float gelu_t(float x) { const float t = x * (1.f + 0.044715f * x * x); const float e = __builtin_amdgcn_exp2f(-2.3022081986f * t); return x * __builtin_amdgcn_rcpf(1.f + e); }
__device__ __forceinline__ float sigmoid_f(float y) { return __builtin_amdgcn_rcpf(1.f + __builtin_amdgcn_exp2f(-1.4426950409f * y)); }
__device__ __forceinline__ void fx_add(u64* p, float v) { const long long q = __float2ll_rn(v * FXS); atomicAdd(p, (u64)q); }
__device__ __forceinline__ float fx_get(const u64* p) { return (float)((double)(long long)(*p) * (double)FXI); }
__device__ __forceinline__ int lane_id() { int l; asm volatile("v_mbcnt_lo_u32_b32 %0, -1, 0\n\tv_mbcnt_hi_u32_b32 %0, -1, %0" : "=v"(l)); return l; }

__device__ __forceinline__ float shx(float v, int o, int lane) { return __builtin_bit_cast(float, __builtin_amdgcn_ds_bpermute((lane ^ o) << 2, __builtin_bit_cast(int, v))); }
__device__ __forceinline__ float wave_sum(float v, int lane) {
#pragma unroll
    for (int o = 1; o < 64; o <<= 1) v += shx(v, o, lane);
    return v;
}

namespace pg8 {
#define PG8_LAS __attribute__((address_space(3)))
typedef unsigned short bf16_t;
constexpr int BM = 256, BK = 64, HALF = 128, HTB = HALF * BK * 2, STAGE_BYTES = 8 * HTB, NXCD = 8, WGM = 8;
__host__ __device__ __forceinline__ int lds_byte(int r, int c) { const int st = (r >> 4) * 2 + (c >> 5), rr = r & 15, cc = c & 31, ob = rr * 64 + cc * 2; return st * 1024 + (ob ^ (((ob >> 9) & 1) << 5)); }
__host__ __device__ __forceinline__ void stage_rc(int b, int& R, int& C) { const int st = b / 1024, sb = b % 1024, swz = sb ^ (((sb >> 9) & 1) << 5); R = (st >> 1) * 16 + swz / 64; C = (st & 1) * 32 + (swz % 64) / 2; }
__host__ __device__ __forceinline__ int perm32(int rho) { const int n = rho >> 4, i = rho & 15; return 8 * (i >> 2) + 4 * n + (i & 3); }
struct Unit { int pm, pn; };
struct Gemm { const bf16_t* A; const bf16_t* Bt; int M, N, K, lda; };
struct StaticOrder {
    int nM, nN, nwg, G, c;
    __host__ __device__ void init(int M, int N, int G_, int c_) { nM = M / BM; nN = N / BM; nwg = nM * nN; G = G_; c = c_; }
    __host__ __device__ bool next(int i, Unit& u) const {
        const long L = (long)i * G + c; if (L >= nwg) return false;
        int wgid = (int)L; { const int q = nwg / NXCD, r = nwg % NXCD, xcd = wgid % NXCD, off = wgid / NXCD; wgid = (xcd < r ? xcd * (q + 1) : r * (q + 1) + (xcd - r) * q) + off; }
        const int nig = WGM * nN, gid = wgid / nig, fm = gid * WGM, gsz = (nM - fm) < WGM ? (nM - fm) : WGM;
        u.pm = fm + ((wgid % nig) % gsz); u.pn = (wgid % nig) / gsz; return true;
    }
};
template <class Epi, class Sched, bool ALIGN_EPI = false, bool SP2 = false, bool F8 = false, bool SWAP1 = false>
__device__ __forceinline__ void gemm_phase(PG8_LAS unsigned char* lds, const Gemm g, const Sched& S, const Epi& E, const int wave) {
    int tid = wave * 64 + lane_id(); asm volatile("" : "+v"(tid));
    const int wid = __builtin_amdgcn_readfirstlane(tid >> 6), lane = tid & 63, wr = wid >> 2, wc = wid & 3, fr = lane & 15, fq = lane >> 4;
    const int K = g.K, nt = K / BK, lda = g.lda;
    unsigned voffA[2], voffB[2];
#pragma unroll
    for (int i = 0; i < 2; ++i) { int R, C; stage_rc(tid * 16 + i * 8192, R, C); const int Rb = Epi::PERM ? ((R & ~31) + perm32(R & 31)) : R;
        voffA[i] = (unsigned)(R * lda + C) * 2u; voffB[i] = (unsigned)(Rb * K + C) * 2u; }
    const size_t kstep = (size_t)(BK * 2);
    const size_t hstepA = (size_t)HALF * lda * 2, hstepB = (size_t)HALF * K * 2;
    const size_t tstepA = 2 * hstepA, tstepB = 2 * hstepB;
    const unsigned ldsw = (unsigned)wid * 1024u;
    const int aoff = lds_byte(wr * 64 + fr, fq * 8), boff = lds_byte(wc * 32 + fr, fq * 8);
#define PG8_SA(b, h) (((b) * 2 + (h)) * HTB)
#define PG8_SB(b, h) ((4 + (b) * 2 + (h)) * HTB)
#define PG8_STAGE(bufoff, gbase, voff) do { _Pragma("unroll") for (int _i = 0; _i < 2; ++_i) \
        { unsigned vo_ = (voff)[_i]; asm volatile("" : "+v"(vo_)); __builtin_amdgcn_global_load_lds((const unsigned*)((const char*)(gbase) + vo_), (PG8_LAS unsigned*)(lds + (bufoff) + ldsw + _i * 8192), 16, 0, 0); } } while (0)
#define PG8_LDA(dst, b, h) do { _Pragma("unroll") for (int m = 0; m < 4; ++m) _Pragma("unroll") for (int k = 0; k < 2; ++k) dst[m][k] = *(const PG8_LAS bf16x8*)(lds + PG8_SA(b, h) + aoff + m * 2048 + k * 1024); } while (0)
#define PG8_LDB(dst, b, h) do { _Pragma("unroll") for (int n = 0; n < 2; ++n) _Pragma("unroll") for (int k = 0; k < 2; ++k) dst[n][k] = *(const PG8_LAS bf16x8*)(lds + PG8_SB(b, h) + boff + n * 2048 + k * 1024); } while (0)
#define PG8_CAT(x) __builtin_bit_cast(v8i, __builtin_shufflevector((x)[0], (x)[1], 0, 1, 2, 3, 4, 5, 6, 7, 8, 9, 10, 11, 12, 13, 14, 15))
#define PG8_MMA(ai, bj, At, Bt) do { __builtin_amdgcn_s_setprio(1); _Pragma("unroll") for (int m = 0; m < 4; ++m) _Pragma("unroll") for (int n = 0; n < 2; ++n) { \
        if constexpr (F8 && SWAP1 && (bj) == 1) acc[ai][bj][m][n] = __builtin_amdgcn_mfma_scale_f32_16x16x128_f8f6f4(PG8_CAT(At[m]), PG8_CAT(Bt[n]), acc[ai][bj][m][n], 0, 0, 0, 0x7f7f7f7f, 0, 0x7f7f7f7f); \
        else if constexpr (F8) acc[ai][bj][m][n] = __builtin_amdgcn_mfma_scale_f32_16x16x128_f8f6f4(PG8_CAT(Bt[n]), PG8_CAT(At[m]), acc[ai][bj][m][n], 0, 0, 0, 0x7f7f7f7f, 0, 0x7f7f7f7f); \
        else { _Pragma("unroll") for (int k = 0; k < 2; ++k) acc[ai][bj][m][n] = __builtin_amdgcn_mfma_f32_16x16x32_bf16(Bt[n][k], At[m][k], acc[ai][bj][m][n], 0, 0, 0); } } __builtin_amdgcn_s_setprio(0); } while (0)
#define PG8_WAIT_V(n) asm volatile("s_waitcnt vmcnt(" #n ")" ::: "memory")
#define PG8_WAIT_L(n) asm volatile("s_waitcnt lgkmcnt(" #n ")" ::: "memory")
#define PG8_BAR __builtin_amdgcn_s_barrier()
#define PG8_SCHED __builtin_amdgcn_sched_barrier(0)
    Unit cur, nxt; int ui = 0;
    if (!S.next(0, cur)) return;
    f32x4 acc[2][2][4][2];
#pragma unroll
    for (int a = 0; a < 2; ++a)
#pragma unroll
        for (int b = 0; b < 2; ++b)
#pragma unroll
            for (int m = 0; m < 4; ++m)
#pragma unroll
                for (int n = 0; n < 2; ++n) acc[a][b][m][n] = (f32x4){0.f, 0.f, 0.f, 0.f};
    bf16x8 At[4][2], B0[2][2], B1[2][2];
    const char* cA = (const char*)g.A + (size_t)cur.pm * tstepA; const char* cB = (const char*)g.Bt + (size_t)cur.pn * tstepB;
    if constexpr (SP2) {
        PG8_STAGE(PG8_SB(0, 0), cB, voffB); PG8_STAGE(PG8_SB(0, 1), cB + hstepB, voffB); PG8_STAGE(PG8_SA(0, 0), cA, voffA); PG8_STAGE(PG8_SA(0, 1), cA + hstepA, voffA);
        if (wr == 1) PG8_BAR;
        PG8_WAIT_V(2); PG8_BAR;
        PG8_STAGE(PG8_SB(1, 0), cB + kstep, voffB); PG8_STAGE(PG8_SA(1, 0), cA + kstep, voffA); PG8_STAGE(PG8_SB(1, 1), cB + hstepB + kstep, voffB);
        PG8_WAIT_V(6); PG8_BAR;
    } else {
        PG8_STAGE(PG8_SB(0, 0), cB, voffB); PG8_STAGE(PG8_SA(0, 0), cA, voffA); PG8_STAGE(PG8_SB(0, 1), cB + hstepB, voffB); PG8_STAGE(PG8_SA(0, 1), cA + hstepA, voffA);
        if (wr == 1) PG8_BAR;
        PG8_WAIT_V(4); PG8_BAR;
        PG8_STAGE(PG8_SB(1, 0), cB + kstep, voffB); PG8_STAGE(PG8_SA(1, 0), cA + kstep, voffA); PG8_STAGE(PG8_SB(1, 1), cB + hstepB + kstep, voffB);
        PG8_WAIT_V(6); PG8_BAR;
    }
    for (;;) {
        const bool has_next = S.next(ui + 1, nxt);
        const char* nA = has_next ? (const char*)g.A + (size_t)nxt.pm * tstepA : cA; const char* nB = has_next ? (const char*)g.Bt + (size_t)nxt.pn * tstepB : cB;
#pragma unroll 1
        for (int t = 0; t < nt; t += 2) {
            const bool last = (t == nt - 2);
            const char* a1 = cA + (size_t)(t + 1) * kstep;
            const char* a2 = last ? nA : cA + (size_t)(t + 2) * kstep; const char* b2 = last ? nB : cB + (size_t)(t + 2) * kstep;
            const char* a3 = a2 + kstep; const char* b3 = b2 + kstep;
            if constexpr (SP2) {
            PG8_LDB(B0, 0, 0); PG8_LDB(B1, 0, 1); PG8_SCHED; PG8_LDA(At, 0, 0); PG8_STAGE(PG8_SA(1, 1), a1 + hstepA, voffA);
            PG8_WAIT_V(8); PG8_WAIT_L(0); PG8_BAR; PG8_MMA(0, 0, At, B0); PG8_MMA(0, 1, At, B1); PG8_BAR; PG8_SCHED;
            PG8_LDA(At, 0, 1); PG8_STAGE(PG8_SB(0, 0), b2, voffB); PG8_STAGE(PG8_SB(0, 1), b2 + hstepB, voffB); PG8_STAGE(PG8_SA(0, 0), a2, voffA);
            PG8_WAIT_V(8); PG8_WAIT_L(0); PG8_BAR; PG8_MMA(1, 0, At, B0); PG8_MMA(1, 1, At, B1); PG8_BAR; PG8_SCHED;
            PG8_LDB(B0, 1, 0); PG8_LDB(B1, 1, 1); PG8_SCHED; PG8_LDA(At, 1, 0); PG8_STAGE(PG8_SA(0, 1), a2 + hstepA, voffA);
            PG8_WAIT_V(8); PG8_WAIT_L(0); PG8_BAR; PG8_MMA(0, 0, At, B0); PG8_MMA(0, 1, At, B1); PG8_BAR; PG8_SCHED;
            PG8_LDA(At, 1, 1); PG8_STAGE(PG8_SB(1, 0), b3, voffB); PG8_STAGE(PG8_SB(1, 1), b3 + hstepB, voffB); PG8_STAGE(PG8_SA(1, 0), a3, voffA);
            PG8_WAIT_V(8); PG8_WAIT_L(0); PG8_BAR; PG8_MMA(1, 0, At, B0); PG8_MMA(1, 1, At, B1); PG8_BAR; PG8_SCHED;
            } else {
            PG8_LDB(B0, 0, 0); PG8_SCHED; PG8_LDA(At, 0, 0); PG8_STAGE(PG8_SA(1, 1), a1 + hstepA, voffA);
            PG8_WAIT_L(8); PG8_BAR; PG8_WAIT_L(0); PG8_MMA(0, 0, At, B0); PG8_BAR; PG8_SCHED;
            PG8_LDB(B1, 0, 1); PG8_STAGE(PG8_SB(0, 0), b2, voffB);
            PG8_BAR; PG8_WAIT_L(0); PG8_MMA(0, 1, At, B1); PG8_BAR;
            PG8_LDA(At, 0, 1); PG8_STAGE(PG8_SA(0, 0), a2, voffA);
            PG8_BAR; PG8_WAIT_L(0); PG8_MMA(1, 0, At, B0); PG8_BAR; PG8_SCHED;
            PG8_STAGE(PG8_SB(0, 1), b2 + hstepB, voffB);
            PG8_WAIT_V(6); PG8_BAR; PG8_MMA(1, 1, At, B1); PG8_BAR;
            PG8_LDB(B0, 1, 0); PG8_SCHED; PG8_LDA(At, 1, 0); PG8_STAGE(PG8_SA(0, 1), a2 + hstepA, voffA);
            PG8_WAIT_L(8); PG8_BAR; PG8_WAIT_L(0); PG8_MMA(0, 0, At, B0); PG8_BAR; PG8_SCHED;
            PG8_LDB(B1, 1, 1); PG8_STAGE(PG8_SB(1, 0), b3, voffB);
            PG8_BAR; PG8_WAIT_L(0); PG8_MMA(0, 1, At, B1); PG8_BAR;
            PG8_LDA(At, 1, 1); PG8_STAGE(PG8_SA(1, 0), a3, voffA);
            PG8_BAR; PG8_WAIT_L(0); PG8_MMA(1, 0, At, B0); PG8_BAR; PG8_SCHED;
            PG8_STAGE(PG8_SB(1, 1), b3 + hstepB, voffB);
            PG8_WAIT_V(6); PG8_BAR; PG8_MMA(1, 1, At, B1); PG8_BAR;
            }
        }
        if constexpr (ALIGN_EPI) { if (wr == 0) PG8_BAR; }
        { const int le = lane_id(); E(acc, cur, wr, wc, le & 15, le >> 4); }
        if (!has_next) break;
#pragma unroll
        for (int a = 0; a < 2; ++a)
#pragma unroll
            for (int b = 0; b < 2; ++b)
#pragma unroll
                for (int m = 0; m < 4; ++m)
#pragma unroll
                    for (int n = 0; n < 2; ++n) acc[a][b][m][n] = (f32x4){0.f, 0.f, 0.f, 0.f};
        cur = nxt; cA = nA; cB = nB; ++ui;
        if constexpr (ALIGN_EPI) { if (wr == 1) PG8_BAR; }
    }
    PG8_WAIT_V(0);
    if constexpr (!ALIGN_EPI) { if (wr == 0) PG8_BAR; }
    PG8_BAR;
#undef PG8_SA
#undef PG8_SB
#undef PG8_STAGE
#undef PG8_LDA
#undef PG8_LDB
#undef PG8_MMA
#undef PG8_CAT
#undef PG8_WAIT_V
#undef PG8_WAIT_L
#undef PG8_BAR
#undef PG8_SCHED
}

#define EPI_ROWS(ai, m) (u.pm * BM + wr * 64 + fr + (ai) * HALF + (m) * 16)
struct EpiIn {
    static constexpr bool PERM = true;
    int mode; float sc;
    bf16_t *U, *GA, *VG; unsigned char *CQKV, *KR; const float* bgate; const float* rope; u64 *sqq, *sqkv, *ssum, *ssq;
    __device__ __forceinline__ void operator()(const f32x4 (&acc)[2][2][4][2], const Unit& u, int wr, int wc, int fr, int fq) const {
        const int pn = u.pn, cw = wc * 32 + 8 * fq;
        if (mode == 1 || pn >= 29) {
            const int c0 = (mode == 1 ? pn : pn - 29) * 256 + cw;
#pragma unroll
            for (int ai = 0; ai < 2; ++ai)
#pragma unroll
                for (int m = 0; m < 4; ++m) { const int row = EPI_ROWS(ai, m); float s = 0.f, q = 0.f;
#pragma unroll
                    for (int bj = 0; bj < 2; ++bj) { f32x4 v0 = acc[ai][bj][m][0] * sc, v1 = acc[ai][bj][m][1] * sc;
#pragma unroll
                        for (int e = 0; e < 4; ++e) { v0[e] = gelu_t(v0[e]); v1[e] = gelu_t(v1[e]); }
                        s += (v0[0] + v0[1]) + (v0[2] + v0[3]) + (v1[0] + v1[1]) + (v1[2] + v1[3]);
                        q += (v0[0] * v0[0] + v0[1] * v0[1]) + (v0[2] * v0[2] + v0[3] * v0[3]) + (v1[0] * v1[0] + v1[1] * v1[1]) + (v1[2] * v1[2] + v1[3] * v1[3]);
                        v4u w; w.x = cvt_pk_bf16(v0[0], v0[1]); w.y = cvt_pk_bf16(v0[2], v0[3]); w.z = cvt_pk_bf16(v1[0], v1[1]); w.w = cvt_pk_bf16(v1[2], v1[3]);
                        __builtin_nontemporal_store(w, (v4u*)(VG + (size_t)row * 2048 + c0 + bj * HALF)); }
                    s += shx(s, 16, fq * 16 + fr); s += shx(s, 32, fq * 16 + fr); q += shx(q, 16, fq * 16 + fr); q += shx(q, 32, fq * 16 + fr);
                    if (fq == 0) { fx_add(ssum + row, s); fx_add(ssq + row, q); } }
        } else if (pn < 16) {
            const int c0 = pn * 128 + cw; const float* bg = bgate + 2048 + c0;
            const f32x4 b0 = *(const f32x4*)bg, b1 = *(const f32x4*)(bg + 4);
#pragma unroll
            for (int ai = 0; ai < 2; ++ai)
#pragma unroll
                for (int m = 0; m < 4; ++m) { const int row = EPI_ROWS(ai, m);
                    f32x4 v0 = acc[ai][0][m][0] * sc, v1 = acc[ai][0][m][1] * sc; const f32x4 g0 = acc[ai][1][m][0] * sc + b0, g1 = acc[ai][1][m][1] * sc + b1;
#pragma unroll
                    for (int e = 0; e < 4; ++e) { v0[e] = gelu_t(v0[e]) * sigmoid_f(g0[e]); v1[e] = gelu_t(v1[e]) * sigmoid_f(g1[e]); }
                    v4u w; w.x = cvt_pk_bf16(v0[0], v0[1]); w.y = cvt_pk_bf16(v0[2], v0[3]); w.z = cvt_pk_bf16(v1[0], v1[1]); w.w = cvt_pk_bf16(v1[2], v1[3]);
                    __builtin_nontemporal_store(w, (v4u*)(U + (size_t)row * 2048 + c0)); }
        } else if (pn < 24) {
            const int c0 = (pn - 16) * 256 + cw; const float* bg = bgate + c0;
            f32x4 bv[2][2];
#pragma unroll
            for (int bj = 0; bj < 2; ++bj) { bv[bj][0] = *(const f32x4*)(bg + bj * HALF); bv[bj][1] = *(const f32x4*)(bg + bj * HALF + 4); }
#pragma unroll
            for (int ai = 0; ai < 2; ++ai)
#pragma unroll
                for (int m = 0; m < 4; ++m) { const int row = EPI_ROWS(ai, m);
#pragma unroll
                    for (int bj = 0; bj < 2; ++bj) { f32x4 v0 = acc[ai][bj][m][0] * sc + bv[bj][0], v1 = acc[ai][bj][m][1] * sc + bv[bj][1];
#pragma unroll
                        for (int e = 0; e < 4; ++e) { v0[e] = sigmoid_f(v0[e]); v1[e] = sigmoid_f(v1[e]); }
                        v4u w; w.x = cvt_pk_bf16(v0[0], v0[1]); w.y = cvt_pk_bf16(v0[2], v0[3]); w.z = cvt_pk_bf16(v1[0], v1[1]); w.w = cvt_pk_bf16(v1[2], v1[3]);
                        __builtin_nontemporal_store(w, (v4u*)(GA + (size_t)row * 2048 + c0 + bj * HALF)); } }
        } else if (pn < 28) {
            const int pc = pn - 24; u64* sq = pc < 2 ? sqq : sqkv;
#pragma unroll
            for (int ai = 0; ai < 2; ++ai)
#pragma unroll
                for (int m = 0; m < 4; ++m) { const int row = EPI_ROWS(ai, m); float s = 0.f;
#pragma unroll
                    for (int bj = 0; bj < 2; ++bj) { const f32x4 v0 = acc[ai][bj][m][0] * sc, v1 = acc[ai][bj][m][1] * sc;
                        s += (v0[0] * v0[0] + v0[1] * v0[1]) + (v0[2] * v0[2] + v0[3] * v0[3]) + (v1[0] * v1[0] + v1[1] * v1[1]) + (v1[2] * v1[2] + v1[3] * v1[3]);
                        v2u w; w.x = pack_fp8x4(v0 * XN8_SCALE); w.y = pack_fp8x4(v1 * XN8_SCALE);
                        *(v2u*)(CQKV + (size_t)row * 1024 + pc * 256 + bj * HALF + cw) = w; }
                    s += shx(s, 16, fq * 16 + fr); s += shx(s, 32, fq * 16 + fr);
                    if (fq == 0) fx_add(sq + row, s); }
        } else {
            if (wc < 2) {
                const int i0 = cw >> 1;
#pragma unroll
                for (int ai = 0; ai < 2; ++ai)
#pragma unroll
                    for (int m = 0; m < 4; ++m) { const int row = EPI_ROWS(ai, m);
                        const f32x4 c4 = *(const f32x4*)(rope + (size_t)row * 32 + i0), s4 = *(const f32x4*)(rope + (size_t)MTOK * 32 + (size_t)row * 32 + i0);
                        const f32x4 v0 = acc[ai][0][m][0] * sc, v1 = acc[ai][0][m][1] * sc;
                        const f32x4 r0 = {v0[0] * c4[0] - v0[1] * s4[0], v0[0] * s4[0] + v0[1] * c4[0], v0[2] * c4[1] - v0[3] * s4[1], v0[2] * s4[1] + v0[3] * c4[1]};
                        const f32x4 r1 = {v1[0] * c4[2] - v1[1] * s4[2], v1[0] * s4[2] + v1[1] * c4[2], v1[2] * c4[3] - v1[3] * s4[3], v1[2] * s4[3] + v1[3] * c4[3]};
                        v2u w; w.x = pack_fp8x4(r0 * K8_SCALE); w.y = pack_fp8x4(r1 * K8_SCALE);
                        *(v2u*)(KR + (size_t)row * DR + cw) = w; }
            }
        }
    }
};
struct EpiQ {
    static constexpr bool PERM = true;
    unsigned char* Q; const u64* sqq; const float* rope;
    __device__ __forceinline__ void operator()(const f32x4 (&acc)[2][2][4][2], const Unit& u, int wr, int wc, int fr, int fq) const {
        const int cw = wc * 32 + 8 * fq;
#pragma unroll
        for (int ai = 0; ai < 2; ++ai)
#pragma unroll
            for (int m = 0; m < 4; ++m) { const int row = EPI_ROWS(ai, m); const int b = row >> 13, s = row & 8191;
                const float rq = __builtin_amdgcn_rsqf(fx_get(sqq + row) * (1.f / QL) + EPS) * (C2Q * IN8_DESCALE * Q8_SCALE);
#pragma unroll
                for (int bj = 0; bj < 2; ++bj) { const int colg = u.pn * 256 + bj * HALF + cw; const int head = colg / DQK, dd = colg - head * DQK;
                    f32x4 v0 = acc[ai][bj][m][0] * rq, v1 = acc[ai][bj][m][1] * rq;
                    if (dd >= DN) { const int i0 = (dd - DN) >> 1;
                        const f32x4 c4 = *(const f32x4*)(rope + (size_t)row * 32 + i0), s4 = *(const f32x4*)(rope + (size_t)MTOK * 32 + (size_t)row * 32 + i0);
                        const f32x4 r0 = {v0[0] * c4[0] - v0[1] * s4[0], v0[0] * s4[0] + v0[1] * c4[0], v0[2] * c4[1] - v0[3] * s4[1], v0[2] * s4[1] + v0[3] * c4[1]};
                        const f32x4 r1 = {v1[0] * c4[2] - v1[1] * s4[2], v1[0] * s4[2] + v1[1] * c4[2], v1[2] * c4[3] - v1[3] * s4[3], v1[2] * s4[3] + v1[3] * c4[3]};
                        v0 = r0; v1 = r1; }
                    v2u w; w.x = pack_fp8x4(v0); w.y = pack_fp8x4(v1);
                    *(v2u*)(Q + ((size_t)(b * NHEAD + head) * SEQL + s) * DQK + dd) = w; } }
    }
};
struct EpiKV {
    static constexpr bool PERM = true;
    unsigned char* Kb; unsigned char* Vt; const u64* sqkv;
    __device__ __forceinline__ void operator()(const f32x4 (&acc)[2][2][4][2], const Unit& u, int wr, int wc, int fr, int fq) const {
        const int cw = wc * 32 + 8 * fq, head = u.pn;
#pragma unroll
        for (int ai = 0; ai < 2; ++ai)
#pragma unroll
            for (int m = 0; m < 4; ++m) {
                { const int row = EPI_ROWS(ai, m); const int b = row >> 13, s = row & 8191;
                  const float rk = __builtin_amdgcn_rsqf(fx_get(sqkv + row) * (1.f / QL) + EPS) * (IN8_DESCALE * K8_SCALE); const size_t tr = (size_t)(b * NHEAD + head) * SEQL + s;
                  v2u w; w.x = pack_fp8x4(acc[ai][0][m][0] * rk); w.y = pack_fp8x4(acc[ai][0][m][1] * rk); *(v2u*)(Kb + tr * DN + cw) = w; }
                { const int row0 = u.pm * BM + wr * 64 + ai * HALF + m * 16 + 4 * fq; const int b = row0 >> 13, s0 = row0 & 8191;
                  f32x4 rk4;
#pragma unroll
                  for (int e = 0; e < 4; ++e) rk4[e] = __builtin_amdgcn_rsqf(fx_get(sqkv + row0 + e) * (1.f / QL) + EPS) * (IN8_DESCALE * V8_SCALE);
                  const int slot = (s0 & ~63) + 32 * (fq & 1) + 4 * (2 * m + (fq >> 1));
#pragma unroll
                  for (int n = 0; n < 2; ++n) { const int dv = wc * 32 + 8 * (fr >> 2) + 4 * n + (fr & 3);
                      *(unsigned*)(Vt + ((size_t)(b * NHEAD + head) * DVH + dv) * SEQL + slot) = pack_fp8x4(acc[ai][1][m][n] * rk4); } }
            }
    }
};
struct EpiOut {
    static constexpr bool PERM = false;
    const float* x; bf16_t* X1B; u64* sqx;
    __device__ __forceinline__ void operator()(const f32x4 (&acc)[2][2][4][2], const Unit& u, int wr, int wc, int fr, int fq) const {
        const int col0 = u.pn * BM + wc * 32 + 4 * fq;
#pragma unroll
        for (int ai = 0; ai < 2; ++ai)
#pragma unroll
            for (int m = 0; m < 4; ++m) { const int row = EPI_ROWS(ai, m); float s = 0.f;
#pragma unroll
                for (int bj = 0; bj < 2; ++bj)
#pragma unroll
                    for (int n = 0; n < 2; ++n) { const size_t off = (size_t)row * D_MODEL + col0 + bj * HALF + n * 16;
                        const f32x4 v = *(const f32x4*)(x + off) + acc[ai][bj][m][n];
                        s += (v[0] * v[0] + v[1] * v[1]) + (v[2] * v[2] + v[3] * v[3]);
                        v2u w; w.x = cvt_pk_bf16(v[0], v[1]); w.y = cvt_pk_bf16(v[2], v[3]); *(v2u*)(X1B + off) = w; }
                s += shx(s, 16, fq * 16 + fr); s += shx(s, 32, fq * 16 + fr);
                if (fq == 0) fx_add(sqx + row, s); }
    }
};
struct EpiPQ {
    static constexpr bool PERM = true;
    bf16_t* QP; const u64* sqx;
    __device__ __forceinline__ void operator()(const f32x4 (&acc)[2][2][4][2], const Unit& u, int wr, int wc, int fr, int fq) const {
        const int cw = u.pn * 256 + wc * 32 + 8 * fq;
#pragma unroll
        for (int ai = 0; ai < 2; ++ai)
#pragma unroll
            for (int m = 0; m < 4; ++m) { const int row = EPI_ROWS(ai, m);
                const float r2 = __builtin_amdgcn_rsqf(fx_get(sqx + row) * (1.f / D_MODEL) + EPS);
#pragma unroll
                for (int bj = 0; bj < 2; ++bj) { const f32x4 v0 = acc[ai][bj][m][0] * r2, v1 = acc[ai][bj][m][1] * r2;
                    v4u w; w.x = cvt_pk_bf16(v0[0], v0[1]); w.y = cvt_pk_bf16(v0[2], v0[3]); w.z = cvt_pk_bf16(v1[0], v1[1]); w.w = cvt_pk_bf16(v1[2], v1[3]);
                    __builtin_nontemporal_store(w, (v4u*)(QP + (size_t)row * D_MODEL + cw + bj * HALF)); } }
    }
};
#undef EPI_ROWS
}

typedef GAS unsigned gu32;
#define RLX_AGENT __ATOMIC_RELAXED, __HIP_MEMORY_SCOPE_AGENT
#define XB_TMO      128
#define XB_XCNT(j)  (256  + 64 * (j))
#define XB_XSUB(j)  (1280 + 64 * (j))
#define XB_XGEN(j)  (2304 + 64 * (j))
#define XB_TOP      3328
#define XB_TOPGEN   3392
#define XCD_BAR_WORDS 3456
#define XB_SPIN_CAP (1u << 18)
__device__ __forceinline__ unsigned xb_ld(unsigned* p)              { return __hip_atomic_load(p, __ATOMIC_RELAXED, __HIP_MEMORY_SCOPE_AGENT); }
__device__ __forceinline__ unsigned xb_add(unsigned* p, unsigned v) { return __hip_atomic_fetch_add(p, v, __ATOMIC_RELAXED, __HIP_MEMORY_SCOPE_AGENT); }
__device__ __forceinline__ unsigned xb_xcc_id() { return (unsigned)__builtin_amdgcn_s_getreg((3 << 11) | 20) & 0xFu; }
#define XB_SPIN(cond, bar) do { unsigned _sp = 0; while (cond) { __builtin_amdgcn_s_sleep(1); \
    if ((++_sp & 255u) == 0u) { if (xb_ld(&(bar)[XB_TMO])) break; if (_sp > XB_SPIN_CAP) { atomicAdd(&(bar)[XB_TMO], 1u); break; } } } } while (0)
struct XcdBarrier { unsigned* bar; unsigned x; volatile LAS unsigned* st; int wave; };
__device__ __forceinline__ XcdBarrier xcd_barrier_post(unsigned* bar, volatile LAS unsigned* st, int wave) {
    XcdBarrier b; b.bar = bar; b.x = xb_xcc_id(); b.st = st; b.wave = wave;
    if (wave == 0 && lane_id() == 0) (void)xb_add(&bar[XB_XCNT(b.x)], 1u);
    return b;
}
__device__ __forceinline__ void xcd_barrier_complete(unsigned* bar, unsigned x, unsigned& nloc, unsigned& nx) {
    const unsigned G = gridDim.x * gridDim.y * gridDim.z;
    unsigned sum, cnt, mine, sp = 0u;
    for (;;) {
        sum = 0u; cnt = 0u; mine = 0u;
#pragma unroll
        for (unsigned j = 0; j < 16; ++j) { const unsigned c = xb_ld(&bar[XB_XCNT(j)]); sum += c; cnt += (c > 0u) ? 1u : 0u; mine = (j == x) ? c : mine; }
        if (sum == G) break;
        __builtin_amdgcn_s_sleep(1);
        if ((++sp & 255u) == 0u) { if (xb_ld(&bar[XB_TMO])) break; if (sp > XB_SPIN_CAP) { atomicAdd(&bar[XB_TMO], 1u); break; } }
    }
    nloc = mine > 0u ? mine : 1u; nx = cnt > 0u ? cnt : 1u;
}
__device__ __forceinline__ void xcd_barrier(const XcdBarrier& b) {
    asm volatile("s_waitcnt vmcnt(0)" ::: "memory");
    __syncthreads();
    if (b.wave == 0 && lane_id() == 0) {
        unsigned* bar = b.bar;
        __builtin_amdgcn_s_waitcnt(0);
        unsigned nloc = b.st[0], nx = b.st[1];
        if (nloc == 0u) { xcd_barrier_complete(bar, b.x, nloc, nx); b.st[0] = nloc; b.st[1] = nx; }
        const unsigned old = xb_add(&bar[XB_XSUB(b.x)], 1u);
        const unsigned gen = old / nloc;
        if (old + 1u == (gen + 1u) * nloc) {
            __builtin_amdgcn_fence(__ATOMIC_RELEASE, "agent");
            asm volatile("s_waitcnt vmcnt(0)" ::: "memory");
            const unsigned og = xb_add(&bar[XB_TOP], 1u);
            const unsigned tg = og / nx;
            if (og + 1u == (tg + 1u) * nx) xb_add(&bar[XB_TOPGEN], 1u);
            else XB_SPIN(xb_ld(&bar[XB_TOPGEN]) == tg, bar);
            __builtin_amdgcn_fence(__ATOMIC_ACQUIRE, "agent");
            xb_add(&bar[XB_XGEN(b.x)], 1u);
            asm volatile("s_waitcnt vmcnt(0)" ::: "memory");
        } else {
            XB_SPIN(xb_ld(&bar[XB_XGEN(b.x)]) == gen, bar);
            __builtin_amdgcn_fence(__ATOMIC_ACQUIRE, "agent");
            asm volatile("s_waitcnt vmcnt(0)" ::: "memory");
        }
    }
    __syncthreads();
}

struct Args { const float* in[20]; float* out; unsigned char* ws; };
struct Frame {
    LAS unsigned char* lds; int tid, lane, wave, vcu, G;
};

__device__ __forceinline__ int colmap(int mode, int r) {
    if (mode == 0) return r;
    if (mode == 1) return 3136 + r;
    if (mode == 3) { if (r < 4096) { const int k = r >> 8, j = r & 255; return j < 128 ? 1088 + 128 * k + j : 7232 + 128 * k + (j - 128); } if (r < 6144) return 5184 + (r - 4096); if (r < 7168) return r - 6144;
        if (r < 7232) { const int j = r - 7168; return 1024 + (j >> 1) + 32 * (j & 1); } if (r < 7424) return -1; return 3136 + (r - 7424); }
    const int h = r / DQK, d = r - h * DQK; if (d < DN) return r; const int j = d - DN; return h * DQK + DN + (j >> 1) + 32 * (j & 1);
}
template <bool F8 = false>
__device__ __forceinline__ void p0_transpose_item(const float* W, int K, int N, bf16* WT, int ndst, int mode, const float* kscale, LAS float* scr, int item, int lane) {
    const int nblk = ndst / 32, kb = item / nblk, nb = item % nblk, k0 = 64 * kb, n0 = 32 * nb;
    const int src = colmap(mode, n0 + (lane & 31));
    const int s0 = colmap(mode, n0), s31 = colmap(mode, n0 + 31);
    if (s0 >= 0 && s31 == s0 + 31 && (s0 & 3) == 0) {
        const int kr = lane >> 3, n4 = lane & 7; f32x4 v[8];
#pragma unroll
        for (int i = 0; i < 8; ++i) v[i] = *(const f32x4*)(W + (size_t)(k0 + 8 * i + kr) * N + s0 + 4 * n4);
#pragma unroll
        for (int i = 0; i < 8; ++i) { const float ks = kscale ? kscale[k0 + 8 * i + kr] : 1.f; LAS float* d = scr + (8 * i + kr) * 33 + 4 * n4;
            d[0] = v[i][0] * ks; d[1] = v[i][1] * ks; d[2] = v[i][2] * ks; d[3] = v[i][3] * ks; }
    } else {
#pragma unroll 8
    for (int i = 0; i < 32; ++i) { const int kk = 2 * i + (lane >> 5); float v = 0.f;
        if (src >= 0) { v = W[(size_t)(k0 + kk) * N + src]; if (kscale) v *= kscale[k0 + kk]; }
        scr[kk * 33 + (lane & 31)] = v; }
    }
    LDS_WAIT(); asm volatile("" ::: "memory");
    const int c = lane & 7;
#pragma unroll
    for (int j = 0; j < 4; ++j) { const int n = (lane >> 3) + 8 * j; const LAS float* s = scr + (8 * c) * 33 + n;
        if constexpr (F8) { float t[8];
#pragma unroll
            for (int e = 0; e < 8; ++e) t[e] = fminf(fmaxf(s[e * 33] * WIN8_SCALE, -448.f), 448.f);
            int w0 = 0, w1 = 0; w0 = __builtin_amdgcn_cvt_pk_fp8_f32(t[0], t[1], w0, false); w0 = __builtin_amdgcn_cvt_pk_fp8_f32(t[2], t[3], w0, true); w1 = __builtin_amdgcn_cvt_pk_fp8_f32(t[4], t[5], w1, false); w1 = __builtin_amdgcn_cvt_pk_fp8_f32(t[6], t[7], w1, true);
            v2u o; o.x = (unsigned)w0; o.y = (unsigned)w1; *(v2u*)((unsigned char*)WT + (size_t)(n0 + n) * K + k0 + 8 * c) = o; continue; }
        v4u o; o.x = cvt_pk_bf16(s[0 * 33], s[1 * 33]); o.y = cvt_pk_bf16(s[2 * 33], s[3 * 33]); o.z = cvt_pk_bf16(s[4 * 33], s[5 * 33]); o.w = cvt_pk_bf16(s[6 * 33], s[7 * 33]);
        *(v4u*)(WT + (size_t)(n0 + n) * K + k0 + 8 * c) = o; }
    LDS_WAIT(); asm volatile("" ::: "memory");
}

__device__ __forceinline__ void sgu_unit(const Frame& F, int unit, const bf16* VG, bf16* U, const bf16* WSP, const float* lng, const float* lnb, const float* bsp, const u64* ssum, const u64* ssq) {
    const int chunk = unit >> 3, g = unit & 7, row0 = chunk * 128, c0 = g * 256;
    const int tid = F.tid, lane = F.lane, w = F.wave, fr = lane & 15, fq = lane >> 4;
    LAS unsigned* vt = (LAS unsigned*)F.lds;
    LAS float* st = (LAS float*)(F.lds + 256 * 272);
    if (tid < 128) { const float mean = fx_get(ssum + row0 + tid) * (1.f / D_MODEL), ex2 = fx_get(ssq + row0 + tid) * (1.f / D_MODEL);
        const float var = fmaxf(ex2 - mean * mean, 0.f); st[2 * tid] = mean; st[2 * tid + 1] = __builtin_amdgcn_rsqf(var + EPS); }
    __syncthreads();
#pragma unroll 1
    for (int q = 0; q < 4; ++q) {
        const int wi = w + 8 * q, c8 = lane & 7, rlo = lane >> 3, s2 = 8 * (wi & 7) + rlo, cg = 8 * (wi >> 3) + c8;
        const bf16* p = VG + (size_t)(row0 + 2 * s2) * D_MODEL + c0 + 8 * cg;
        const v4u a = *(const v4u*)p, b = *(const v4u*)(p + D_MODEL);
        const f32x4 g0 = *(const f32x4*)(lng + c0 + 8 * cg), g1 = *(const f32x4*)(lng + c0 + 8 * cg + 4), b0 = *(const f32x4*)(lnb + c0 + 8 * cg), b1 = *(const f32x4*)(lnb + c0 + 8 * cg + 4);
        const float m0 = st[4 * s2], r0 = st[4 * s2 + 1], m1 = st[4 * s2 + 2], r1 = st[4 * s2 + 3];
        const unsigned aw[4] = {a.x, a.y, a.z, a.w}, bw[4] = {b.x, b.y, b.z, b.w};
        const int pd = s2 ^ (c8 << 3);
#pragma unroll
        for (int j = 0; j < 8; ++j) { const float ga = j < 4 ? g0[j & 3] : g1[j & 3], be = j < 4 ? b0[j & 3] : b1[j & 3];
            const float x0 = (j & 1) ? bf_hi(aw[j >> 1]) : bf_lo(aw[j >> 1]), x1 = (j & 1) ? bf_hi(bw[j >> 1]) : bf_lo(bw[j >> 1]);
            vt[(8 * cg + j) * 68 + pd] = cvt_pk_bf16((x0 - m0) * r0 * ga + be, (x1 - m1) * r1 * ga + be); }
    }
    __syncthreads();
    f32x4 acc[2][8];
#pragma unroll
    for (int rt = 0; rt < 2; ++rt)
#pragma unroll
        for (int tt = 0; tt < 8; ++tt) acc[rt][tt] = (f32x4){0.f, 0.f, 0.f, 0.f};
    const bf16* wg = WSP + (size_t)g * 128 * 128;
#pragma unroll
    for (int kk = 0; kk < 4; ++kk) {
        bf16x8 af[2];
#pragma unroll
        for (int rt = 0; rt < 2; ++rt) { const int ch = 32 * w + 16 * rt + fr; const int d = 16 * kk + 4 * fq, pd = d ^ (((ch >> 3) & 7) << 3);
            af[rt] = *(const LAS bf16x8*)((const LAS unsigned char*)vt + ch * 272 + pd * 4); }
#pragma unroll
        for (int tt = 0; tt < 8; ++tt) { if (tt >= 2 * kk) {
            const bf16x8 bfr = *(const bf16x8*)(wg + (size_t)(16 * tt + fr) * 128 + 32 * kk + 8 * fq);
#pragma unroll
            for (int rt = 0; rt < 2; ++rt) acc[rt][tt] = __builtin_amdgcn_mfma_f32_16x16x32_bf16(af[rt], bfr, acc[rt][tt], 0, 0, 0); } }
    }
#pragma unroll
    for (int tt = 0; tt < 8; ++tt) { const int t = 16 * tt + fr; const float bs = bsp[g * 128 + t];
#pragma unroll
        for (int rt = 0; rt < 2; ++rt) { const size_t off = (size_t)(row0 + t) * D_MODEL + c0 + 32 * w + 16 * rt + 4 * fq;
            const v2u uu = *(const v2u*)(U + off);
            const f32x4 a = acc[rt][tt];
            v2u o; o.x = cvt_pk_bf16(bf_lo(uu.x) * (a[0] + bs), bf_hi(uu.x) * (a[1] + bs));
            o.y = cvt_pk_bf16(bf_lo(uu.y) * (a[2] + bs), bf_hi(uu.y) * (a[3] + bs));
            *(v2u*)(U + off) = o; } }
    __syncthreads();
}

namespace att {
constexpr int KT = 64 * 192, VT = 128 * 64;
constexpr int L_K = 0, L_V = 4 * KT, L_WS = 4 * KT + 4 * VT;
#define KSWZ(row, ch) ((row) * 192 + ((((ch) ^ (((row) >> 2) & 3))) << 4))
__device__ __forceinline__ int v_st(int k, int c) { const int kk = (k & ~0xC) | ((k & 4) << 1) | ((k & 8) >> 1); return ((kk >> 3) * 4 + (c >> 5)) * 512 + ((kk & 7) * 32 + (c & 31)) * 2; }
__device__ __forceinline__ int v_rd_base(int lane) { return ((lane & 3) << 3) | (((lane >> 2) & 3) << 6) | (((lane >> 4) & 1) << 5) | (((lane >> 5) & 1) << 8); }
constexpr int v_rd_off(int d0, int ks, int half) { return d0 * 512 + ks * 4096 + half * 2048; }
__device__ __forceinline__ int crow(int r, int hi) { return (r & 3) + 8 * (r >> 2) + 4 * hi; }
__device__ __forceinline__ void mask_tile(f32x16& p0, f32x16& p1, int dq) {
    const float NEG = -__builtin_inff();
#pragma unroll
    for (int r = 0; r < 16; ++r) { const int c = (r & 3) + 8 * (r >> 2); if (dq - c < 0) p0[r] = NEG; if (dq - c - 32 < 0) p1[r] = NEG; }
}
constexpr float THR = 8.f;
__device__ __forceinline__ void softmax_tile(f32x16& p0, f32x16& p1, float& m_reg, float& alpha, v8i& pk, bool first) {
    float pmax;
    { float a4[4];
#pragma unroll
      for (int c = 0; c < 4; ++c) { a4[c] = fmaxf(fmaxf(p0[4 * c], p0[4 * c + 1]), p0[4 * c + 2]); a4[c] = fmaxf(fmaxf(a4[c], p0[4 * c + 3]), p1[4 * c]);
          a4[c] = fmaxf(fmaxf(a4[c], p1[4 * c + 1]), p1[4 * c + 2]); a4[c] = fmaxf(a4[c], p1[4 * c + 3]); }
      pmax = fmaxf(fmaxf(a4[0], a4[1]), fmaxf(a4[2], a4[3])); }
    { auto rr = __builtin_amdgcn_permlane32_swap(__float_as_uint(pmax), __float_as_uint(pmax), false, false); pmax = fmaxf(__uint_as_float(rr[0]), __uint_as_float(rr[1])); }
    if (__builtin_expect(__all(pmax - m_reg <= THR) && !first, 1)) { alpha = 1.f; }
    else { float delta = first ? pmax - m_reg : fmaxf(pmax - m_reg, 0.f); if (!(delta > -1e30f)) delta = 0.f;
        alpha = first ? 1.f : __builtin_amdgcn_exp2f(-delta); m_reg += delta; }
#pragma unroll
    for (int r = 0; r < 16; ++r) { p0[r] = __builtin_amdgcn_exp2f(p0[r] - m_reg); p1[r] = __builtin_amdgcn_exp2f(p1[r] - m_reg); }
#pragma unroll
    for (int w = 0; w < 4; ++w) { int d0 = 0, d1 = 0; d0 = __builtin_amdgcn_cvt_pk_fp8_f32(p0[4 * w], p0[4 * w + 1], d0, false); d0 = __builtin_amdgcn_cvt_pk_fp8_f32(p0[4 * w + 2], p0[4 * w + 3], d0, true);
        d1 = __builtin_amdgcn_cvt_pk_fp8_f32(p1[4 * w], p1[4 * w + 1], d1, false); d1 = __builtin_amdgcn_cvt_pk_fp8_f32(p1[4 * w + 2], p1[4 * w + 3], d1, true); pk[w] = d0; pk[4 + w] = d1; }
}
template <int KB>
__device__ __forceinline__ void qkt(f32x16& p0, f32x16& p1, const char* K_lds, int r32, int hi, const v8i* qr) {
    p0 = f32x16{}; p1 = f32x16{};
    const char* k0 = K_lds + KB * KT + KSWZ(r32, 2 * hi); const char* k1 = K_lds + KB * KT + KSWZ(r32, 2 * hi + 1);
#pragma unroll
    for (int ks = 0; ks < 3; ++ks) {
        const v4u a0 = *reinterpret_cast<const v4u*>(k0 + ks * 64), a1 = *reinterpret_cast<const v4u*>(k1 + ks * 64);
        const v4u b0 = *reinterpret_cast<const v4u*>(k0 + ks * 64 + 32 * 192), b1 = *reinterpret_cast<const v4u*>(k1 + ks * 64 + 32 * 192);
        const v8i ka = {(int)a0.x, (int)a0.y, (int)a0.z, (int)a0.w, (int)a1.x, (int)a1.y, (int)a1.z, (int)a1.w};
        const v8i kb = {(int)b0.x, (int)b0.y, (int)b0.z, (int)b0.w, (int)b1.x, (int)b1.y, (int)b1.z, (int)b1.w};
        p0 = __builtin_amdgcn_mfma_scale_f32_32x32x64_f8f6f4(ka, qr[ks], p0, 0, 0, 0, 0x7c7c7c7c, 0, 0x79797979);
        p1 = __builtin_amdgcn_mfma_scale_f32_32x32x64_f8f6f4(kb, qr[ks], p1, 0, 0, 0, 0x7c7c7c7c, 0, 0x79797979); }
}
template <int VB>
__device__ __forceinline__ void pv_tile(f32x16* o, f32x16& lacc, const char* V_lds, int r32, int hi, v8i pk) {
    const int sw = (r32 >> 2) & 3;
    const char* v0 = V_lds + VB * VT + r32 * 64 + (((2 * hi) ^ sw) << 4); const char* v1 = V_lds + VB * VT + r32 * 64 + (((2 * hi + 1) ^ sw) << 4);
#pragma unroll
    for (int d0 = 0; d0 < 4; ++d0) { const v4u a = *reinterpret_cast<const v4u*>(v0 + d0 * 2048), b = *reinterpret_cast<const v4u*>(v1 + d0 * 2048);
        const v8i vb = {(int)a.x, (int)a.y, (int)a.z, (int)a.w, (int)b.x, (int)b.y, (int)b.z, (int)b.w};
        o[d0] = __builtin_amdgcn_mfma_scale_f32_32x32x64_f8f6f4(pk, vb, o[d0], 0, 0, 0, 0x7f7f7f7f, 0, 0x7c7c7c7c); if (d0 == 1) SBAR(); }
    { int c1 = 0x38383838; asm volatile("" : "+v"(c1)); const v8i ones = {c1, c1, c1, c1, c1, c1, c1, c1};
      lacc = __builtin_amdgcn_mfma_scale_f32_32x32x64_f8f6f4(pk, ones, lacc, 0, 0, 0, 0x7f7f7f7f, 0, 0x7f7f7f7f); }
}
__device__ __forceinline__ void attn_unit(int bh, int qb, const unsigned char* Q, const unsigned char* K, const unsigned char* KRp, const unsigned char* V, const bf16* GA, bf16* MG, char* lds, LAS unsigned char* lds3, const int wave0) {
    int tid = wave0 * 64 + lane_id(); asm volatile("" : "+v"(tid));
    const int wid = __builtin_amdgcn_readfirstlane(tid >> 6), lane = tid & 63, r32 = lane & 31, hi = lane >> 5;
    const int q0 = qb * 256, qlo = q0 + wid * 32, qm = qlo + r32 - 4 * hi;
    const unsigned char* Qw = Q + ((size_t)bh * SEQL + qlo + r32) * DQK;
    const unsigned char* Kh = K + (size_t)bh * SEQL * DN; const unsigned char* KRh = KRp + (size_t)(bh >> 4) * SEQL * DR; const unsigned char* Vh = V + (size_t)bh * SEQL * DVH;
    char* V_lds = lds + L_V; char* K_lds = lds + L_K;
    float* ws = (float*)(lds + L_WS) + wid * 64; float* li_l = ws, * al_l = ws + 32;
    v8i qr[3];
#pragma unroll
    for (int ks = 0; ks < 3; ++ks) { const v4u a = *reinterpret_cast<const v4u*>(Qw + ks * 64 + hi * 32), b = *reinterpret_cast<const v4u*>(Qw + ks * 64 + hi * 32 + 16);
        qr[ks] = (v8i){(int)a.x, (int)a.y, (int)a.z, (int)a.w, (int)b.x, (int)b.y, (int)b.z, (int)b.w}; }
    const int NT = 4 * (qb + 1);
    unsigned ksp[2], kst[2], vso;
#pragma unroll
    for (int i = 0; i < 2; ++i) { const int o = i * 8192 + tid * 16, row = (o / 192) & 63, pos = (o - (o / 192) * 192) >> 4, ch = pos ^ ((row >> 2) & 3);
        if (ch < 8) { ksp[i] = (unsigned)(Kh - Vh) + (unsigned)(row * DN + ch * 16); kst[i] = 64 * DN; } else { ksp[i] = (unsigned)(KRh - Vh) + (unsigned)(row * DR + (ch - 8) * 16); kst[i] = 64 * DR; } }
    { const int j = tid >> 2, c = (tid & 3) ^ ((j >> 2) & 3); vso = (unsigned)(j * SEQL + c * 16); }
    float m_reg = 0.f; f32x16 lacc = {}; f32x16 o[4] = {};
    const unsigned ldw = (unsigned)wid * 1024u;
#define SOFF(x) ({ unsigned o_ = (x); asm volatile("" : "+v"(o_)); (const unsigned*)((const char*)Vh + o_); })
#define SDMA(t, bf) do { \
        __builtin_amdgcn_global_load_lds(SOFF(ksp[0] + (unsigned)(t) * kst[0]), (LAS unsigned*)(lds3 + L_K + (bf) * KT + ldw), 16, 0, 0); \
        if (wid < 4) __builtin_amdgcn_global_load_lds(SOFF(ksp[1] + (unsigned)(t) * kst[1]), (LAS unsigned*)(lds3 + L_K + (bf) * KT + 8192 + ldw), 16, 0, 0); \
        __builtin_amdgcn_global_load_lds(SOFF(vso + (unsigned)(t) * 64u), (LAS unsigned*)(lds3 + L_V + (bf) * VT + ldw), 16, 0, 0); } while (0)
#define TILE(t, BF) do { f32x16 p0, p1; float alpha; v8i pk; \
        __builtin_amdgcn_s_setprio(1); qkt<BF>(p0, p1, K_lds, r32, hi, qr); __builtin_amdgcn_s_setprio(0); \
        { const int kb_ = (t) * 64; if (kb_ + 63 > qlo) mask_tile(p0, p1, qm - kb_); } \
        softmax_tile(p0, p1, m_reg, alpha, pk, (t) == 0); \
        if (__any(alpha < 1.f)) { if (hi == 0) al_l[r32] = alpha; asm volatile("s_waitcnt lgkmcnt(0)" ::: "memory"); \
            _Pragma("unroll") for (int r = 0; r < 16; ++r) { const float a_ = al_l[crow(r, hi)]; lacc[r] *= a_; _Pragma("unroll") for (int d_ = 0; d_ < 4; ++d_) o[d_][r] *= a_; } } \
        __builtin_amdgcn_s_setprio(1); pv_tile<BF>(o, lacc, V_lds, r32, hi, pk); __builtin_amdgcn_s_setprio(0); SBAR(); } while (0)
    SDMA(0, 0); SDMA(1, 1); VM_WAIT(); __syncthreads();
    for (int t = 0; t < NT; t += 4) {
        SDMA(t + 2, 2); SDMA(t + 3, 3); SBAR();
        TILE(t, 0); TILE(t + 1, 1);
        VM_WAIT(); __syncthreads();
        if (t + 4 < NT) { SDMA(t + 4, 0); SDMA(t + 5, 1); } SBAR();
        TILE(t + 2, 2); TILE(t + 3, 3);
        VM_WAIT(); __syncthreads(); }
#undef TILE
#undef SDMA
#undef SOFF
    float* stg = (float*)lds + wid * 4096;
    float rli[16];
#pragma unroll
    for (int r = 0; r < 16; ++r) rli[r] = __builtin_amdgcn_rcpf(lacc[r]);
    const int le = lane_id(), r32e = le & 31, hie = le >> 5;
#pragma unroll
    for (int r = 0; r < 16; ++r) { const int orow = crow(r, hie);
#pragma unroll
        for (int d0 = 0; d0 < 4; ++d0) stg[orow * 128 + d0 * 32 + r32e] = o[d0][r] * rli[r]; }
    asm volatile("s_waitcnt lgkmcnt(0)" ::: "memory");
    const int b = bh >> 4, h = bh & 15;
#pragma unroll 4
    for (int it = 0; it < 16; ++it) { const int row = 2 * it + hie, c4 = r32e * 4;
        const f32x4 ov = *(const f32x4*)(stg + row * 128 + c4);
        const size_t off = ((size_t)b * SEQL + qlo + row) * D_MODEL + h * DVH + c4;
        const v2u ga = *(const v2u*)(GA + off), ob = *(const v2u*)(MG + off);
        v2u w; w.x = cvt_pk_bf16(bf_lo(ga.x) * ov[0] + bf_lo(ob.x), bf_hi(ga.x) * ov[1] + bf_hi(ob.x)); w.y = cvt_pk_bf16(bf_lo(ga.y) * ov[2] + bf_lo(ob.y), bf_hi(ga.y) * ov[3] + bf_hi(ob.y));
        *(v2u*)(MG + off) = w; }
    __syncthreads();
}
#undef KSWZ
}

__device__ __forceinline__ void ce_desc(float& a, float& b) { const float hi = fmaxf(a, b), lo = fminf(a, b); a = hi; b = lo; }
template <int N> __device__ __forceinline__ void bitonic_sort_desc(float (&v)[N]) {
#pragma unroll
    for (int k = 2; k <= N; k <<= 1)
#pragma unroll
        for (int j = k >> 1; j > 0; j >>= 1)
#pragma unroll
            for (int i = 0; i < N; ++i) { const int l = i ^ j; if (l > i) { if ((i & k) == 0) ce_desc(v[i], v[l]); else ce_desc(v[l], v[i]); } }
}
template <int N> __device__ __forceinline__ void bitonic_merge_desc(float (&v)[N]) {
#pragma unroll
    for (int j = N >> 1; j > 0; j >>= 1)
#pragma unroll
        for (int i = 0; i < N; ++i) { const int l = i ^ j; if (l > i) ce_desc(v[i], v[l]); }
}
__device__ __forceinline__ void merge_top16(float (&a)[16], const float (&b)[16]) {
#pragma unroll
    for (int i = 0; i < 16; ++i) a[i] = fmaxf(a[i], b[15 - i]);
    bitonic_merge_desc<16>(a);
}
__device__ __forceinline__ void topk_unit(const Frame& F, int tg, int h, const bf16* QP, int* TOPI, float* TOPG) {
    const int lane = F.lane, fr = lane & 15, fq = lane >> 4;
    const int t0 = tg * 16;
    LAS float* sl = (LAS float*)(F.lds + 65536) + F.wave * 512;
    float s01[2][16];
#pragma unroll
    for (int p = 0; p < 2; ++p) {
        f32x4 acc[8];
#pragma unroll
        for (int mt = 0; mt < 8; ++mt) acc[mt] = (f32x4){0.f, 0.f, 0.f, 0.f};
        const bf16* qp = QP + (size_t)(t0 + fr) * D_MODEL + h * 256 + p * 128 + 8 * fq;
        const LAS unsigned char* kp = F.lds + p * 32768 + fr * 256;
#pragma unroll
        for (int kk = 0; kk < 4; ++kk) { const bf16x8 bq = *(const bf16x8*)(qp + 32 * kk);
#pragma unroll
            for (int mt = 0; mt < 8; ++mt) { const bf16x8 ak = *(const LAS bf16x8*)(kp + mt * 4096 + (((4 * kk + fq) ^ fr) << 4));
                acc[mt] = __builtin_amdgcn_mfma_f32_16x16x32_bf16(ak, bq, acc[mt], 0, 0, 0); } }
        float a[16], b[16];
#pragma unroll
        for (int mt = 0; mt < 8; ++mt)
#pragma unroll
            for (int e = 0; e < 4; ++e) { const unsigned n = (unsigned)(16 * mt + 4 * fq + e); const float pk = __uint_as_float((__float_as_uint(acc[mt][e]) & ~0x7Fu) | n);
                if (mt < 4) a[mt * 4 + e] = pk; else b[(mt - 4) * 4 + e] = pk; }
        bitonic_sort_desc<16>(a); bitonic_sort_desc<16>(b); merge_top16(a, b);
#pragma unroll
        for (int i = 0; i < 16; ++i) b[i] = shx(a[i], 16, F.lane);
        merge_top16(a, b);
#pragma unroll
        for (int i = 0; i < 16; ++i) b[i] = shx(a[i], 32, F.lane);
        merge_top16(a, b);
#pragma unroll
        for (int i = 0; i < 16; ++i) s01[p][i] = a[i];
    }
    if (fq == 0) {
#pragma unroll
        for (int p = 0; p < 2; ++p)
#pragma unroll
            for (int i = 0; i < 16; ++i) sl[fr * 32 + p * 16 + i] = s01[p][i];
    }
    float c[4][16];
#pragma unroll
    for (int gidx = 0; gidx < 4; ++gidx)
#pragma unroll
        for (int i = 0; i < 16; ++i) c[gidx][i] = -3.0e38f;
#define CAND(n, i, j) do { const float v_ = __uint_as_float(__float_as_uint(s01[0][i]) & ~0x7Fu) + __uint_as_float(__float_as_uint(s01[1][j]) & ~0x7Fu); \
        c[(n) >> 4][(n) & 15] = __uint_as_float((__float_as_uint(v_) & ~0xFFu) | (unsigned)((i) * 16 + (j))); } while (0)
    CAND(0, 0, 0); CAND(1, 0, 1); CAND(2, 0, 2); CAND(3, 0, 3); CAND(4, 0, 4); CAND(5, 0, 5); CAND(6, 0, 6); CAND(7, 0, 7);
    CAND(8, 0, 8); CAND(9, 0, 9); CAND(10, 0, 10); CAND(11, 0, 11); CAND(12, 0, 12); CAND(13, 0, 13); CAND(14, 0, 14); CAND(15, 0, 15);
    CAND(16, 1, 0); CAND(17, 1, 1); CAND(18, 1, 2); CAND(19, 1, 3); CAND(20, 1, 4); CAND(21, 1, 5); CAND(22, 1, 6); CAND(23, 1, 7);
    CAND(24, 2, 0); CAND(25, 2, 1); CAND(26, 2, 2); CAND(27, 2, 3); CAND(28, 2, 4);
    CAND(29, 3, 0); CAND(30, 3, 1); CAND(31, 3, 2); CAND(32, 3, 3);
    CAND(33, 4, 0); CAND(34, 4, 1); CAND(35, 4, 2);
    CAND(36, 5, 0); CAND(37, 5, 1); CAND(38, 6, 0); CAND(39, 6, 1); CAND(40, 7, 0); CAND(41, 7, 1);
    CAND(42, 8, 0); CAND(43, 9, 0); CAND(44, 10, 0); CAND(45, 11, 0); CAND(46, 12, 0); CAND(47, 13, 0); CAND(48, 14, 0); CAND(49, 15, 0);
#undef CAND
    bitonic_sort_desc<16>(c[0]); bitonic_sort_desc<16>(c[1]); bitonic_sort_desc<16>(c[2]); bitonic_sort_desc<16>(c[3]);
    merge_top16(c[0], c[1]); merge_top16(c[2], c[3]); merge_top16(c[0], c[2]);
    LDS_WAIT(); asm volatile("" ::: "memory");
    float sc[16]; int ix[16]; float mx = -3.0e38f;
#pragma unroll
    for (int w = 0; w < 16; ++w) { const unsigned id = __float_as_uint(c[0][w]) & 0xFFu; const unsigned u0 = __float_as_uint(sl[fr * 32 + (id >> 4)]), u1 = __float_as_uint(sl[fr * 32 + 16 + (id & 15)]);
        sc[w] = __uint_as_float(u0 & ~0x7Fu) + __uint_as_float(u1 & ~0x7Fu); ix[w] = (int)((u0 & 0x7Fu) * NKEYS + (u1 & 0x7Fu)); mx = fmaxf(mx, sc[w]); }
    float sum = 0.f;
#pragma unroll
    for (int w = 0; w < 16; ++w) { sc[w] = __builtin_amdgcn_exp2f((sc[w] - mx) * 1.4426950409f); sum += sc[w]; }
    const float rs = __builtin_amdgcn_rcpf(sum);
    if (fq == 0) { int* ti = TOPI + (size_t)(t0 + fr) * 128 + h * 16; float* tgp = TOPG + (size_t)(t0 + fr) * 128 + h * 16;
#pragma unroll
        for (int w = 0; w < 16; ++w) { ti[w] = ix[w]; tgp[w] = sc[w] * rs; } }
    LDS_WAIT(); asm volatile("" ::: "memory");
}

typedef float f32x2 __attribute__((ext_vector_type(2)));
struct PeerIdx { int i0, i1; float a0, a1; };
struct PeerRow { v4u x[2]; };
__device__ __forceinline__ void pu_gather(int t, int sl, int lane, const PeerIdx& I, v4u (&wu)[16], PeerRow& R, const bf16* X, const unsigned char* PU8) {
    const int r = lane & 7, g = lane >> 3;
#pragma unroll
    for (int k = 0; k < 16; ++k) { const int e = __shfl(k < 8 ? I.i0 : I.i1, (8 * k + g) & 63); wu[k] = *(const v4u*)(PU8 + ((size_t)sl * NEXP + e) * 128 + 16 * r); }
    const bf16* xp = X + (size_t)t * D_MODEL + 128 * sl + 16 * r;
    R.x[0] = __builtin_nontemporal_load((const v4u*)xp); R.x[1] = __builtin_nontemporal_load((const v4u*)(xp + 8));
}
__device__ __forceinline__ void pu_compute(int t, int sl, int lane, const v4u (&wu)[16], const PeerRow& R, float* PART) {
    const int r = lane & 7, g = lane >> 3;
    float hh[16];
    { const unsigned xw[8] = {R.x[0].x, R.x[0].y, R.x[0].z, R.x[0].w, R.x[1].x, R.x[1].y, R.x[1].z, R.x[1].w};
#pragma unroll
      for (int q = 0; q < 8; ++q) { hh[2 * q] = bf_lo(xw[q]); hh[2 * q + 1] = bf_hi(xw[q]); } }
    float d[16];
    { f32x2 ac[16];
#pragma unroll
      for (int k = 0; k < 16; ++k) ac[k] = (f32x2){0.f, 0.f};
#pragma unroll
      for (int q = 0; q < 4; ++q) { const f32x2 hlo = {hh[4 * q], hh[4 * q + 1]}, hhi = {hh[4 * q + 2], hh[4 * q + 3]};
#pragma unroll
          for (int k = 0; k < 16; ++k) { const int w_ = (int)(q == 0 ? wu[k].x : q == 1 ? wu[k].y : q == 2 ? wu[k].z : wu[k].w);
              ac[k] += __builtin_amdgcn_cvt_pk_f32_fp8(w_, false) * hlo; ac[k] += __builtin_amdgcn_cvt_pk_f32_fp8(w_, true) * hhi; } }
#pragma unroll
      for (int k = 0; k < 16; ++k) d[k] = ac[k][0] + ac[k][1]; }
    const bool b0 = lane & 1, b1 = lane & 2, b2 = lane & 4;
    float res[2];
#pragma unroll
    for (int hf = 0; hf < 2; ++hf) { float e1[4], f1[2];
#pragma unroll
        for (int m = 0; m < 4; ++m) e1[m] = (b0 ? d[8 * hf + 2 * m + 1] : d[8 * hf + 2 * m]) + shx(b0 ? d[8 * hf + 2 * m] : d[8 * hf + 2 * m + 1], 1, lane);
#pragma unroll
        for (int n = 0; n < 2; ++n) f1[n] = (b1 ? e1[2 * n + 1] : e1[2 * n]) + shx(b1 ? e1[2 * n] : e1[2 * n + 1], 2, lane);
        res[hf] = (b2 ? f1[1] : f1[0]) + shx(b2 ? f1[0] : f1[1], 4, lane); }
    float* po = PART + ((size_t)t * 16 + sl) * 128 + 8 * r + g;
    __builtin_nontemporal_store(res[0], po); __builtin_nontemporal_store(res[1], po + 64);
}
__device__ __forceinline__ void peer_fin_token(int t, int lane, const float* PART, const int* TOPI, float* TOPG, const float* USC, const float* VSC, const u64* sqx) {
    const float r2 = __builtin_amdgcn_rsqf(fx_get(sqx + t) * (1.f / D_MODEL) + EPS);
    float s0 = 0.f, s1 = 0.f;
#pragma unroll
    for (int sl = 0; sl < 16; ++sl) { s0 += __builtin_nontemporal_load(PART + ((size_t)t * 16 + sl) * 128 + lane); s1 += __builtin_nontemporal_load(PART + ((size_t)t * 16 + sl) * 128 + 64 + lane); }
    const int e0 = TOPI[(size_t)t * 128 + lane], e1 = TOPI[(size_t)t * 128 + 64 + lane];
    float* gp = TOPG + (size_t)t * 128;
    gp[lane] = gelu_t(s0 * USC[e0] * r2) * gp[lane] * VSC[e0]; gp[64 + lane] = gelu_t(s1 * USC[e1] * r2) * gp[64 + lane] * VSC[e1];
}
__device__ __forceinline__ void pv_gather(int t, int sl, int lane, const PeerIdx& I, v4u (&wv)[16], float (&xv)[2], const bf16* X, const unsigned char* PV8) {
    const int r = lane & 7, g = lane >> 3;
#pragma unroll
    for (int k = 0; k < 16; ++k) { const int e = __shfl(k < 8 ? I.i0 : I.i1, (8 * k + g) & 63); wv[k] = *(const v4u*)(PV8 + ((size_t)sl * NEXP + e) * 128 + 16 * r); }
    const bf16* xp = X + (size_t)t * D_MODEL + 128 * sl + 16 * r + g; xv[0] = __uint_as_float((unsigned)xp[0] << 16); xv[1] = __uint_as_float((unsigned)xp[8] << 16);
}
__device__ __forceinline__ void pv_compute(int t, int sl, int lane, const PeerIdx& I, const v4u (&wv)[16], const float (&xv)[2], float* X, u64* ssq2) {
    const int r = lane & 7, g = lane >> 3;
    float oa[16];
    { f32x2 o2[8]; float ak[16];
#pragma unroll
      for (int e = 0; e < 8; ++e) o2[e] = (f32x2){0.f, 0.f};
#pragma unroll
      for (int k = 0; k < 16; ++k) ak[k] = __shfl(k < 8 ? I.a0 : I.a1, (8 * k + g) & 63);
#pragma unroll
      for (int k = 0; k < 16; ++k) { const f32x2 a2 = {ak[k], ak[k]};
#pragma unroll
          for (int q = 0; q < 4; ++q) { const int w_ = (int)(q == 0 ? wv[k].x : q == 1 ? wv[k].y : q == 2 ? wv[k].z : wv[k].w);
              o2[2 * q] += __builtin_amdgcn_cvt_pk_f32_fp8(w_, false) * a2; o2[2 * q + 1] += __builtin_amdgcn_cvt_pk_f32_fp8(w_, true) * a2; } }
#pragma unroll
      for (int e = 0; e < 8; ++e) { oa[2 * e] = o2[e][0]; oa[2 * e + 1] = o2[e][1]; } }
    const bool c0 = lane & 8, c1 = lane & 16, c2 = lane & 32;
    float p1[8], p2[4], p3[2];
#pragma unroll
    for (int m = 0; m < 8; ++m) p1[m] = (c0 ? oa[2 * m + 1] : oa[2 * m]) + shx(c0 ? oa[2 * m] : oa[2 * m + 1], 8, lane);
#pragma unroll
    for (int n = 0; n < 4; ++n) p2[n] = (c1 ? p1[2 * n + 1] : p1[2 * n]) + shx(c1 ? p1[2 * n] : p1[2 * n + 1], 16, lane);
#pragma unroll
    for (int q = 0; q < 2; ++q) p3[q] = (c2 ? p2[2 * q + 1] : p2[2 * q]) + shx(c2 ? p2[2 * q] : p2[2 * q + 1], 32, lane);
    float* xp = X + (size_t)t * D_MODEL + 128 * sl + 16 * r + g;
    const float y0 = xv[0] + p3[0], y1 = xv[1] + p3[1];
    xp[0] = y0; xp[8] = y1;
    const float ss = wave_sum(y0 * y0 + y1 * y1, lane);
    if (lane == 0) fx_add(ssq2 + t, ss);
}
__device__ __forceinline__ void row8_load(f32x4 (&v)[8], const float* src, int lane) {
    const f32x4* xr = (const f32x4*)src + lane;
#pragma unroll
    for (int j = 0; j < 8; ++j) v[j] = __builtin_nontemporal_load(xr + 64 * j);
}
__device__ __forceinline__ void row_to_fp8(f32x4 (&v)[8], unsigned char* tab, int e, float* inv_scale, int lane, const float* colmul) {
    float am = 0.f;
#pragma unroll
    for (int j = 0; j < 8; ++j) { if (colmul) v[j] = v[j] * *((const f32x4*)colmul + lane + 64 * j);
        am = fmaxf(am, fmaxf(fmaxf(fabsf(v[j][0]), fabsf(v[j][1])), fmaxf(fabsf(v[j][2]), fabsf(v[j][3])))); }
#pragma unroll
    for (int o = 1; o < 64; o <<= 1) am = fmaxf(am, shx(am, o, lane));
    am = fmaxf(am, 1e-30f); const float sc = 256.f / am;
#pragma unroll
    for (int j = 0; j < 8; ++j) { int w = 0; w = __builtin_amdgcn_cvt_pk_fp8_f32(v[j][0] * sc, v[j][1] * sc, w, false); w = __builtin_amdgcn_cvt_pk_fp8_f32(v[j][2] * sc, v[j][3] * sc, w, true); const int dw = lane + 64 * j; *(unsigned*)(tab + ((size_t)(dw >> 5) * NEXP + e) * 128 + (dw & 31) * 4) = (unsigned)w; }
    if (lane == 0) *inv_scale = am * (1.f / 256.f);
}

__global__ void __launch_bounds__(512, 2) mk_fwd(Args args) {
    extern __shared__ __attribute__((aligned(16))) unsigned char lds[];
    Frame F;
    F.lds = (LAS unsigned char*)lds;
    F.wave = __builtin_amdgcn_readfirstlane((int)threadIdx.x >> 6); F.lane = lane_id(); F.tid = F.wave * 64 + F.lane;
    F.G = gridDim.x; { const int bx = blockIdx.x; F.vcu = (F.G % 8 == 0) ? (bx % 8) * (F.G / 8) + bx / 8 : bx; }
    unsigned char* ws = args.ws;
    gu32* ctl = (gu32*)(ws + WS_CTL);
    volatile LAS unsigned* MISC = (volatile LAS unsigned*)(F.lds + MISC_OFF);
    for (int u = F.tid; u < (LDS_BYTES - LDSCTL_OFF) / 4; u += 512) ((LAS unsigned*)(F.lds + LDSCTL_OFF))[u] = 0u;
    __syncthreads();
    XcdBarrier bar; bar.bar = (unsigned*)(ctl + CW_BAR); bar.x = 0; bar.st = nullptr;
    bar = xcd_barrier_post((unsigned*)(ctl + CW_BAR), MISC + 8, F.wave);
#define GRID_BAR() xcd_barrier(bar)
#define PHASE_BEGIN() do { F.lane = lane_id(); asm volatile("" : "+v"(F.lane)); F.tid = F.wave * 64 + F.lane; } while (0)
    const float* x = args.in[0]; const int* positions = (const int*)args.in[1]; const float* g_norm1 = args.in[2]; const float* w_in = args.in[3];
    const float* g_q_a = args.in[4]; const float* w_uq = args.in[5]; const float* g_kv_a = args.in[6]; const float* w_ukv = args.in[7];
    const float* sgu_ln_g = args.in[8]; const float* sgu_ln_b = args.in[9]; const float* w_spatial = args.in[10]; const float* b_spatial = args.in[11];
    const float* b_gate = args.in[12]; const float* w_out = args.in[13]; const float* g_norm2 = args.in[14]; const float* w_peer_q = args.in[15];
    const float* peer_keys = args.in[16]; const float* peer_u = args.in[17]; const float* peer_v = args.in[18]; const float* g_final = args.in[19];
    float* out = args.out;
    bf16* KEYS = (bf16*)(ws + WS_KEYS); bf16* WSP = (bf16*)(ws + WS_WSP); bf16* WUQ = (bf16*)(ws + WS_WUQ); bf16* WUKV = (bf16*)(ws + WS_WUKV);
    bf16* WOUT = (bf16*)(ws + WS_WOUT); bf16* WPQ = (bf16*)(ws + WS_WPQ); float* ROPE = (float*)(ws + WS_ROPE);
    unsigned char* XN8 = ws + WS_XN8; unsigned char* WIN8 = ws + WS_WIN8; unsigned char* CQKV = ws + WS_CQKV; bf16* U = (bf16*)(ws + WS_U); bf16* VG = (bf16*)(ws + WS_VG);
    unsigned char* Vb = ws + WS_V; unsigned char* Kb = ws + WS_K; unsigned char* KR = ws + WS_KR; unsigned char* Qb = ws + WS_Q; bf16* GA = (bf16*)(ws + WS_GA); float* X2 = (float*)(ws + WS_X2);
    bf16* X1B = (bf16*)(ws + WS_X1B); unsigned char* PU = ws + WS_PU; unsigned char* PV = ws + WS_PV; float* USC = (float*)(ws + WS_PSC); float* VSC = USC + NEXP; float* PART = (float*)(ws + WS_PART); bf16* QP = (bf16*)(ws + WS_QP);
    int* TOPI = (int*)(ws + WS_TOPI); float* TOPG = (float*)(ws + WS_TOPG);
    u64* SQQ = (u64*)(ws + CTL_STATS); u64* SQKV = SQQ + MTOK; u64* SSUM = SQKV + MTOK; u64* SSQ = SSUM + MTOK; u64* SQX1 = SSQ + MTOK;
    const int gw = F.vcu * 8 + F.wave, NGW = F.G * 8;

    {
        LAS float* scr = (LAS float*)(F.lds + RING_OFF + F.wave * 16384);
        constexpr int I_IN8 = (D_MODEL / 64) * (IN8_ROWS / 32), I_UQ = (QL / 64) * (NQ_COLS / 32), I_UKV = (QL / 64) * (NKV_COLS / 32), I_O = (D_MODEL / 64) * (D_MODEL / 32);
        constexpr int NITEMS = I_IN8 + I_UQ + I_UKV + 2 * I_O;
        for (int it = gw; it < NITEMS; it += NGW) {
            int r = it;
            if (r < I_IN8) { p0_transpose_item<true>(w_in, D_MODEL, IN_COLS, (bf16*)WIN8, IN8_ROWS, 3, nullptr, scr, r, F.lane); continue; } r -= I_IN8;
            if (r < I_UQ) { p0_transpose_item<true>(w_uq, QL, NQ_COLS, WUQ, NQ_COLS, 2, g_q_a, scr, r, F.lane); continue; } r -= I_UQ;
            if (r < I_UKV) { p0_transpose_item<true>(w_ukv, QL, NKV_COLS, WUKV, NKV_COLS, 0, g_kv_a, scr, r, F.lane); continue; } r -= I_UKV;
            if (r < I_O) { p0_transpose_item(w_out, D_MODEL, D_MODEL, WOUT, D_MODEL, 0, nullptr, scr, r, F.lane); continue; } r -= I_O;
            p0_transpose_item(w_peer_q, D_MODEL, D_MODEL, WPQ, D_MODEL, 0, g_norm2, scr, r, F.lane);
        }
        {
#define XN_LOAD(v, m_) do { const f32x4* xr_ = (const f32x4*)(x + (size_t)(m_) * D_MODEL) + F.lane; _Pragma("unroll") for (int j = 0; j < 8; ++j) v[j] = __builtin_nontemporal_load(xr_ + 64 * j); } while (0)
#define XN_DO(v, m_) do { float s_ = 0.f; _Pragma("unroll") for (int j = 0; j < 8; ++j) s_ += (v[j][0] * v[j][0] + v[j][1] * v[j][1]) + (v[j][2] * v[j][2] + v[j][3] * v[j][3]); \
            const float r_ = __builtin_amdgcn_rsqf(wave_sum(s_, F.lane) * (1.f / D_MODEL) + EPS); \
            _Pragma("unroll") for (int j = 0; j < 8; ++j) { const f32x4 h_ = v[j] * r_ * gn[j]; \
                const f32x4 h8_ = __builtin_elementwise_min(__builtin_elementwise_max(h_ * XN8_SCALE, (f32x4){-448.f, -448.f, -448.f, -448.f}), (f32x4){448.f, 448.f, 448.f, 448.f}); \
                int p_ = 0; p_ = __builtin_amdgcn_cvt_pk_fp8_f32(h8_[0], h8_[1], p_, false); p_ = __builtin_amdgcn_cvt_pk_fp8_f32(h8_[2], h8_[3], p_, true); ((unsigned*)(XN8 + (size_t)(m_) * D_MODEL))[F.lane + 64 * j] = (unsigned)p_; } } while (0)
            f32x4 gn[8];
#pragma unroll
            for (int j = 0; j < 8; ++j) gn[j] = *((const f32x4*)g_norm1 + F.lane + 64 * j);
            f32x4 va[8], vb[8]; int m = gw; if (m < MTOK) XN_LOAD(va, m);
#pragma unroll 1
            for (; m < MTOK; m += 2 * NGW) {
                if (m + NGW < MTOK) XN_LOAD(vb, m + NGW);
                XN_DO(va, m);
                if (m + NGW < MTOK) { if (m + 2 * NGW < MTOK) XN_LOAD(va, m + 2 * NGW); XN_DO(vb, m + NGW); } }
#undef XN_LOAD
#undef XN_DO
        }
        for (int it = gw; it < MTOK / 2; it += NGW) { const int row = 2 * it + (F.lane >> 5), i = F.lane & 31;
            const float freq = exp2f(-(float)i * (13.287712379549449f / 32.f)); const float ang = (float)positions[row] * freq;
            const double ad = (double)ang; const double k = __builtin_rint(ad * 0.15915494309189535); const float red = (float)(ad - k * 6.283185307179586);
            ROPE[(size_t)row * 32 + i] = __cosf(red); ROPE[(size_t)MTOK * 32 + (size_t)row * 32 + i] = __sinf(red); }
        for (int it = gw; it < (PHEADS * 2 * NKEYS * KD) / 512; it += NGW) { const size_t e = (size_t)it * 512 + 8 * F.lane; const f32x4 a = *(const f32x4*)(peer_keys + e), b = *(const f32x4*)(peer_keys + e + 4);
            v4u w; w.x = cvt_pk_bf16(a[0], a[1]); w.y = cvt_pk_bf16(a[2], a[3]); w.z = cvt_pk_bf16(b[0], b[1]); w.w = cvt_pk_bf16(b[2], b[3]); *(v4u*)(KEYS + e) = w; }
        for (int it = gw; it < (8 * 128 * 128) / 512; it += NGW) { const size_t e = (size_t)it * 512 + 8 * F.lane; const int t = (int)((e >> 7) & 127), s0 = (int)(e & 127);
            const f32x4 a = *(const f32x4*)(w_spatial + e), b = *(const f32x4*)(w_spatial + e + 4); float v[8] = {a[0], a[1], a[2], a[3], b[0], b[1], b[2], b[3]};
#pragma unroll
            for (int j = 0; j < 8; ++j) if (s0 + j > t) v[j] = 0.f;
            v4u w; w.x = cvt_pk_bf16(v[0], v[1]); w.y = cvt_pk_bf16(v[2], v[3]); w.z = cvt_pk_bf16(v[4], v[5]); w.w = cvt_pk_bf16(v[6], v[7]); *(v4u*)(WSP + e) = w; }
        for (size_t it = (size_t)gw * 64 + F.lane; it < (size_t)5 * MTOK; it += (size_t)NGW * 64) SQQ[it] = 0ull;
        GRID_BAR();
    }
    {
        PHASE_BEGIN();
        pg8::EpiIn E{0, IN8_DESCALE, U, GA, VG, CQKV, KR, b_gate, ROPE, SQQ, SQKV, SSUM, SSQ};
        { pg8::Gemm g{(const bf16*)XN8, (const bf16*)WIN8, MTOK, IN8_ROWS, D_MODEL / 2, D_MODEL / 2}; pg8::StaticOrder S; S.init(MTOK, IN8_ROWS, F.G, (int)blockIdx.x);
          pg8::gemm_phase<pg8::EpiIn, pg8::StaticOrder, true, true, true>(F.lds + RING_OFF, g, S, E, F.wave); }
        GRID_BAR();
    }
    {
        PHASE_BEGIN();
        { pg8::Gemm g{(const bf16*)CQKV, WUQ, MTOK, NQ_COLS, QL / 2, 512}; pg8::StaticOrder S; S.init(MTOK, NQ_COLS, F.G, (int)blockIdx.x);
          pg8::EpiQ E{Qb, SQQ, ROPE}; pg8::gemm_phase<pg8::EpiQ, pg8::StaticOrder, true, true, true>(F.lds + RING_OFF, g, S, E, F.wave); }
        { pg8::Gemm g{(const bf16*)(CQKV + QL), WUKV, MTOK, NKV_COLS, QL / 2, 512}; pg8::StaticOrder S; S.init(MTOK, NKV_COLS, F.G, (int)blockIdx.x);
          pg8::EpiKV E{Kb, Vb, SQKV}; pg8::gemm_phase<pg8::EpiKV, pg8::StaticOrder, true, true, true, true>(F.lds + RING_OFF, g, S, E, F.wave); }
        PHASE_BEGIN();
        for (int un = F.vcu; un < (MTOK / 128) * 8; un += F.G) sgu_unit(F, un, VG, U, WSP, sgu_ln_g, sgu_ln_b, b_spatial, SSUM, SSQ);
        GRID_BAR();
    }
    {
        PHASE_BEGIN();
        if (F.G == 256) { const int s = F.vcu & 7, bh = F.vcu >> 3;
#pragma unroll 1
            for (int i = 0; i < 4; ++i) { const int qb = (i == 0) ? s : (i == 1) ? 15 - s : (i == 2) ? 16 + s : 31 - s; att::attn_unit(bh, qb, Qb, Kb, KR, Vb, GA, U, (char*)lds + RING_OFF, F.lds + RING_OFF, F.wave); }
        } else {
#pragma unroll 1
            for (int un = F.vcu; un < 1024; un += F.G) att::attn_unit(un >> 5, 31 - (un & 31), Qb, Kb, KR, Vb, GA, U, (char*)lds + RING_OFF, F.lds + RING_OFF, F.wave);
        }
        GRID_BAR();
    }
    {
        PHASE_BEGIN();
        for (int it = gw * 64 + F.lane; it < MTOK; it += NGW * 64) SQQ[it] = 0ull;
        { f32x4 va[8], vb[8];
#pragma unroll 1
          for (int e = gw; e < NEXP; e += NGW) {
              if (e == gw) row8_load(va, peer_u + (size_t)e * D_MODEL, F.lane);
              row8_load(vb, peer_v + (size_t)e * D_MODEL, F.lane);
              row_to_fp8(va, PU, e, USC + e, F.lane, g_norm2);
              if (e + NGW < NEXP) row8_load(va, peer_u + (size_t)(e + NGW) * D_MODEL, F.lane);
              row_to_fp8(vb, PV, e, VSC + e, F.lane, nullptr); } }
        VM_WAIT(); __syncthreads();
        pg8::Gemm g{U, WOUT, MTOK, D_MODEL, D_MODEL, D_MODEL}; pg8::StaticOrder S; S.init(MTOK, D_MODEL, F.G, (int)blockIdx.x);
        pg8::EpiOut E{x, X1B, SQX1}; pg8::gemm_phase<pg8::EpiOut, pg8::StaticOrder, true, true>(F.lds + RING_OFF, g, S, E, F.wave);
        GRID_BAR();
    }
    {
        PHASE_BEGIN();
        pg8::Gemm g{X1B, WPQ, MTOK, D_MODEL, D_MODEL, D_MODEL}; pg8::StaticOrder S; S.init(MTOK, D_MODEL, F.G, (int)blockIdx.x);
        pg8::EpiPQ E{QP, SQX1}; pg8::gemm_phase<pg8::EpiPQ, pg8::StaticOrder, true, true>(F.lds + RING_OFF, g, S, E, F.wave);
        GRID_BAR();
    }
    {
        PHASE_BEGIN();
        { const int NH8 = (F.G % 8 == 0) ? 8 : 1, grp = (int)blockIdx.x % NH8, bi = (int)blockIdx.x / NH8, nbl = F.G / NH8;
#pragma unroll 1
          for (int h = grp; h < PHEADS; h += NH8) {
#pragma unroll
              for (int it = 0; it < 8; ++it) { const int id = it * 512 + F.tid, c = id & 15, n = (id >> 4) & 127, pp = id >> 11;
                  const v4u w = *(const v4u*)(KEYS + ((size_t)(h * 2 + pp) * NKEYS + n) * KD + 8 * c);
                  *(LAS v4u*)(F.lds + pp * 32768 + n * 256 + ((c ^ (n & 15)) << 4)) = w; }
              __syncthreads();
#pragma unroll 1
              for (int tg = bi * 8 + F.wave; tg < MTOK / 16; tg += nbl * 8) topk_unit(F, tg, h, QP, TOPI, TOPG);
              __syncthreads(); } }
        GRID_BAR();
    }
    {
        PHASE_BEGIN();
        const int NG = (F.G % 8 == 0) ? 8 : 1, grp = (int)blockIdx.x % NG, li = (int)blockIdx.x / NG, nl = F.G / NG;
        const int t0 = li * 8 + F.wave, ts = nl * 8, NTW = (MTOK - t0 + ts - 1) / ts;
#define LOAD_IDX(I, n) do { const int t_ = t0 + (n) * ts; I.i0 = __builtin_nontemporal_load(TOPI + (size_t)t_ * 128 + F.lane); I.i1 = __builtin_nontemporal_load(TOPI + (size_t)t_ * 128 + 64 + F.lane); } while (0)
#pragma unroll 1
        for (int sl = grp; sl < 16; sl += NG) {
            PeerIdx IA, IB; PeerRow RA, RB; v4u wA[16], wB[16];
            LOAD_IDX(IA, 0); pu_gather(t0, sl, F.lane, IA, wA, RA, X1B, PU); if (NTW > 1) LOAD_IDX(IB, 1);
#pragma unroll 1
            for (int n = 0; n < NTW; n += 2) {
                if (n + 2 < NTW) LOAD_IDX(IA, n + 2);
                if (n + 1 < NTW) pu_gather(t0 + (n + 1) * ts, sl, F.lane, IB, wB, RB, X1B, PU);
                pu_compute(t0 + n * ts, sl, F.lane, wA, RA, PART);
                if (n + 1 < NTW) {
                    if (n + 3 < NTW) LOAD_IDX(IB, n + 3);
                    if (n + 2 < NTW) pu_gather(t0 + (n + 2) * ts, sl, F.lane, IA, wA, RA, X1B, PU);
                    pu_compute(t0 + (n + 1) * ts, sl, F.lane, wB, RB, PART); }
            } }
#undef LOAD_IDX
        GRID_BAR();
#pragma unroll 1
        for (int t = gw; t < MTOK; t += NGW) peer_fin_token(t, F.lane, PART, TOPI, TOPG, USC, VSC, SQX1);
        GRID_BAR();
#define LOAD_IDXA(I, n) do { const int t_ = t0 + (n) * ts; I.i0 = __builtin_nontemporal_load(TOPI + (size_t)t_ * 128 + F.lane); I.i1 = __builtin_nontemporal_load(TOPI + (size_t)t_ * 128 + 64 + F.lane); \
            I.a0 = __builtin_nontemporal_load(TOPG + (size_t)t_ * 128 + F.lane); I.a1 = __builtin_nontemporal_load(TOPG + (size_t)t_ * 128 + 64 + F.lane); } while (0)
#pragma unroll 1
        for (int sl = grp; sl < 16; sl += NG) {
            PeerIdx IA, IB, IC; float xA[2], xB[2]; v4u wA[16], wB[16];
            LOAD_IDXA(IA, 0); pv_gather(t0, sl, F.lane, IA, wA, xA, X1B, PV); if (NTW > 1) LOAD_IDXA(IB, 1);
#pragma unroll 1
            for (int n = 0; n < NTW; n += 2) {
                if (n + 2 < NTW) LOAD_IDXA(IC, n + 2);
                if (n + 1 < NTW) pv_gather(t0 + (n + 1) * ts, sl, F.lane, IB, wB, xB, X1B, PV);
                pv_compute(t0 + n * ts, sl, F.lane, IA, wA, xA, X2, SQQ);
                IA = IC;
                if (n + 1 < NTW) {
                    if (n + 3 < NTW) LOAD_IDXA(IC, n + 3);
                    if (n + 2 < NTW) pv_gather(t0 + (n + 2) * ts, sl, F.lane, IA, wA, xA, X1B, PV);
                    pv_compute(t0 + (n + 1) * ts, sl, F.lane, IB, wB, xB, X2, SQQ);
                    IB = IC; }
            } }
#undef LOAD_IDXA
        GRID_BAR();
#pragma unroll 1
        for (int t = gw; t < MTOK; t += NGW) { const float rf = __builtin_amdgcn_rsqf(fx_get(SQQ + t) * (1.f / D_MODEL) + EPS);
            const f32x4* xr = (const f32x4*)(X2 + (size_t)t * D_MODEL) + F.lane; f32x4* orow = (f32x4*)(out + (size_t)t * D_MODEL) + F.lane;
#pragma unroll
            for (int j = 0; j < 8; ++j) { const f32x4 v = __builtin_nontemporal_load(xr + 64 * j), gg = *((const f32x4*)g_final + F.lane + 64 * j); f32x4 o4;
#pragma unroll
                for (int e = 0; e < 4; ++e) o4[e] = v[e] * rf * gg[e];
                __builtin_nontemporal_store(o4, orow + 64 * j); } }
    }
#undef GRID_BAR
}

extern "C" void kernel_launch(void* const* d_in, const int* in_sizes, int n_in, void* d_out, int out_size, void* d_ws, size_t ws_size, hipStream_t stream) {
    static int grid = 0;
    if (grid == 0) {
        if (n_in != 20 || in_sizes[0] != MTOK * D_MODEL || out_size != MTOK * D_MODEL || ws_size < WS_END) {
            fprintf(stderr, "kernel_launch: unexpected shapes (n_in %d, in0 %d, out %d, ws %zu); nothing launched\n", n_in, n_in > 0 ? in_sizes[0] : -1, out_size, ws_size); grid = -1; return; }
        int dev = 0, cus = 0;
        if (hipGetDevice(&dev) != hipSuccess || hipDeviceGetAttribute(&cus, hipDeviceAttributeMultiprocessorCount, dev) != hipSuccess) { fprintf(stderr, "kernel_launch: device query failed\n"); grid = -1; return; }
        if (hipFuncSetAttribute((const void*)mk_fwd, hipFuncAttributeMaxDynamicSharedMemorySize, LDS_BYTES) != hipSuccess) { fprintf(stderr, "kernel_launch: hipFuncSetAttribute failed\n"); grid = -1; return; }
        (void)hipGetLastError();
        grid = cus;
    }
    if (grid < 0) return;
    (void)hipMemsetAsync((char*)d_ws + WS_CTL, 0, CTL_ZERO_BYTES, stream);
    Args a{};
    for (int i = 0; i < 20; ++i) a.in[i] = (const float*)d_in[i];
    a.out = (float*)d_out; a.ws = (unsigned char*)d_ws;
    hipLaunchKernelGGL(mk_fwd, dim3(grid), dim3(512), LDS_BYTES, stream, a);
    const hipError_t le = hipPeekAtLastError();
    if (le != hipSuccess) fprintf(stderr, "kernel_launch: launch failed: %s\n", hipGetErrorName(le));
}
```

```cpp
#include <hip/hip_runtime.h>
#include <hip/hip_bf16.h>
#include <cstdio>
#include <cstdint>


constexpr int D_MODEL = 2048, NB = 2, SEQL = 8192, MTOK = NB * SEQL;
constexpr int NHEAD = 16, QL = 512, DN = 128, DR = 64, DVH = 128, DQK = 192;
constexpr int IN_COLS = 9280, IN16_ROWS = 2048, IN8_ROWS = 9472;
constexpr float Q8_SCALE = 64.f, K8_SCALE = 8.f, V8_SCALE = 8.f;
constexpr float XN8_SCALE = 8.f, WIN8_SCALE = 64.f, IN8_DESCALE = 1.f / 512.f;
constexpr int NQ_COLS = NHEAD * DQK, NKV_COLS = NHEAD * (DN + DVH);
constexpr int PHEADS = 8, NKEYS = 128, TOPK = 16, KD = 128, NEXP = 16384;
constexpr float EPS = 1e-6f;
constexpr float FXS = 16777216.f, FXI = 1.f / 16777216.f;
constexpr float C2Q = 0.07216878364870322f * 1.4426950408889634f;

constexpr size_t MiB = 1u << 20;
constexpr size_t WS_CTL = 0, CTL_ZERO_BYTES = 32 * 1024;
constexpr size_t WS_KEYS = 1 * MiB, WS_WSP = 1 * MiB + 512 * 1024;
constexpr size_t WS_WUQ = 2 * MiB, WS_WUKV = 5 * MiB, WS_WOUT = 9 * MiB, WS_WPQ = 17 * MiB;
constexpr size_t WS_ROPE = 27 * MiB;
constexpr size_t WS_WIN8 = 46 * MiB;
constexpr size_t WS_XN8 = 66 * MiB;
constexpr size_t WS_Q = 32 * MiB;
constexpr size_t WS_CQKV = 128 * MiB;
constexpr size_t WS_U = 160 * MiB;
constexpr size_t WS_VG = 224 * MiB;
constexpr size_t WS_GA = 288 * MiB;
constexpr size_t WS_V = 352 * MiB;
constexpr size_t WS_K = 416 * MiB;
constexpr size_t WS_KR = 504 * MiB;
constexpr size_t WS_X2 = 288 * MiB;
constexpr size_t WS_X1B = 96 * MiB;
constexpr size_t WS_PU = 32 * MiB, WS_PV = 64 * MiB;
constexpr size_t WS_PART = 288 * MiB;
constexpr size_t WS_PSC = 31 * MiB;
constexpr size_t WS_QP = 224 * MiB;
constexpr size_t WS_TOPI = 480 * MiB, WS_TOPG = 488 * MiB;
constexpr size_t WS_END = 512 * MiB;
constexpr int CW_BAR = 4096;
constexpr size_t CTL_STATS = 128 * 1024;
constexpr int RING_OFF = 0, RING_BYTES = 131072;
constexpr int LDSCTL_OFF = RING_BYTES, MISC_OFF = LDSCTL_OFF + 320;
constexpr int LDS_BYTES = 147456;

#define GAS __attribute__((address_space(1)))
#define LAS __attribute__((address_space(3)))
typedef unsigned short bf16;
typedef unsigned v4u __attribute__((ext_vector_type(4)));
typedef unsigned v2u __attribute__((ext_vector_type(2)));
typedef float f32x4 __attribute__((ext_vector_type(4)));
typedef float f32x16 __attribute__((ext_vector_type(16)));
typedef short bf16x8 __attribute__((ext_vector_type(8)));
typedef short s16x4 __attribute__((ext_vector_type(4)));
typedef int v8i __attribute__((ext_vector_type(8)));
typedef unsigned long long u64;
#define LDS_WAIT() asm volatile("s_waitcnt lgkmcnt(0)" ::: "memory")
#define VM_WAIT() asm volatile("s_waitcnt vmcnt(0)" ::: "memory")
#define SBAR() __builtin_amdgcn_sched_barrier(0)

typedef float f32x2_t __attribute__((ext_vector_type(2))); typedef __bf16 bf16x2_t __attribute__((ext_vector_type(2)));
__device__ __forceinline__ unsigned cvt_pk_bf16(float lo, float hi) { f32x2_t v = {lo, hi}; bf16x2_t b = __builtin_convertvector(v, bf16x2_t); return __builtin_bit_cast(unsigned, b); }
__device__ __forceinline__ unsigned pack_fp8x4(f32x4 v) {
    v = __builtin_elementwise_min(__builtin_elementwise_max(v, (f32x4){-448.f, -448.f, -448.f, -448.f}), (f32x4){448.f, 448.f, 448.f, 448.f});
    int p = 0; p = __builtin_amdgcn_cvt_pk_fp8_f32(v[0], v[1], p, false); p = __builtin_amdgcn_cvt_pk_fp8_f32(v[2], v[3], p, true); return (unsigned)p; }
__device__ __forceinline__ float bf_lo(unsigned w) { return __uint_as_float(w << 16); }
__device__ __forceinline__ float bf_hi(unsigned w) { return __uint_as_float(w & 0xffff0000u); }
__device__ __forceinline__ float gelu_t(float x) { const float t = x * (1.f + 0.044715f * x * x); const float e = __builtin_amdgcn_exp2f(-2.3022081986f * t); return x * __builtin_amdgcn_rcpf(1.f + e); }
__device__ __forceinline__ float sigmoid_f(float y) { return __builtin_amdgcn_rcpf(1.f + __builtin_amdgcn_exp2f(-1.4426950409f * y)); }
__device__ __forceinline__ void fx_add(u64* p, float v) { const long long q = __float2ll_rn(v * FXS); atomicAdd(p, (u64)q); }
__device__ __forceinline__ float fx_get(const u64* p) { return (float)((double)(long long)(*p) * (double)FXI); }
__device__ __forceinline__ int lane_id() { int l; asm volatile("v_mbcnt_lo_u32_b32 %0, -1, 0\n\tv_mbcnt_hi_u32_b32 %0, -1, %0" : "=v"(l)); return l; }

__device__ __forceinline__ float shx(float v, int o, int lane) { return __builtin_bit_cast(float, __builtin_amdgcn_ds_bpermute((lane ^ o) << 2, __builtin_bit_cast(int, v))); }
__device__ __forceinline__ float wave_sum(float v, int lane) {
#pragma unroll
    for (int o = 1; o < 64; o <<= 1) v += shx(v, o, lane);
    return v;
}

namespace pg8 {
#define PG8_LAS __attribute__((address_space(3)))
typedef unsigned short bf16_t;
constexpr int BM = 256, BK = 64, HALF = 128, HTB = HALF * BK * 2, STAGE_BYTES = 8 * HTB, NXCD = 8, WGM = 8;
__host__ __device__ __forceinline__ int lds_byte(int r, int c) { const int st = (r >> 4) * 2 + (c >> 5), rr = r & 15, cc = c & 31, ob = rr * 64 + cc * 2; return st * 1024 + (ob ^ (((ob >> 9) & 1) << 5)); }
__host__ __device__ __forceinline__ void stage_rc(int b, int& R, int& C) { const int st = b / 1024, sb = b % 1024, swz = sb ^ (((sb >> 9) & 1) << 5); R = (st >> 1) * 16 + swz / 64; C = (st & 1) * 32 + (swz % 64) / 2; }
__host__ __device__ __forceinline__ int perm32(int rho) { const int n = rho >> 4, i = rho & 15; return 8 * (i >> 2) + 4 * n + (i & 3); }
struct Unit { int pm, pn; };
struct Gemm { const bf16_t* A; const bf16_t* Bt; int M, N, K, lda; };
struct StaticOrder {
    int nM, nN, nwg, G, c;
    __host__ __device__ void init(int M, int N, int G_, int c_) { nM = M / BM; nN = N / BM; nwg = nM * nN; G = G_; c = c_; }
    __host__ __device__ bool next(int i, Unit& u) const {
        const long L = (long)i * G + c; if (L >= nwg) return false;
        int wgid = (int)L; { const int q = nwg / NXCD, r = nwg % NXCD, xcd = wgid % NXCD, off = wgid / NXCD; wgid = (xcd < r ? xcd * (q + 1) : r * (q + 1) + (xcd - r) * q) + off; }
        const int nig = WGM * nN, gid = wgid / nig, fm = gid * WGM, gsz = (nM - fm) < WGM ? (nM - fm) : WGM;
        u.pm = fm + ((wgid % nig) % gsz); u.pn = (wgid % nig) / gsz; return true;
    }
};
template <class Epi, class Sched, bool ALIGN_EPI = false, bool SP2 = false, bool F8 = false, bool SWAP1 = false>
__device__ __forceinline__ void gemm_phase(PG8_LAS unsigned char* lds, const Gemm g, const Sched& S, const Epi& E, const int wave) {
    int tid = wave * 64 + lane_id(); asm volatile("" : "+v"(tid));
    const int wid = __builtin_amdgcn_readfirstlane(tid >> 6), lane = tid & 63, wr = wid >> 2, wc = wid & 3, fr = lane & 15, fq = lane >> 4;
    const int K = g.K, nt = K / BK, lda = g.lda;
    unsigned voffA[2], voffB[2];
#pragma unroll
    for (int i = 0; i < 2; ++i) { int R, C; stage_rc(tid * 16 + i * 8192, R, C); const int Rb = Epi::PERM ? ((R & ~31) + perm32(R & 31)) : R;
        voffA[i] = (unsigned)(R * lda + C) * 2u; voffB[i] = (unsigned)(Rb * K + C) * 2u; }
    const size_t kstep = (size_t)(BK * 2);
    const size_t hstepA = (size_t)HALF * lda * 2, hstepB = (size_t)HALF * K * 2;
    const size_t tstepA = 2 * hstepA, tstepB = 2 * hstepB;
    const unsigned ldsw = (unsigned)wid * 1024u;
    const int aoff = lds_byte(wr * 64 + fr, fq * 8), boff = lds_byte(wc * 32 + fr, fq * 8);
#define PG8_SA(b, h) (((b) * 2 + (h)) * HTB)
#define PG8_SB(b, h) ((4 + (b) * 2 + (h)) * HTB)
#define PG8_STAGE(bufoff, gbase, voff) do { _Pragma("unroll") for (int _i = 0; _i < 2; ++_i) \
        { unsigned vo_ = (voff)[_i]; asm volatile("" : "+v"(vo_)); __builtin_amdgcn_global_load_lds((const unsigned*)((const char*)(gbase) + vo_), (PG8_LAS unsigned*)(lds + (bufoff) + ldsw + _i * 8192), 16, 0, 0); } } while (0)
#define PG8_LDA(dst, b, h) do { _Pragma("unroll") for (int m = 0; m < 4; ++m) _Pragma("unroll") for (int k = 0; k < 2; ++k) dst[m][k] = *(const PG8_LAS bf16x8*)(lds + PG8_SA(b, h) + aoff + m * 2048 + k * 1024); } while (0)
#define PG8_LDB(dst, b, h) do { _Pragma("unroll") for (int n = 0; n < 2; ++n) _Pragma("unroll") for (int k = 0; k < 2; ++k) dst[n][k] = *(const PG8_LAS bf16x8*)(lds + PG8_SB(b, h) + boff + n * 2048 + k * 1024); } while (0)
#define PG8_CAT(x) __builtin_bit_cast(v8i, __builtin_shufflevector((x)[0], (x)[1], 0, 1, 2, 3, 4, 5, 6, 7, 8, 9, 10, 11, 12, 13, 14, 15))
#define PG8_MMA(ai, bj, At, Bt) do { __builtin_amdgcn_s_setprio(1); _Pragma("unroll") for (int m = 0; m < 4; ++m) _Pragma("unroll") for (int n = 0; n < 2; ++n) { \
        if constexpr (F8 && SWAP1 && (bj) == 1) acc[ai][bj][m][n] = __builtin_amdgcn_mfma_scale_f32_16x16x128_f8f6f4(PG8_CAT(At[m]), PG8_CAT(Bt[n]), acc[ai][bj][m][n], 0, 0, 0, 0x7f7f7f7f, 0, 0x7f7f7f7f); \
        else if constexpr (F8) acc[ai][bj][m][n] = __builtin_amdgcn_mfma_scale_f32_16x16x128_f8f6f4(PG8_CAT(Bt[n]), PG8_CAT(At[m]), acc[ai][bj][m][n], 0, 0, 0, 0x7f7f7f7f, 0, 0x7f7f7f7f); \
        else { _Pragma("unroll") for (int k = 0; k < 2; ++k) acc[ai][bj][m][n] = __builtin_amdgcn_mfma_f32_16x16x32_bf16(Bt[n][k], At[m][k], acc[ai][bj][m][n], 0, 0, 0); } } __builtin_amdgcn_s_setprio(0); } while (0)
#define PG8_WAIT_V(n) asm volatile("s_waitcnt vmcnt(" #n ")" ::: "memory")
#define PG8_WAIT_L(n) asm volatile("s_waitcnt lgkmcnt(" #n ")" ::: "memory")
#define PG8_BAR __builtin_amdgcn_s_barrier()
#define PG8_SCHED __builtin_amdgcn_sched_barrier(0)
    Unit cur, nxt; int ui = 0;
    if (!S.next(0, cur)) return;
    f32x4 acc[2][2][4][2];
#pragma unroll
    for (int a = 0; a < 2; ++a)
#pragma unroll
        for (int b = 0; b < 2; ++b)
#pragma unroll
            for (int m = 0; m < 4; ++m)
#pragma unroll
                for (int n = 0; n < 2; ++n) acc[a][b][m][n] = (f32x4){0.f, 0.f, 0.f, 0.f};
    bf16x8 At[4][2], B0[2][2], B1[2][2];
    const char* cA = (const char*)g.A + (size_t)cur.pm * tstepA; const char* cB = (const char*)g.Bt + (size_t)cur.pn * tstepB;
    if constexpr (SP2) {
        PG8_STAGE(PG8_SB(0, 0), cB, voffB); PG8_STAGE(PG8_SB(0, 1), cB + hstepB, voffB); PG8_STAGE(PG8_SA(0, 0), cA, voffA); PG8_STAGE(PG8_SA(0, 1), cA + hstepA, voffA);
        if (wr == 1) PG8_BAR;
        PG8_WAIT_V(2); PG8_BAR;
        PG8_STAGE(PG8_SB(1, 0), cB + kstep, voffB); PG8_STAGE(PG8_SA(1, 0), cA + kstep, voffA); PG8_STAGE(PG8_SB(1, 1), cB + hstepB + kstep, voffB);
        PG8_WAIT_V(6); PG8_BAR;
    } else {
        PG8_STAGE(PG8_SB(0, 0), cB, voffB); PG8_STAGE(PG8_SA(0, 0), cA, voffA); PG8_STAGE(PG8_SB(0, 1), cB + hstepB, voffB); PG8_STAGE(PG8_SA(0, 1), cA + hstepA, voffA);
        if (wr == 1) PG8_BAR;
        PG8_WAIT_V(4); PG8_BAR;
        PG8_STAGE(PG8_SB(1, 0), cB + kstep, voffB); PG8_STAGE(PG8_SA(1, 0), cA + kstep, voffA); PG8_STAGE(PG8_SB(1, 1), cB + hstepB + kstep, voffB);
        PG8_WAIT_V(6); PG8_BAR;
    }
    for (;;) {
        const bool has_next = S.next(ui + 1, nxt);
        const char* nA = has_next ? (const char*)g.A + (size_t)nxt.pm * tstepA : cA; const char* nB = has_next ? (const char*)g.Bt + (size_t)nxt.pn * tstepB : cB;
#pragma unroll 1
        for (int t = 0; t < nt; t += 2) {
            const bool last = (t == nt - 2);
            const char* a1 = cA + (size_t)(t + 1) * kstep;
            const char* a2 = last ? nA : cA + (size_t)(t + 2) * kstep; const char* b2 = last ? nB : cB + (size_t)(t + 2) * kstep;
            const char* a3 = a2 + kstep; const char* b3 = b2 + kstep;
            if constexpr (SP2) {
            PG8_LDB(B0, 0, 0); PG8_LDB(B1, 0, 1); PG8_SCHED; PG8_LDA(At, 0, 0); PG8_STAGE(PG8_SA(1, 1), a1 + hstepA, voffA);
            PG8_WAIT_V(8); PG8_WAIT_L(0); PG8_BAR; PG8_MMA(0, 0, At, B0); PG8_MMA(0, 1, At, B1); PG8_BAR; PG8_SCHED;
            PG8_LDA(At, 0, 1); PG8_STAGE(PG8_SB(0, 0), b2, voffB); PG8_STAGE(PG8_SB(0, 1), b2 + hstepB, voffB); PG8_STAGE(PG8_SA(0, 0), a2, voffA);
            PG8_WAIT_V(8); PG8_WAIT_L(0); PG8_BAR; PG8_MMA(1, 0, At, B0); PG8_MMA(1, 1, At, B1); PG8_BAR; PG8_SCHED;
            PG8_LDB(B0, 1, 0); PG8_LDB(B1, 1, 1); PG8_SCHED; PG8_LDA(At, 1, 0); PG8_STAGE(PG8_SA(0, 1), a2 + hstepA, voffA);
            PG8_WAIT_V(8); PG8_WAIT_L(0); PG8_BAR; PG8_MMA(0, 0, At, B0); PG8_MMA(0, 1, At, B1); PG8_BAR; PG8_SCHED;
            PG8_LDA(At, 1, 1); PG8_STAGE(PG8_SB(1, 0), b3, voffB); PG8_STAGE(PG8_SB(1, 1), b3 + hstepB, voffB); PG8_STAGE(PG8_SA(1, 0), a3, voffA);
            PG8_WAIT_V(8); PG8_WAIT_L(0); PG8_BAR; PG8_MMA(1, 0, At, B0); PG8_MMA(1, 1, At, B1); PG8_BAR; PG8_SCHED;
            } else {
            PG8_LDB(B0, 0, 0); PG8_SCHED; PG8_LDA(At, 0, 0); PG8_STAGE(PG8_SA(1, 1), a1 + hstepA, voffA);
            PG8_WAIT_L(8); PG8_BAR; PG8_WAIT_L(0); PG8_MMA(0, 0, At, B0); PG8_BAR; PG8_SCHED;
            PG8_LDB(B1, 0, 1); PG8_STAGE(PG8_SB(0, 0), b2, voffB);
            PG8_BAR; PG8_WAIT_L(0); PG8_MMA(0, 1, At, B1); PG8_BAR;
            PG8_LDA(At, 0, 1); PG8_STAGE(PG8_SA(0, 0), a2, voffA);
            PG8_BAR; PG8_WAIT_L(0); PG8_MMA(1, 0, At, B0); PG8_BAR; PG8_SCHED;
            PG8_STAGE(PG8_SB(0, 1), b2 + hstepB, voffB);
            PG8_WAIT_V(6); PG8_BAR; PG8_MMA(1, 1, At, B1); PG8_BAR;
            PG8_LDB(B0, 1, 0); PG8_SCHED; PG8_LDA(At, 1, 0); PG8_STAGE(PG8_SA(0, 1), a2 + hstepA, voffA);
            PG8_WAIT_L(8); PG8_BAR; PG8_WAIT_L(0); PG8_MMA(0, 0, At, B0); PG8_BAR; PG8_SCHED;
            PG8_LDB(B1, 1, 1); PG8_STAGE(PG8_SB(1, 0), b3, voffB);
            PG8_BAR; PG8_WAIT_L(0); PG8_MMA(0, 1, At, B1); PG8_BAR;
            PG8_LDA(At, 1, 1); PG8_STAGE(PG8_SA(1, 0), a3, voffA);
            PG8_BAR; PG8_WAIT_L(0); PG8_MMA(1, 0, At, B0); PG8_BAR; PG8_SCHED;
            PG8_STAGE(PG8_SB(1, 1), b3 + hstepB, voffB);
            PG8_WAIT_V(6); PG8_BAR; PG8_MMA(1, 1, At, B1); PG8_BAR;
            }
        }
        if constexpr (ALIGN_EPI) { if (wr == 0) PG8_BAR; }
        { const int le = lane_id(); E(acc, cur, wr, wc, le & 15, le >> 4); }
        if (!has_next) break;
#pragma unroll
        for (int a = 0; a < 2; ++a)
#pragma unroll
            for (int b = 0; b < 2; ++b)
#pragma unroll
                for (int m = 0; m < 4; ++m)
#pragma unroll
                    for (int n = 0; n < 2; ++n) acc[a][b][m][n] = (f32x4){0.f, 0.f, 0.f, 0.f};
        cur = nxt; cA = nA; cB = nB; ++ui;
        if constexpr (ALIGN_EPI) { if (wr == 1) PG8_BAR; }
    }
    PG8_WAIT_V(0);
    if constexpr (!ALIGN_EPI) { if (wr == 0) PG8_BAR; }
    PG8_BAR;
#undef PG8_SA
#undef PG8_SB
#undef PG8_STAGE
#undef PG8_LDA
#undef PG8_LDB
#undef PG8_MMA
#undef PG8_CAT
#undef PG8_WAIT_V
#undef PG8_WAIT_L
#undef PG8_BAR
#undef PG8_SCHED
}

#define EPI_ROWS(ai, m) (u.pm * BM + wr * 64 + fr + (ai) * HALF + (m) * 16)
struct EpiIn {
    static constexpr bool PERM = true;
    int mode; float sc;
    bf16_t *U, *GA, *VG; unsigned char *CQKV, *KR; const float* bgate; const float* rope; u64 *sqq, *sqkv, *ssum, *ssq;
    __device__ __forceinline__ void operator()(const f32x4 (&acc)[2][2][4][2], const Unit& u, int wr, int wc, int fr, int fq) const {
        const int pn = u.pn, cw = wc * 32 + 8 * fq;
        if (mode == 1 || pn >= 29) {
            const int c0 = (mode == 1 ? pn : pn - 29) * 256 + cw;
#pragma unroll
            for (int ai = 0; ai < 2; ++ai)
#pragma unroll
                for (int m = 0; m < 4; ++m) { const int row = EPI_ROWS(ai, m); float s = 0.f, q = 0.f;
#pragma unroll
                    for (int bj = 0; bj < 2; ++bj) { f32x4 v0 = acc[ai][bj][m][0] * sc, v1 = acc[ai][bj][m][1] * sc;
#pragma unroll
                        for (int e = 0; e < 4; ++e) { v0[e] = gelu_t(v0[e]); v1[e] = gelu_t(v1[e]); }
                        s += (v0[0] + v0[1]) + (v0[2] + v0[3]) + (v1[0] + v1[1]) + (v1[2] + v1[3]);
                        q += (v0[0] * v0[0] + v0[1] * v0[1]) + (v0[2] * v0[2] + v0[3] * v0[3]) + (v1[0] * v1[0] + v1[1] * v1[1]) + (v1[2] * v1[2] + v1[3] * v1[3]);
                        v4u w; w.x = cvt_pk_bf16(v0[0], v0[1]); w.y = cvt_pk_bf16(v0[2], v0[3]); w.z = cvt_pk_bf16(v1[0], v1[1]); w.w = cvt_pk_bf16(v1[2], v1[3]);
                        __builtin_nontemporal_store(w, (v4u*)(VG + (size_t)row * 2048 + c0 + bj * HALF)); }
                    s += shx(s, 16, fq * 16 + fr); s += shx(s, 32, fq * 16 + fr); q += shx(q, 16, fq * 16 + fr); q += shx(q, 32, fq * 16 + fr);
                    if (fq == 0) { fx_add(ssum + row, s); fx_add(ssq + row, q); } }
        } else if (pn < 16) {
            const int c0 = pn * 128 + cw; const float* bg = bgate + 2048 + c0;
            const f32x4 b0 = *(const f32x4*)bg, b1 = *(const f32x4*)(bg + 4);
#pragma unroll
            for (int ai = 0; ai < 2; ++ai)
#pragma unroll
                for (int m = 0; m < 4; ++m) { const int row = EPI_ROWS(ai, m);
                    f32x4 v0 = acc[ai][0][m][0] * sc, v1 = acc[ai][0][m][1] * sc; const f32x4 g0 = acc[ai][1][m][0] * sc + b0, g1 = acc[ai][1][m][1] * sc + b1;
#pragma unroll
                    for (int e = 0; e < 4; ++e) { v0[e] = gelu_t(v0[e]) * sigmoid_f(g0[e]); v1[e] = gelu_t(v1[e]) * sigmoid_f(g1[e]); }
                    v4u w; w.x = cvt_pk_bf16(v0[0], v0[1]); w.y = cvt_pk_bf16(v0[2], v0[3]); w.z = cvt_pk_bf16(v1[0], v1[1]); w.w = cvt_pk_bf16(v1[2], v1[3]);
                    __builtin_nontemporal_store(w, (v4u*)(U + (size_t)row * 2048 + c0)); }
        } else if (pn < 24) {
            const int c0 = (pn - 16) * 256 + cw; const float* bg = bgate + c0;
            f32x4 bv[2][2];
#pragma unroll
            for (int bj = 0; bj < 2; ++bj) { bv[bj][0] = *(const f32x4*)(bg + bj * HALF); bv[bj][1] = *(const f32x4*)(bg + bj * HALF + 4); }
#pragma unroll
            for (int ai = 0; ai < 2; ++ai)
#pragma unroll
                for (int m = 0; m < 4; ++m) { const int row = EPI_ROWS(ai, m);
#pragma unroll
                    for (int bj = 0; bj < 2; ++bj) { f32x4 v0 = acc[ai][bj][m][0] * sc + bv[bj][0], v1 = acc[ai][bj][m][1] * sc + bv[bj][1];
#pragma unroll
                        for (int e = 0; e < 4; ++e) { v0[e] = sigmoid_f(v0[e]); v1[e] = sigmoid_f(v1[e]); }
                        v4u w; w.x = cvt_pk_bf16(v0[0], v0[1]); w.y = cvt_pk_bf16(v0[2], v0[3]); w.z = cvt_pk_bf16(v1[0], v1[1]); w.w = cvt_pk_bf16(v1[2], v1[3]);
                        __builtin_nontemporal_store(w, (v4u*)(GA + (size_t)row * 2048 + c0 + bj * HALF)); } }
        } else if (pn < 28) {
            const int pc = pn - 24; u64* sq = pc < 2 ? sqq : sqkv;
#pragma unroll
            for (int ai = 0; ai < 2; ++ai)
#pragma unroll
                for (int m = 0; m < 4; ++m) { const int row = EPI_ROWS(ai, m); float s = 0.f;
#pragma unroll
                    for (int bj = 0; bj < 2; ++bj) { const f32x4 v0 = acc[ai][bj][m][0] * sc, v1 = acc[ai][bj][m][1] * sc;
                        s += (v0[0] * v0[0] + v0[1] * v0[1]) + (v0[2] * v0[2] + v0[3] * v0[3]) + (v1[0] * v1[0] + v1[1] * v1[1]) + (v1[2] * v1[2] + v1[3] * v1[3]);
                        v2u w; w.x = pack_fp8x4(v0 * XN8_SCALE); w.y = pack_fp8x4(v1 * XN8_SCALE);
                        *(v2u*)(CQKV + (size_t)row * 1024 + pc * 256 + bj * HALF + cw) = w; }
                    s += shx(s, 16, fq * 16 + fr); s += shx(s, 32, fq * 16 + fr);
                    if (fq == 0) fx_add(sq + row, s); }
        } else {
            if (wc < 2) {
                const int i0 = cw >> 1;
#pragma unroll
                for (int ai = 0; ai < 2; ++ai)
#pragma unroll
                    for (int m = 0; m < 4; ++m) { const int row = EPI_ROWS(ai, m);
                        const f32x4 c4 = *(const f32x4*)(rope + (size_t)row * 32 + i0), s4 = *(const f32x4*)(rope + (size_t)MTOK * 32 + (size_t)row * 32 + i0);
                        const f32x4 v0 = acc[ai][0][m][0] * sc, v1 = acc[ai][0][m][1] * sc;
                        const f32x4 r0 = {v0[0] * c4[0] - v0[1] * s4[0], v0[0] * s4[0] + v0[1] * c4[0], v0[2] * c4[1] - v0[3] * s4[1], v0[2] * s4[1] + v0[3] * c4[1]};
                        const f32x4 r1 = {v1[0] * c4[2] - v1[1] * s4[2], v1[0] * s4[2] + v1[1] * c4[2], v1[2] * c4[3] - v1[3] * s4[3], v1[2] * s4[3] + v1[3] * c4[3]};
                        v2u w; w.x = pack_fp8x4(r0 * K8_SCALE); w.y = pack_fp8x4(r1 * K8_SCALE);
                        *(v2u*)(KR + (size_t)row * DR + cw) = w; }
            }
        }
    }
};
struct EpiQ {
    static constexpr bool PERM = true;
    unsigned char* Q; const u64* sqq; const float* rope;
    __device__ __forceinline__ void operator()(const f32x4 (&acc)[2][2][4][2], const Unit& u, int wr, int wc, int fr, int fq) const {
        const int cw = wc * 32 + 8 * fq;
#pragma unroll
        for (int ai = 0; ai < 2; ++ai)
#pragma unroll
            for (int m = 0; m < 4; ++m) { const int row = EPI_ROWS(ai, m); const int b = row >> 13, s = row & 8191;
                const float rq = __builtin_amdgcn_rsqf(fx_get(sqq + row) * (1.f / QL) + EPS) * (C2Q * IN8_DESCALE * Q8_SCALE);
#pragma unroll
                for (int bj = 0; bj < 2; ++bj) { const int colg = u.pn * 256 + bj * HALF + cw; const int head = colg / DQK, dd = colg - head * DQK;
                    f32x4 v0 = acc[ai][bj][m][0] * rq, v1 = acc[ai][bj][m][1] * rq;
                    if (dd >= DN) { const int i0 = (dd - DN) >> 1;
                        const f32x4 c4 = *(const f32x4*)(rope + (size_t)row * 32 + i0), s4 = *(const f32x4*)(rope + (size_t)MTOK * 32 + (size_t)row * 32 + i0);
                        const f32x4 r0 = {v0[0] * c4[0] - v0[1] * s4[0], v0[0] * s4[0] + v0[1] * c4[0], v0[2] * c4[1] - v0[3] * s4[1], v0[2] * s4[1] + v0[3] * c4[1]};
                        const f32x4 r1 = {v1[0] * c4[2] - v1[1] * s4[2], v1[0] * s4[2] + v1[1] * c4[2], v1[2] * c4[3] - v1[3] * s4[3], v1[2] * s4[3] + v1[3] * c4[3]};
                        v0 = r0; v1 = r1; }
                    v2u w; w.x = pack_fp8x4(v0); w.y = pack_fp8x4(v1);
                    *(v2u*)(Q + ((size_t)(b * NHEAD + head) * SEQL + s) * DQK + dd) = w; } }
    }
};
struct EpiKV {
    static constexpr bool PERM = true;
    unsigned char* Kb; unsigned char* Vt; const u64* sqkv;
    __device__ __forceinline__ void operator()(const f32x4 (&acc)[2][2][4][2], const Unit& u, int wr, int wc, int fr, int fq) const {
        const int cw = wc * 32 + 8 * fq, head = u.pn;
#pragma unroll
        for (int ai = 0; ai < 2; ++ai)
#pragma unroll
            for (int m = 0; m < 4; ++m) {
                { const int row = EPI_ROWS(ai, m); const int b = row >> 13, s = row & 8191;
                  const float rk = __builtin_amdgcn_rsqf(fx_get(sqkv + row) * (1.f / QL) + EPS) * (IN8_DESCALE * K8_SCALE); const size_t tr = (size_t)(b * NHEAD + head) * SEQL + s;
                  v2u w; w.x = pack_fp8x4(acc[ai][0][m][0] * rk); w.y = pack_fp8x4(acc[ai][0][m][1] * rk); *(v2u*)(Kb + tr * DN + cw) = w; }
                { const int row0 = u.pm * BM + wr * 64 + ai * HALF + m * 16 + 4 * fq; const int b = row0 >> 13, s0 = row0 & 8191;
                  f32x4 rk4;
#pragma unroll
                  for (int e = 0; e < 4; ++e) rk4[e] = __builtin_amdgcn_rsqf(fx_get(sqkv + row0 + e) * (1.f / QL) + EPS) * (IN8_DESCALE * V8_SCALE);
                  const int slot = (s0 & ~63) + 32 * (fq & 1) + 4 * (2 * m + (fq >> 1));
#pragma unroll
                  for (int n = 0; n < 2; ++n) { const int dv = wc * 32 + 8 * (fr >> 2) + 4 * n + (fr & 3);
                      *(unsigned*)(Vt + ((size_t)(b * NHEAD + head) * DVH + dv) * SEQL + slot) = pack_fp8x4(acc[ai][1][m][n] * rk4); } }
            }
    }
};
struct EpiOut {
    static constexpr bool PERM = false;
    const float* x; bf16_t* X1B; u64* sqx;
    __device__ __forceinline__ void operator()(const f32x4 (&acc)[2][2][4][2], const Unit& u, int wr, int wc, int fr, int fq) const {
        const int col0 = u.pn * BM + wc * 32 + 4 * fq;
#pragma unroll
        for (int ai = 0; ai < 2; ++ai)
#pragma unroll
            for (int m = 0; m < 4; ++m) { const int row = EPI_ROWS(ai, m); float s = 0.f;
#pragma unroll
                for (int bj = 0; bj < 2; ++bj)
#pragma unroll
                    for (int n = 0; n < 2; ++n) { const size_t off = (size_t)row * D_MODEL + col0 + bj * HALF + n * 16;
                        const f32x4 v = *(const f32x4*)(x + off) + acc[ai][bj][m][n];
                        s += (v[0] * v[0] + v[1] * v[1]) + (v[2] * v[2] + v[3] * v[3]);
                        v2u w; w.x = cvt_pk_bf16(v[0], v[1]); w.y = cvt_pk_bf16(v[2], v[3]); *(v2u*)(X1B + off) = w; }
                s += shx(s, 16, fq * 16 + fr); s += shx(s, 32, fq * 16 + fr);
                if (fq == 0) fx_add(sqx + row, s); }
    }
};
struct EpiPQ {
    static constexpr bool PERM = true;
    bf16_t* QP; const u64* sqx;
    __device__ __forceinline__ void operator()(const f32x4 (&acc)[2][2][4][2], const Unit& u, int wr, int wc, int fr, int fq) const {
        const int cw = u.pn * 256 + wc * 32 + 8 * fq;
#pragma unroll
        for (int ai = 0; ai < 2; ++ai)
#pragma unroll
            for (int m = 0; m < 4; ++m) { const int row = EPI_ROWS(ai, m);
                const float r2 = __builtin_amdgcn_rsqf(fx_get(sqx + row) * (1.f / D_MODEL) + EPS);
#pragma unroll
                for (int bj = 0; bj < 2; ++bj) { const f32x4 v0 = acc[ai][bj][m][0] * r2, v1 = acc[ai][bj][m][1] * r2;
                    v4u w; w.x = cvt_pk_bf16(v0[0], v0[1]); w.y = cvt_pk_bf16(v0[2], v0[3]); w.z = cvt_pk_bf16(v1[0], v1[1]); w.w = cvt_pk_bf16(v1[2], v1[3]);
                    __builtin_nontemporal_store(w, (v4u*)(QP + (size_t)row * D_MODEL + cw + bj * HALF)); } }
    }
};
#undef EPI_ROWS
}

typedef GAS unsigned gu32;
#define RLX_AGENT __ATOMIC_RELAXED, __HIP_MEMORY_SCOPE_AGENT
#define XB_TMO      128
#define XB_XCNT(j)  (256  + 64 * (j))
#define XB_XSUB(j)  (1280 + 64 * (j))
#define XB_XGEN(j)  (2304 + 64 * (j))
#define XB_TOP      3328
#define XB_TOPGEN   3392
#define XCD_BAR_WORDS 3456
#define XB_SPIN_CAP (1u << 18)
__device__ __forceinline__ unsigned xb_ld(unsigned* p)              { return __hip_atomic_load(p, __ATOMIC_RELAXED, __HIP_MEMORY_SCOPE_AGENT); }
__device__ __forceinline__ unsigned xb_add(unsigned* p, unsigned v) { return __hip_atomic_fetch_add(p, v, __ATOMIC_RELAXED, __HIP_MEMORY_SCOPE_AGENT); }
__device__ __forceinline__ unsigned xb_xcc_id() { return (unsigned)__builtin_amdgcn_s_getreg((3 << 11) | 20) & 0xFu; }
#define XB_SPIN(cond, bar) do { unsigned _sp = 0; while (cond) { __builtin_amdgcn_s_sleep(1); \
    if ((++_sp & 255u) == 0u) { if (xb_ld(&(bar)[XB_TMO])) break; if (_sp > XB_SPIN_CAP) { atomicAdd(&(bar)[XB_TMO], 1u); break; } } } } while (0)
struct XcdBarrier { unsigned* bar; unsigned x; volatile LAS unsigned* st; int wave; };
__device__ __forceinline__ XcdBarrier xcd_barrier_post(unsigned* bar, volatile LAS unsigned* st, int wave) {
    XcdBarrier b; b.bar = bar; b.x = xb_xcc_id(); b.st = st; b.wave = wave;
    if (wave == 0 && lane_id() == 0) (void)xb_add(&bar[XB_XCNT(b.x)], 1u);
    return b;
}
__device__ __forceinline__ void xcd_barrier_complete(unsigned* bar, unsigned x, unsigned& nloc, unsigned& nx) {
    const unsigned G = gridDim.x * gridDim.y * gridDim.z;
    unsigned sum, cnt, mine, sp = 0u;
    for (;;) {
        sum = 0u; cnt = 0u; mine = 0u;
#pragma unroll
        for (unsigned j = 0; j < 16; ++j) { const unsigned c = xb_ld(&bar[XB_XCNT(j)]); sum += c; cnt += (c > 0u) ? 1u : 0u; mine = (j == x) ? c : mine; }
        if (sum == G) break;
        __builtin_amdgcn_s_sleep(1);
        if ((++sp & 255u) == 0u) { if (xb_ld(&bar[XB_TMO])) break; if (sp > XB_SPIN_CAP) { atomicAdd(&bar[XB_TMO], 1u); break; } }
    }
    nloc = mine > 0u ? mine : 1u; nx = cnt > 0u ? cnt : 1u;
}
__device__ __forceinline__ void xcd_barrier(const XcdBarrier& b) {
    asm volatile("s_waitcnt vmcnt(0)" ::: "memory");
    __syncthreads();
    if (b.wave == 0 && lane_id() == 0) {
        unsigned* bar = b.bar;
        __builtin_amdgcn_s_waitcnt(0);
        unsigned nloc = b.st[0], nx = b.st[1];
        if (nloc == 0u) { xcd_barrier_complete(bar, b.x, nloc, nx); b.st[0] = nloc; b.st[1] = nx; }
        const unsigned old = xb_add(&bar[XB_XSUB(b.x)], 1u);
        const unsigned gen = old / nloc;
        if (old + 1u == (gen + 1u) * nloc) {
            __builtin_amdgcn_fence(__ATOMIC_RELEASE, "agent");
            asm volatile("s_waitcnt vmcnt(0)" ::: "memory");
            const unsigned og = xb_add(&bar[XB_TOP], 1u);
            const unsigned tg = og / nx;
            if (og + 1u == (tg + 1u) * nx) xb_add(&bar[XB_TOPGEN], 1u);
            else XB_SPIN(xb_ld(&bar[XB_TOPGEN]) == tg, bar);
            __builtin_amdgcn_fence(__ATOMIC_ACQUIRE, "agent");
            xb_add(&bar[XB_XGEN(b.x)], 1u);
            asm volatile("s_waitcnt vmcnt(0)" ::: "memory");
        } else {
            XB_SPIN(xb_ld(&bar[XB_XGEN(b.x)]) == gen, bar);
            __builtin_amdgcn_fence(__ATOMIC_ACQUIRE, "agent");
            asm volatile("s_waitcnt vmcnt(0)" ::: "memory");
        }
    }
    __syncthreads();
}

struct Args { const float* in[20]; float* out; unsigned char* ws; };
struct Frame {
    LAS unsigned char* lds; int tid, lane, wave, vcu, G;
};

__device__ __forceinline__ int colmap(int mode, int r) {
    if (mode == 0) return r;
    if (mode == 1) return 3136 + r;
    if (mode == 3) { if (r < 4096) { const int k = r >> 8, j = r & 255; return j < 128 ? 1088 + 128 * k + j : 7232 + 128 * k + (j - 128); } if (r < 6144) return 5184 + (r - 4096); if (r < 7168) return r - 6144;
        if (r < 7232) { const int j = r - 7168; return 1024 + (j >> 1) + 32 * (j & 1); } if (r < 7424) return -1; return 3136 + (r - 7424); }
    const int h = r / DQK, d = r - h * DQK; if (d < DN) return r; const int j = d - DN; return h * DQK + DN + (j >> 1) + 32 * (j & 1);
}
template <bool F8 = false>
__device__ __forceinline__ void p0_transpose_item(const float* W, int K, int N, bf16* WT, int ndst, int mode, const float* kscale, LAS float* scr, int item, int lane) {
    const int nblk = ndst / 32, kb = item / nblk, nb = item % nblk, k0 = 64 * kb, n0 = 32 * nb;
    const int src = colmap(mode, n0 + (lane & 31));
    const int s0 = colmap(mode, n0), s31 = colmap(mode, n0 + 31);
    if (s0 >= 0 && s31 == s0 + 31 && (s0 & 3) == 0) {
        const int kr = lane >> 3, n4 = lane & 7; f32x4 v[8];
#pragma unroll
        for (int i = 0; i < 8; ++i) v[i] = *(const f32x4*)(W + (size_t)(k0 + 8 * i + kr) * N + s0 + 4 * n4);
#pragma unroll
        for (int i = 0; i < 8; ++i) { const float ks = kscale ? kscale[k0 + 8 * i + kr] : 1.f; LAS float* d = scr + (8 * i + kr) * 33 + 4 * n4;
            d[0] = v[i][0] * ks; d[1] = v[i][1] * ks; d[2] = v[i][2] * ks; d[3] = v[i][3] * ks; }
    } else {
#pragma unroll 8
    for (int i = 0; i < 32; ++i) { const int kk = 2 * i + (lane >> 5); float v = 0.f;
        if (src >= 0) { v = W[(size_t)(k0 + kk) * N + src]; if (kscale) v *= kscale[k0 + kk]; }
        scr[kk * 33 + (lane & 31)] = v; }
    }
    LDS_WAIT(); asm volatile("" ::: "memory");
    const int c = lane & 7;
#pragma unroll
    for (int j = 0; j < 4; ++j) { const int n = (lane >> 3) + 8 * j; const LAS float* s = scr + (8 * c) * 33 + n;
        if constexpr (F8) { float t[8];
#pragma unroll
            for (int e = 0; e < 8; ++e) t[e] = fminf(fmaxf(s[e * 33] * WIN8_SCALE, -448.f), 448.f);
            int w0 = 0, w1 = 0; w0 = __builtin_amdgcn_cvt_pk_fp8_f32(t[0], t[1], w0, false); w0 = __builtin_amdgcn_cvt_pk_fp8_f32(t[2], t[3], w0, true); w1 = __builtin_amdgcn_cvt_pk_fp8_f32(t[4], t[5], w1, false); w1 = __builtin_amdgcn_cvt_pk_fp8_f32(t[6], t[7], w1, true);
            v2u o; o.x = (unsigned)w0; o.y = (unsigned)w1; *(v2u*)((unsigned char*)WT + (size_t)(n0 + n) * K + k0 + 8 * c) = o; continue; }
        v4u o; o.x = cvt_pk_bf16(s[0 * 33], s[1 * 33]); o.y = cvt_pk_bf16(s[2 * 33], s[3 * 33]); o.z = cvt_pk_bf16(s[4 * 33], s[5 * 33]); o.w = cvt_pk_bf16(s[6 * 33], s[7 * 33]);
        *(v4u*)(WT + (size_t)(n0 + n) * K + k0 + 8 * c) = o; }
    LDS_WAIT(); asm volatile("" ::: "memory");
}

__device__ __forceinline__ void sgu_unit(const Frame& F, int unit, const bf16* VG, bf16* U, const bf16* WSP, const float* lng, const float* lnb, const float* bsp, const u64* ssum, const u64* ssq) {
    const int chunk = unit >> 3, g = unit & 7, row0 = chunk * 128, c0 = g * 256;
    const int tid = F.tid, lane = F.lane, w = F.wave, fr = lane & 15, fq = lane >> 4;
    LAS unsigned* vt = (LAS unsigned*)F.lds;
    LAS float* st = (LAS float*)(F.lds + 256 * 272);
    if (tid < 128) { const float mean = fx_get(ssum + row0 + tid) * (1.f / D_MODEL), ex2 = fx_get(ssq + row0 + tid) * (1.f / D_MODEL);
        const float var = fmaxf(ex2 - mean * mean, 0.f); st[2 * tid] = mean; st[2 * tid + 1] = __builtin_amdgcn_rsqf(var + EPS); }
    __syncthreads();
#pragma unroll 1
    for (int q = 0; q < 4; ++q) {
        const int wi = w + 8 * q, c8 = lane & 7, rlo = lane >> 3, s2 = 8 * (wi & 7) + rlo, cg = 8 * (wi >> 3) + c8;
        const bf16* p = VG + (size_t)(row0 + 2 * s2) * D_MODEL + c0 + 8 * cg;
        const v4u a = *(const v4u*)p, b = *(const v4u*)(p + D_MODEL);
        const f32x4 g0 = *(const f32x4*)(lng + c0 + 8 * cg), g1 = *(const f32x4*)(lng + c0 + 8 * cg + 4), b0 = *(const f32x4*)(lnb + c0 + 8 * cg), b1 = *(const f32x4*)(lnb + c0 + 8 * cg + 4);
        const float m0 = st[4 * s2], r0 = st[4 * s2 + 1], m1 = st[4 * s2 + 2], r1 = st[4 * s2 + 3];
        const unsigned aw[4] = {a.x, a.y, a.z, a.w}, bw[4] = {b.x, b.y, b.z, b.w};
        const int pd = s2 ^ (c8 << 3);
#pragma unroll
        for (int j = 0; j < 8; ++j) { const float ga = j < 4 ? g0[j & 3] : g1[j & 3], be = j < 4 ? b0[j & 3] : b1[j & 3];
            const float x0 = (j & 1) ? bf_hi(aw[j >> 1]) : bf_lo(aw[j >> 1]), x1 = (j & 1) ? bf_hi(bw[j >> 1]) : bf_lo(bw[j >> 1]);
            vt[(8 * cg + j) * 68 + pd] = cvt_pk_bf16((x0 - m0) * r0 * ga + be, (x1 - m1) * r1 * ga + be); }
    }
    __syncthreads();
    f32x4 acc[2][8];
#pragma unroll
    for (int rt = 0; rt < 2; ++rt)
#pragma unroll
        for (int tt = 0; tt < 8; ++tt) acc[rt][tt] = (f32x4){0.f, 0.f, 0.f, 0.f};
    const bf16* wg = WSP + (size_t)g * 128 * 128;
#pragma unroll
    for (int kk = 0; kk < 4; ++kk) {
        bf16x8 af[2];
#pragma unroll
        for (int rt = 0; rt < 2; ++rt) { const int ch = 32 * w + 16 * rt + fr; const int d = 16 * kk + 4 * fq, pd = d ^ (((ch >> 3) & 7) << 3);
            af[rt] = *(const LAS bf16x8*)((const LAS unsigned char*)vt + ch * 272 + pd * 4); }
#pragma unroll
        for (int tt = 0; tt < 8; ++tt) { if (tt >= 2 * kk) {
            const bf16x8 bfr = *(const bf16x8*)(wg + (size_t)(16 * tt + fr) * 128 + 32 * kk + 8 * fq);
#pragma unroll
            for (int rt = 0; rt < 2; ++rt) acc[rt][tt] = __builtin_amdgcn_mfma_f32_16x16x32_bf16(af[rt], bfr, acc[rt][tt], 0, 0, 0); } }
    }
#pragma unroll
    for (int tt = 0; tt < 8; ++tt) { const int t = 16 * tt + fr; const float bs = bsp[g * 128 + t];
#pragma unroll
        for (int rt = 0; rt < 2; ++rt) { const size_t off = (size_t)(row0 + t) * D_MODEL + c0 + 32 * w + 16 * rt + 4 * fq;
            const v2u uu = *(const v2u*)(U + off);
            const f32x4 a = acc[rt][tt];
            v2u o; o.x = cvt_pk_bf16(bf_lo(uu.x) * (a[0] + bs), bf_hi(uu.x) * (a[1] + bs));
            o.y = cvt_pk_bf16(bf_lo(uu.y) * (a[2] + bs), bf_hi(uu.y) * (a[3] + bs));
            *(v2u*)(U + off) = o; } }
    __syncthreads();
}

namespace att {
constexpr int KT = 64 * 192, VT = 128 * 64;
constexpr int L_K = 0, L_V = 4 * KT, L_WS = 4 * KT + 4 * VT;
#define KSWZ(row, ch) ((row) * 192 + ((((ch) ^ (((row) >> 2) & 3))) << 4))
__device__ __forceinline__ int v_st(int k, int c) { const int kk = (k & ~0xC) | ((k & 4) << 1) | ((k & 8) >> 1); return ((kk >> 3) * 4 + (c >> 5)) * 512 + ((kk & 7) * 32 + (c & 31)) * 2; }
__device__ __forceinline__ int v_rd_base(int lane) { return ((lane & 3) << 3) | (((lane >> 2) & 3) << 6) | (((lane >> 4) & 1) << 5) | (((lane >> 5) & 1) << 8); }
constexpr int v_rd_off(int d0, int ks, int half) { return d0 * 512 + ks * 4096 + half * 2048; }
__device__ __forceinline__ int crow(int r, int hi) { return (r & 3) + 8 * (r >> 2) + 4 * hi; }
__device__ __forceinline__ void mask_tile(f32x16& p0, f32x16& p1, int dq) {
    const float NEG = -__builtin_inff();
#pragma unroll
    for (int r = 0; r < 16; ++r) { const int c = (r & 3) + 8 * (r >> 2); if (dq - c < 0) p0[r] = NEG; if (dq - c - 32 < 0) p1[r] = NEG; }
}
constexpr float THR = 8.f;
__device__ __forceinline__ void softmax_tile(f32x16& p0, f32x16& p1, float& m_reg, float& alpha, v8i& pk, bool first) {
    float pmax;
    { float a4[4];
#pragma unroll
      for (int c = 0; c < 4; ++c) { a4[c] = fmaxf(fmaxf(p0[4 * c], p0[4 * c + 1]), p0[4 * c + 2]); a4[c] = fmaxf(fmaxf(a4[c], p0[4 * c + 3]), p1[4 * c]);
          a4[c] = fmaxf(fmaxf(a4[c], p1[4 * c + 1]), p1[4 * c + 2]); a4[c] = fmaxf(a4[c], p1[4 * c + 3]); }
      pmax = fmaxf(fmaxf(a4[0], a4[1]), fmaxf(a4[2], a4[3])); }
    { auto rr = __builtin_amdgcn_permlane32_swap(__float_as_uint(pmax), __float_as_uint(pmax), false, false); pmax = fmaxf(__uint_as_float(rr[0]), __uint_as_float(rr[1])); }
    if (__builtin_expect(__all(pmax - m_reg <= THR) && !first, 1)) { alpha = 1.f; }
    else { float delta = first ? pmax - m_reg : fmaxf(pmax - m_reg, 0.f); if (!(delta > -1e30f)) delta = 0.f;
        alpha = first ? 1.f : __builtin_amdgcn_exp2f(-delta); m_reg += delta; }
#pragma unroll
    for (int r = 0; r < 16; ++r) { p0[r] = __builtin_amdgcn_exp2f(p0[r] - m_reg); p1[r] = __builtin_amdgcn_exp2f(p1[r] - m_reg); }
#pragma unroll
    for (int w = 0; w < 4; ++w) { int d0 = 0, d1 = 0; d0 = __builtin_amdgcn_cvt_pk_fp8_f32(p0[4 * w], p0[4 * w + 1], d0, false); d0 = __builtin_amdgcn_cvt_pk_fp8_f32(p0[4 * w + 2], p0[4 * w + 3], d0, true);
        d1 = __builtin_amdgcn_cvt_pk_fp8_f32(p1[4 * w], p1[4 * w + 1], d1, false); d1 = __builtin_amdgcn_cvt_pk_fp8_f32(p1[4 * w + 2], p1[4 * w + 3], d1, true); pk[w] = d0; pk[4 + w] = d1; }
}
template <int KB>
__device__ __forceinline__ void qkt(f32x16& p0, f32x16& p1, const char* K_lds, int r32, int hi, const v8i* qr) {
    p0 = f32x16{}; p1 = f32x16{};
    const char* k0 = K_lds + KB * KT + KSWZ(r32, 2 * hi); const char* k1 = K_lds + KB * KT + KSWZ(r32, 2 * hi + 1);
#pragma unroll
    for (int ks = 0; ks < 3; ++ks) {
        const v4u a0 = *reinterpret_cast<const v4u*>(k0 + ks * 64), a1 = *reinterpret_cast<const v4u*>(k1 + ks * 64);
        const v4u b0 = *reinterpret_cast<const v4u*>(k0 + ks * 64 + 32 * 192), b1 = *reinterpret_cast<const v4u*>(k1 + ks * 64 + 32 * 192);
        const v8i ka = {(int)a0.x, (int)a0.y, (int)a0.z, (int)a0.w, (int)a1.x, (int)a1.y, (int)a1.z, (int)a1.w};
        const v8i kb = {(int)b0.x, (int)b0.y, (int)b0.z, (int)b0.w, (int)b1.x, (int)b1.y, (int)b1.z, (int)b1.w};
        p0 = __builtin_amdgcn_mfma_scale_f32_32x32x64_f8f6f4(ka, qr[ks], p0, 0, 0, 0, 0x7c7c7c7c, 0, 0x79797979);
        p1 = __builtin_amdgcn_mfma_scale_f32_32x32x64_f8f6f4(kb, qr[ks], p1, 0, 0, 0, 0x7c7c7c7c, 0, 0x79797979); }
}
template <int VB>
__device__ __forceinline__ void pv_tile(f32x16* o, f32x16& lacc, const char* V_lds, int r32, int hi, v8i pk) {
    const int sw = (r32 >> 2) & 3;
    const char* v0 = V_lds + VB * VT + r32 * 64 + (((2 * hi) ^ sw) << 4); const char* v1 = V_lds + VB * VT + r32 * 64 + (((2 * hi + 1) ^ sw) << 4);
#pragma unroll
    for (int d0 = 0; d0 < 4; ++d0) { const v4u a = *reinterpret_cast<const v4u*>(v0 + d0 * 2048), b = *reinterpret_cast<const v4u*>(v1 + d0 * 2048);
        const v8i vb = {(int)a.x, (int)a.y, (int)a.z, (int)a.w, (int)b.x, (int)b.y, (int)b.z, (int)b.w};
        o[d0] = __builtin_amdgcn_mfma_scale_f32_32x32x64_f8f6f4(pk, vb, o[d0], 0, 0, 0, 0x7f7f7f7f, 0, 0x7c7c7c7c); if (d0 == 1) SBAR(); }
    { int c1 = 0x38383838; asm volatile("" : "+v"(c1)); const v8i ones = {c1, c1, c1, c1, c1, c1, c1, c1};
      lacc = __builtin_amdgcn_mfma_scale_f32_32x32x64_f8f6f4(pk, ones, lacc, 0, 0, 0, 0x7f7f7f7f, 0, 0x7f7f7f7f); }
}
__device__ __forceinline__ void attn_unit(int bh, int qb, const unsigned char* Q, const unsigned char* K, const unsigned char* KRp, const unsigned char* V, const bf16* GA, bf16* MG, char* lds, LAS unsigned char* lds3, const int wave0) {
    int tid = wave0 * 64 + lane_id(); asm volatile("" : "+v"(tid));
    const int wid = __builtin_amdgcn_readfirstlane(tid >> 6), lane = tid & 63, r32 = lane & 31, hi = lane >> 5;
    const int q0 = qb * 256, qlo = q0 + wid * 32, qm = qlo + r32 - 4 * hi;
    const unsigned char* Qw = Q + ((size_t)bh * SEQL + qlo + r32) * DQK;
    const unsigned char* Kh = K + (size_t)bh * SEQL * DN; const unsigned char* KRh = KRp + (size_t)(bh >> 4) * SEQL * DR; const unsigned char* Vh = V + (size_t)bh * SEQL * DVH;
    char* V_lds = lds + L_V; char* K_lds = lds + L_K;
    float* ws = (float*)(lds + L_WS) + wid * 64; float* li_l = ws, * al_l = ws + 32;
    v8i qr[3];
#pragma unroll
    for (int ks = 0; ks < 3; ++ks) { const v4u a = *reinterpret_cast<const v4u*>(Qw + ks * 64 + hi * 32), b = *reinterpret_cast<const v4u*>(Qw + ks * 64 + hi * 32 + 16);
        qr[ks] = (v8i){(int)a.x, (int)a.y, (int)a.z, (int)a.w, (int)b.x, (int)b.y, (int)b.z, (int)b.w}; }
    const int NT = 4 * (qb + 1);
    unsigned ksp[2], kst[2], vso;
#pragma unroll
    for (int i = 0; i < 2; ++i) { const int o = i * 8192 + tid * 16, row = (o / 192) & 63, pos = (o - (o / 192) * 192) >> 4, ch = pos ^ ((row >> 2) & 3);
        if (ch < 8) { ksp[i] = (unsigned)(Kh - Vh) + (unsigned)(row * DN + ch * 16); kst[i] = 64 * DN; } else { ksp[i] = (unsigned)(KRh - Vh) + (unsigned)(row * DR + (ch - 8) * 16); kst[i] = 64 * DR; } }
    { const int j = tid >> 2, c = (tid & 3) ^ ((j >> 2) & 3); vso = (unsigned)(j * SEQL + c * 16); }
    float m_reg = 0.f; f32x16 lacc = {}; f32x16 o[4] = {};
    const unsigned ldw = (unsigned)wid * 1024u;
#define SOFF(x) ({ unsigned o_ = (x); asm volatile("" : "+v"(o_)); (const unsigned*)((const char*)Vh + o_); })
#define SDMA(t, bf) do { \
        __builtin_amdgcn_global_load_lds(SOFF(ksp[0] + (unsigned)(t) * kst[0]), (LAS unsigned*)(lds3 + L_K + (bf) * KT + ldw), 16, 0, 0); \
        if (wid < 4) __builtin_amdgcn_global_load_lds(SOFF(ksp[1] + (unsigned)(t) * kst[1]), (LAS unsigned*)(lds3 + L_K + (bf) * KT + 8192 + ldw), 16, 0, 0); \
        __builtin_amdgcn_global_load_lds(SOFF(vso + (unsigned)(t) * 64u), (LAS unsigned*)(lds3 + L_V + (bf) * VT + ldw), 16, 0, 0); } while (0)
#define TILE(t, BF) do { f32x16 p0, p1; float alpha; v8i pk; \
        __builtin_amdgcn_s_setprio(1); qkt<BF>(p0, p1, K_lds, r32, hi, qr); __builtin_amdgcn_s_setprio(0); \
        { const int kb_ = (t) * 64; if (kb_ + 63 > qlo) mask_tile(p0, p1, qm - kb_); } \
        softmax_tile(p0, p1, m_reg, alpha, pk, (t) == 0); \
        if (__any(alpha < 1.f)) { if (hi == 0) al_l[r32] = alpha; asm volatile("s_waitcnt lgkmcnt(0)" ::: "memory"); \
            _Pragma("unroll") for (int r = 0; r < 16; ++r) { const float a_ = al_l[crow(r, hi)]; lacc[r] *= a_; _Pragma("unroll") for (int d_ = 0; d_ < 4; ++d_) o[d_][r] *= a_; } } \
        __builtin_amdgcn_s_setprio(1); pv_tile<BF>(o, lacc, V_lds, r32, hi, pk); __builtin_amdgcn_s_setprio(0); SBAR(); } while (0)
    SDMA(0, 0); SDMA(1, 1); VM_WAIT(); __syncthreads();
    for (int t = 0; t < NT; t += 4) {
        SDMA(t + 2, 2); SDMA(t + 3, 3); SBAR();
        TILE(t, 0); TILE(t + 1, 1);
        VM_WAIT(); __syncthreads();
        if (t + 4 < NT) { SDMA(t + 4, 0); SDMA(t + 5, 1); } SBAR();
        TILE(t + 2, 2); TILE(t + 3, 3);
        VM_WAIT(); __syncthreads(); }
#undef TILE
#undef SDMA
#undef SOFF
    float* stg = (float*)lds + wid * 4096;
    float rli[16];
#pragma unroll
    for (int r = 0; r < 16; ++r) rli[r] = __builtin_amdgcn_rcpf(lacc[r]);
    const int le = lane_id(), r32e = le & 31, hie = le >> 5;
#pragma unroll
    for (int r = 0; r < 16; ++r) { const int orow = crow(r, hie);
#pragma unroll
        for (int d0 = 0; d0 < 4; ++d0) stg[orow * 128 + d0 * 32 + r32e] = o[d0][r] * rli[r]; }
    asm volatile("s_waitcnt lgkmcnt(0)" ::: "memory");
    const int b = bh >> 4, h = bh & 15;
#pragma unroll 4
    for (int it = 0; it < 16; ++it) { const int row = 2 * it + hie, c4 = r32e * 4;
        const f32x4 ov = *(const f32x4*)(stg + row * 128 + c4);
        const size_t off = ((size_t)b * SEQL + qlo + row) * D_MODEL + h * DVH + c4;
        const v2u ga = *(const v2u*)(GA + off), ob = *(const v2u*)(MG + off);
        v2u w; w.x = cvt_pk_bf16(bf_lo(ga.x) * ov[0] + bf_lo(ob.x), bf_hi(ga.x) * ov[1] + bf_hi(ob.x)); w.y = cvt_pk_bf16(bf_lo(ga.y) * ov[2] + bf_lo(ob.y), bf_hi(ga.y) * ov[3] + bf_hi(ob.y));
        *(v2u*)(MG + off) = w; }
    __syncthreads();
}
#undef KSWZ
}

__device__ __forceinline__ void ce_desc(float& a, float& b) { const float hi = fmaxf(a, b), lo = fminf(a, b); a = hi; b = lo; }
template <int N> __device__ __forceinline__ void bitonic_sort_desc(float (&v)[N]) {
#pragma unroll
    for (int k = 2; k <= N; k <<= 1)
#pragma unroll
        for (int j = k >> 1; j > 0; j >>= 1)
#pragma unroll
            for (int i = 0; i < N; ++i) { const int l = i ^ j; if (l > i) { if ((i & k) == 0) ce_desc(v[i], v[l]); else ce_desc(v[l], v[i]); } }
}
template <int N> __device__ __forceinline__ void bitonic_merge_desc(float (&v)[N]) {
#pragma unroll
    for (int j = N >> 1; j > 0; j >>= 1)
#pragma unroll
        for (int i = 0; i < N; ++i) { const int l = i ^ j; if (l > i) ce_desc(v[i], v[l]); }
}
__device__ __forceinline__ void merge_top16(float (&a)[16], const float (&b)[16]) {
#pragma unroll
    for (int i = 0; i < 16; ++i) a[i] = fmaxf(a[i], b[15 - i]);
    bitonic_merge_desc<16>(a);
}
__device__ __forceinline__ void topk_unit(const Frame& F, int tg, int h, const bf16* QP, int* TOPI, float* TOPG) {
    const int lane = F.lane, fr = lane & 15, fq = lane >> 4;
    const int t0 = tg * 16;
    LAS float* sl = (LAS float*)(F.lds + 65536) + F.wave * 512;
    float s01[2][16];
#pragma unroll
    for (int p = 0; p < 2; ++p) {
        f32x4 acc[8];
#pragma unroll
        for (int mt = 0; mt < 8; ++mt) acc[mt] = (f32x4){0.f, 0.f, 0.f, 0.f};
        const bf16* qp = QP + (size_t)(t0 + fr) * D_MODEL + h * 256 + p * 128 + 8 * fq;
        const LAS unsigned char* kp = F.lds + p * 32768 + fr * 256;
#pragma unroll
        for (int kk = 0; kk < 4; ++kk) { const bf16x8 bq = *(const bf16x8*)(qp + 32 * kk);
#pragma unroll
            for (int mt = 0; mt < 8; ++mt) { const bf16x8 ak = *(const LAS bf16x8*)(kp + mt * 4096 + (((4 * kk + fq) ^ fr) << 4));
                acc[mt] = __builtin_amdgcn_mfma_f32_16x16x32_bf16(ak, bq, acc[mt], 0, 0, 0); } }
        float a[16], b[16];
#pragma unroll
        for (int mt = 0; mt < 8; ++mt)
#pragma unroll
            for (int e = 0; e < 4; ++e) { const unsigned n = (unsigned)(16 * mt + 4 * fq + e); const float pk = __uint_as_float((__float_as_uint(acc[mt][e]) & ~0x7Fu) | n);
                if (mt < 4) a[mt * 4 + e] = pk; else b[(mt - 4) * 4 + e] = pk; }
        bitonic_sort_desc<16>(a); bitonic_sort_desc<16>(b); merge_top16(a, b);
#pragma unroll
        for (int i = 0; i < 16; ++i) b[i] = shx(a[i], 16, F.lane);
        merge_top16(a, b);
#pragma unroll
        for (int i = 0; i < 16; ++i) b[i] = shx(a[i], 32, F.lane);
        merge_top16(a, b);
#pragma unroll
        for (int i = 0; i < 16; ++i) s01[p][i] = a[i];
    }
    if (fq == 0) {
#pragma unroll
        for (int p = 0; p < 2; ++p)
#pragma unroll
            for (int i = 0; i < 16; ++i) sl[fr * 32 + p * 16 + i] = s01[p][i];
    }
    float c[4][16];
#pragma unroll
    for (int gidx = 0; gidx < 4; ++gidx)
#pragma unroll
        for (int i = 0; i < 16; ++i) c[gidx][i] = -3.0e38f;
#define CAND(n, i, j) do { const float v_ = __uint_as_float(__float_as_uint(s01[0][i]) & ~0x7Fu) + __uint_as_float(__float_as_uint(s01[1][j]) & ~0x7Fu); \
        c[(n) >> 4][(n) & 15] = __uint_as_float((__float_as_uint(v_) & ~0xFFu) | (unsigned)((i) * 16 + (j))); } while (0)
    CAND(0, 0, 0); CAND(1, 0, 1); CAND(2, 0, 2); CAND(3, 0, 3); CAND(4, 0, 4); CAND(5, 0, 5); CAND(6, 0, 6); CAND(7, 0, 7);
    CAND(8, 0, 8); CAND(9, 0, 9); CAND(10, 0, 10); CAND(11, 0, 11); CAND(12, 0, 12); CAND(13, 0, 13); CAND(14, 0, 14); CAND(15, 0, 15);
    CAND(16, 1, 0); CAND(17, 1, 1); CAND(18, 1, 2); CAND(19, 1, 3); CAND(20, 1, 4); CAND(21, 1, 5); CAND(22, 1, 6); CAND(23, 1, 7);
    CAND(24, 2, 0); CAND(25, 2, 1); CAND(26, 2, 2); CAND(27, 2, 3); CAND(28, 2, 4);
    CAND(29, 3, 0); CAND(30, 3, 1); CAND(31, 3, 2); CAND(32, 3, 3);
    CAND(33, 4, 0); CAND(34, 4, 1); CAND(35, 4, 2);
    CAND(36, 5, 0); CAND(37, 5, 1); CAND(38, 6, 0); CAND(39, 6, 1); CAND(40, 7, 0); CAND(41, 7, 1);
    CAND(42, 8, 0); CAND(43, 9, 0); CAND(44, 10, 0); CAND(45, 11, 0); CAND(46, 12, 0); CAND(47, 13, 0); CAND(48, 14, 0); CAND(49, 15, 0);
#undef CAND
    bitonic_sort_desc<16>(c[0]); bitonic_sort_desc<16>(c[1]); bitonic_sort_desc<16>(c[2]); bitonic_sort_desc<16>(c[3]);
    merge_top16(c[0], c[1]); merge_top16(c[2], c[3]); merge_top16(c[0], c[2]);
    LDS_WAIT(); asm volatile("" ::: "memory");
    float sc[16]; int ix[16]; float mx = -3.0e38f;
#pragma unroll
    for (int w = 0; w < 16; ++w) { const unsigned id = __float_as_uint(c[0][w]) & 0xFFu; const unsigned u0 = __float_as_uint(sl[fr * 32 + (id >> 4)]), u1 = __float_as_uint(sl[fr * 32 + 16 + (id & 15)]);
        sc[w] = __uint_as_float(u0 & ~0x7Fu) + __uint_as_float(u1 & ~0x7Fu); ix[w] = (int)((u0 & 0x7Fu) * NKEYS + (u1 & 0x7Fu)); mx = fmaxf(mx, sc[w]); }
    float sum = 0.f;
#pragma unroll
    for (int w = 0; w < 16; ++w) { sc[w] = __builtin_amdgcn_exp2f((sc[w] - mx) * 1.4426950409f); sum += sc[w]; }
    const float rs = __builtin_amdgcn_rcpf(sum);
    if (fq == 0) { int* ti = TOPI + (size_t)(t0 + fr) * 128 + h * 16; float* tgp = TOPG + (size_t)(t0 + fr) * 128 + h * 16;
#pragma unroll
        for (int w = 0; w < 16; ++w) { ti[w] = ix[w]; tgp[w] = sc[w] * rs; } }
    LDS_WAIT(); asm volatile("" ::: "memory");
}

typedef float f32x2 __attribute__((ext_vector_type(2)));
struct PeerIdx { int i0, i1; float a0, a1; };
struct PeerRow { v4u x[2]; };
__device__ __forceinline__ void pu_gather(int t, int sl, int lane, const PeerIdx& I, v4u (&wu)[16], PeerRow& R, const bf16* X, const unsigned char* PU8) {
    const int r = lane & 7, g = lane >> 3;
    const unsigned char* sb = PU8 + (size_t)sl * NEXP * 128;
#pragma unroll
    for (int k = 0; k < 16; ++k) { const int e = __shfl(k < 8 ? I.i0 : I.i1, (8 * k + g) & 63); unsigned o_ = (unsigned)(e * 128 + 16 * r); asm volatile("" : "+v"(o_)); wu[k] = *(const v4u*)(sb + o_); }
    const bf16* xp = X + (size_t)t * D_MODEL + 128 * sl + 16 * r;
    R.x[0] = __builtin_nontemporal_load((const v4u*)xp); R.x[1] = __builtin_nontemporal_load((const v4u*)(xp + 8));
}
__device__ __forceinline__ void pu_compute(int t, int sl, int lane, const v4u (&wu)[16], const PeerRow& R, float* PART) {
    const int r = lane & 7, g = lane >> 3;
    float hh[16];
    { const unsigned xw[8] = {R.x[0].x, R.x[0].y, R.x[0].z, R.x[0].w, R.x[1].x, R.x[1].y, R.x[1].z, R.x[1].w};
#pragma unroll
      for (int q = 0; q < 8; ++q) { hh[2 * q] = bf_lo(xw[q]); hh[2 * q + 1] = bf_hi(xw[q]); } }
    float d[16];
    { f32x2 ac[16];
#pragma unroll
      for (int k = 0; k < 16; ++k) ac[k] = (f32x2){0.f, 0.f};
#pragma unroll
      for (int q = 0; q < 4; ++q) { const f32x2 hlo = {hh[4 * q], hh[4 * q + 1]}, hhi = {hh[4 * q + 2], hh[4 * q + 3]};
#pragma unroll
          for (int k = 0; k < 16; ++k) { const int w_ = (int)(q == 0 ? wu[k].x : q == 1 ? wu[k].y : q == 2 ? wu[k].z : wu[k].w);
              ac[k] += __builtin_amdgcn_cvt_pk_f32_fp8(w_, false) * hlo; ac[k] += __builtin_amdgcn_cvt_pk_f32_fp8(w_, true) * hhi; } }
#pragma unroll
      for (int k = 0; k < 16; ++k) d[k] = ac[k][0] + ac[k][1]; }
    const bool b0 = lane & 1, b1 = lane & 2, b2 = lane & 4;
    float res[2];
#pragma unroll
    for (int hf = 0; hf < 2; ++hf) { float e1[4], f1[2];
#pragma unroll
        for (int m = 0; m < 4; ++m) e1[m] = (b0 ? d[8 * hf + 2 * m + 1] : d[8 * hf + 2 * m]) + shx(b0 ? d[8 * hf + 2 * m] : d[8 * hf + 2 * m + 1], 1, lane);
#pragma unroll
        for (int n = 0; n < 2; ++n) f1[n] = (b1 ? e1[2 * n + 1] : e1[2 * n]) + shx(b1 ? e1[2 * n] : e1[2 * n + 1], 2, lane);
        res[hf] = (b2 ? f1[1] : f1[0]) + shx(b2 ? f1[0] : f1[1], 4, lane); }
    float* po = PART + ((size_t)t * 16 + sl) * 128 + 8 * r + g;
    __builtin_nontemporal_store(res[0], po); __builtin_nontemporal_store(res[1], po + 64);
}
__device__ __forceinline__ void peer_fin_token(int t, int lane, const float* PART, const int* TOPI, float* TOPG, const float* USC, const float* VSC, const u64* sqx) {
    const float r2 = __builtin_amdgcn_rsqf(fx_get(sqx + t) * (1.f / D_MODEL) + EPS);
    float s0 = 0.f, s1 = 0.f;
#pragma unroll
    for (int sl = 0; sl < 16; ++sl) { s0 += __builtin_nontemporal_load(PART + ((size_t)t * 16 + sl) * 128 + lane); s1 += __builtin_nontemporal_load(PART + ((size_t)t * 16 + sl) * 128 + 64 + lane); }
    const int e0 = TOPI[(size_t)t * 128 + lane], e1 = TOPI[(size_t)t * 128 + 64 + lane];
    float* gp = TOPG + (size_t)t * 128;
    gp[lane] = gelu_t(s0 * USC[e0] * r2) * gp[lane] * VSC[e0]; gp[64 + lane] = gelu_t(s1 * USC[e1] * r2) * gp[64 + lane] * VSC[e1];
}
__device__ __forceinline__ void pv_gather(int t, int sl, int lane, const PeerIdx& I, v4u (&wv)[16], float (&xv)[2], const bf16* X, const unsigned char* PV8) {
    const int r = lane & 7, g = lane >> 3;
    const unsigned char* sb = PV8 + (size_t)sl * NEXP * 128;
#pragma unroll
    for (int k = 0; k < 16; ++k) { const int e = __shfl(k < 8 ? I.i0 : I.i1, (8 * k + g) & 63); unsigned o_ = (unsigned)(e * 128 + 16 * r); asm volatile("" : "+v"(o_)); wv[k] = *(const v4u*)(sb + o_); }
    const bf16* xp = X + (size_t)t * D_MODEL + 128 * sl + 16 * r + g; xv[0] = __uint_as_float((unsigned)xp[0] << 16); xv[1] = __uint_as_float((unsigned)xp[8] << 16);
}
__device__ __forceinline__ void pv_compute(int t, int sl, int lane, const PeerIdx& I, const v4u (&wv)[16], const float (&xv)[2], float* X, u64* ssq2) {
    const int r = lane & 7, g = lane >> 3;
    float oa[16];
    { f32x2 o2[8]; float ak[16];
#pragma unroll
      for (int e = 0; e < 8; ++e) o2[e] = (f32x2){0.f, 0.f};
#pragma unroll
      for (int k = 0; k < 16; ++k) ak[k] = __shfl(k < 8 ? I.a0 : I.a1, (8 * k + g) & 63);
#pragma unroll
      for (int k = 0; k < 16; ++k) { const f32x2 a2 = {ak[k], ak[k]};
#pragma unroll
          for (int q = 0; q < 4; ++q) { const int w_ = (int)(q == 0 ? wv[k].x : q == 1 ? wv[k].y : q == 2 ? wv[k].z : wv[k].w);
              o2[2 * q] += __builtin_amdgcn_cvt_pk_f32_fp8(w_, false) * a2; o2[2 * q + 1] += __builtin_amdgcn_cvt_pk_f32_fp8(w_, true) * a2; } }
#pragma unroll
      for (int e = 0; e < 8; ++e) { oa[2 * e] = o2[e][0]; oa[2 * e + 1] = o2[e][1]; } }
    const bool c0 = lane & 8, c1 = lane & 16, c2 = lane & 32;
    float p1[8], p2[4], p3[2];
#pragma unroll
    for (int m = 0; m < 8; ++m) p1[m] = (c0 ? oa[2 * m + 1] : oa[2 * m]) + shx(c0 ? oa[2 * m] : oa[2 * m + 1], 8, lane);
#pragma unroll
    for (int n = 0; n < 4; ++n) p2[n] = (c1 ? p1[2 * n + 1] : p1[2 * n]) + shx(c1 ? p1[2 * n] : p1[2 * n + 1], 16, lane);
#pragma unroll
    for (int q = 0; q < 2; ++q) p3[q] = (c2 ? p2[2 * q + 1] : p2[2 * q]) + shx(c2 ? p2[2 * q] : p2[2 * q + 1], 32, lane);
    float* xp = X + (size_t)t * D_MODEL + 128 * sl + 16 * r + g;
    const float y0 = xv[0] + p3[0], y1 = xv[1] + p3[1];
    xp[0] = y0; xp[8] = y1;
    const float ss = wave_sum(y0 * y0 + y1 * y1, lane);
    if (lane == 0) fx_add(ssq2 + t, ss);
}
__device__ __forceinline__ void row8_load(f32x4 (&v)[8], const float* src, int lane) {
    const f32x4* xr = (const f32x4*)src + lane;
#pragma unroll
    for (int j = 0; j < 8; ++j) v[j] = __builtin_nontemporal_load(xr + 64 * j);
}
__device__ __forceinline__ void row_to_fp8(f32x4 (&v)[8], unsigned char* tab, int e, float* inv_scale, int lane, const float* colmul) {
    float am = 0.f;
#pragma unroll
    for (int j = 0; j < 8; ++j) { if (colmul) v[j] = v[j] * *((const f32x4*)colmul + lane + 64 * j);
        am = fmaxf(am, fmaxf(fmaxf(fabsf(v[j][0]), fabsf(v[j][1])), fmaxf(fabsf(v[j][2]), fabsf(v[j][3])))); }
#pragma unroll
    for (int o = 1; o < 64; o <<= 1) am = fmaxf(am, shx(am, o, lane));
    am = fmaxf(am, 1e-30f); const float sc = 256.f / am;
#pragma unroll
    for (int j = 0; j < 8; ++j) { int w = 0; w = __builtin_amdgcn_cvt_pk_fp8_f32(v[j][0] * sc, v[j][1] * sc, w, false); w = __builtin_amdgcn_cvt_pk_fp8_f32(v[j][2] * sc, v[j][3] * sc, w, true); const int dw = lane + 64 * j; *(unsigned*)(tab + ((size_t)(dw >> 5) * NEXP + e) * 128 + (dw & 31) * 4) = (unsigned)w; }
    if (lane == 0) *inv_scale = am * (1.f / 256.f);
}

__global__ void __launch_bounds__(512, 2) mk_fwd(Args args) {
    extern __shared__ __attribute__((aligned(16))) unsigned char lds[];
    Frame F;
    F.lds = (LAS unsigned char*)lds;
    F.wave = __builtin_amdgcn_readfirstlane((int)threadIdx.x >> 6); F.lane = lane_id(); F.tid = F.wave * 64 + F.lane;
    F.G = gridDim.x; { const int bx = blockIdx.x; F.vcu = (F.G % 8 == 0) ? (bx % 8) * (F.G / 8) + bx / 8 : bx; }
    unsigned char* ws = args.ws;
    gu32* ctl = (gu32*)(ws + WS_CTL);
    volatile LAS unsigned* MISC = (volatile LAS unsigned*)(F.lds + MISC_OFF);
    for (int u = F.tid; u < (LDS_BYTES - LDSCTL_OFF) / 4; u += 512) ((LAS unsigned*)(F.lds + LDSCTL_OFF))[u] = 0u;
    __syncthreads();
    XcdBarrier bar; bar.bar = (unsigned*)(ctl + CW_BAR); bar.x = 0; bar.st = nullptr;
    bar = xcd_barrier_post((unsigned*)(ctl + CW_BAR), MISC + 8, F.wave);
#define GRID_BAR() xcd_barrier(bar)
#define PHASE_BEGIN() do { F.lane = lane_id(); asm volatile("" : "+v"(F.lane)); F.tid = F.wave * 64 + F.lane; } while (0)
    const float* x = args.in[0]; const int* positions = (const int*)args.in[1]; const float* g_norm1 = args.in[2]; const float* w_in = args.in[3];
    const float* g_q_a = args.in[4]; const float* w_uq = args.in[5]; const float* g_kv_a = args.in[6]; const float* w_ukv = args.in[7];
    const float* sgu_ln_g = args.in[8]; const float* sgu_ln_b = args.in[9]; const float* w_spatial = args.in[10]; const float* b_spatial = args.in[11];
    const float* b_gate = args.in[12]; const float* w_out = args.in[13]; const float* g_norm2 = args.in[14]; const float* w_peer_q = args.in[15];
    const float* peer_keys = args.in[16]; const float* peer_u = args.in[17]; const float* peer_v = args.in[18]; const float* g_final = args.in[19];
    float* out = args.out;
    bf16* KEYS = (bf16*)(ws + WS_KEYS); bf16* WSP = (bf16*)(ws + WS_WSP); bf16* WUQ = (bf16*)(ws + WS_WUQ); bf16* WUKV = (bf16*)(ws + WS_WUKV);
    bf16* WOUT = (bf16*)(ws + WS_WOUT); bf16* WPQ = (bf16*)(ws + WS_WPQ); float* ROPE = (float*)(ws + WS_ROPE);
    unsigned char* XN8 = ws + WS_XN8; unsigned char* WIN8 = ws + WS_WIN8; unsigned char* CQKV = ws + WS_CQKV; bf16* U = (bf16*)(ws + WS_U); bf16* VG = (bf16*)(ws + WS_VG);
    unsigned char* Vb = ws + WS_V; unsigned char* Kb = ws + WS_K; unsigned char* KR = ws + WS_KR; unsigned char* Qb = ws + WS_Q; bf16* GA = (bf16*)(ws + WS_GA); float* X2 = (float*)(ws + WS_X2);
    bf16* X1B = (bf16*)(ws + WS_X1B); unsigned char* PU = ws + WS_PU; unsigned char* PV = ws + WS_PV; float* USC = (float*)(ws + WS_PSC); float* VSC = USC + NEXP; float* PART = (float*)(ws + WS_PART); bf16* QP = (bf16*)(ws + WS_QP);
    int* TOPI = (int*)(ws + WS_TOPI); float* TOPG = (float*)(ws + WS_TOPG);
    u64* SQQ = (u64*)(ws + CTL_STATS); u64* SQKV = SQQ + MTOK; u64* SSUM = SQKV + MTOK; u64* SSQ = SSUM + MTOK; u64* SQX1 = SSQ + MTOK;
    const int gw = F.vcu * 8 + F.wave, NGW = F.G * 8;

    {
        LAS float* scr = (LAS float*)(F.lds + RING_OFF + F.wave * 16384);
        constexpr int I_IN8 = (D_MODEL / 64) * (IN8_ROWS / 32), I_UQ = (QL / 64) * (NQ_COLS / 32), I_UKV = (QL / 64) * (NKV_COLS / 32), I_O = (D_MODEL / 64) * (D_MODEL / 32);
        constexpr int NITEMS = I_IN8 + I_UQ + I_UKV + 2 * I_O;
        for (int it = gw; it < NITEMS; it += NGW) {
            int r = it;
            if (r < I_IN8) { p0_transpose_item<true>(w_in, D_MODEL, IN_COLS, (bf16*)WIN8, IN8_ROWS, 3, nullptr, scr, r, F.lane); continue; } r -= I_IN8;
            if (r < I_UQ) { p0_transpose_item<true>(w_uq, QL, NQ_COLS, WUQ, NQ_COLS, 2, g_q_a, scr, r, F.lane); continue; } r -= I_UQ;
            if (r < I_UKV) { p0_transpose_item<true>(w_ukv, QL, NKV_COLS, WUKV, NKV_COLS, 0, g_kv_a, scr, r, F.lane); continue; } r -= I_UKV;
            if (r < I_O) { p0_transpose_item(w_out, D_MODEL, D_MODEL, WOUT, D_MODEL, 0, nullptr, scr, r, F.lane); continue; } r -= I_O;
            p0_transpose_item(w_peer_q, D_MODEL, D_MODEL, WPQ, D_MODEL, 0, g_norm2, scr, r, F.lane);
        }
        {
#define XN_LOAD(v, m_) do { const f32x4* xr_ = (const f32x4*)(x + (size_t)(m_) * D_MODEL) + F.lane; _Pragma("unroll") for (int j = 0; j < 8; ++j) v[j] = __builtin_nontemporal_load(xr_ + 64 * j); } while (0)
#define XN_DO(v, m_) do { float s_ = 0.f; _Pragma("unroll") for (int j = 0; j < 8; ++j) s_ += (v[j][0] * v[j][0] + v[j][1] * v[j][1]) + (v[j][2] * v[j][2] + v[j][3] * v[j][3]); \
            const float r_ = __builtin_amdgcn_rsqf(wave_sum(s_, F.lane) * (1.f / D_MODEL) + EPS); \
            _Pragma("unroll") for (int j = 0; j < 8; ++j) { const f32x4 h_ = v[j] * r_ * gn[j]; \
                const f32x4 h8_ = __builtin_elementwise_min(__builtin_elementwise_max(h_ * XN8_SCALE, (f32x4){-448.f, -448.f, -448.f, -448.f}), (f32x4){448.f, 448.f, 448.f, 448.f}); \
                int p_ = 0; p_ = __builtin_amdgcn_cvt_pk_fp8_f32(h8_[0], h8_[1], p_, false); p_ = __builtin_amdgcn_cvt_pk_fp8_f32(h8_[2], h8_[3], p_, true); ((unsigned*)(XN8 + (size_t)(m_) * D_MODEL))[F.lane + 64 * j] = (unsigned)p_; } } while (0)
            f32x4 gn[8];
#pragma unroll
            for (int j = 0; j < 8; ++j) gn[j] = *((const f32x4*)g_norm1 + F.lane + 64 * j);
            f32x4 va[8], vb[8]; int m = gw; if (m < MTOK) XN_LOAD(va, m);
#pragma unroll 1
            for (; m < MTOK; m += 2 * NGW) {
                if (m + NGW < MTOK) XN_LOAD(vb, m + NGW);
                XN_DO(va, m);
                if (m + NGW < MTOK) { if (m + 2 * NGW < MTOK) XN_LOAD(va, m + 2 * NGW); XN_DO(vb, m + NGW); } }
#undef XN_LOAD
#undef XN_DO
        }
        for (int it = gw; it < MTOK / 2; it += NGW) { const int row = 2 * it + (F.lane >> 5), i = F.lane & 31;
            const float freq = exp2f(-(float)i * (13.287712379549449f / 32.f)); const float ang = (float)positions[row] * freq;
            const double ad = (double)ang; const double k = __builtin_rint(ad * 0.15915494309189535); const float red = (float)(ad - k * 6.283185307179586);
            ROPE[(size_t)row * 32 + i] = __cosf(red); ROPE[(size_t)MTOK * 32 + (size_t)row * 32 + i] = __sinf(red); }
        for (int it = gw; it < (PHEADS * 2 * NKEYS * KD) / 512; it += NGW) { const size_t e = (size_t)it * 512 + 8 * F.lane; const f32x4 a = *(const f32x4*)(peer_keys + e), b = *(const f32x4*)(peer_keys + e + 4);
            v4u w; w.x = cvt_pk_bf16(a[0], a[1]); w.y = cvt_pk_bf16(a[2], a[3]); w.z = cvt_pk_bf16(b[0], b[1]); w.w = cvt_pk_bf16(b[2], b[3]); *(v4u*)(KEYS + e) = w; }
        for (int it = gw; it < (8 * 128 * 128) / 512; it += NGW) { const size_t e = (size_t)it * 512 + 8 * F.lane; const int t = (int)((e >> 7) & 127), s0 = (int)(e & 127);
            const f32x4 a = *(const f32x4*)(w_spatial + e), b = *(const f32x4*)(w_spatial + e + 4); float v[8] = {a[0], a[1], a[2], a[3], b[0], b[1], b[2], b[3]};
#pragma unroll
            for (int j = 0; j < 8; ++j) if (s0 + j > t) v[j] = 0.f;
            v4u w; w.x = cvt_pk_bf16(v[0], v[1]); w.y = cvt_pk_bf16(v[2], v[3]); w.z = cvt_pk_bf16(v[4], v[5]); w.w = cvt_pk_bf16(v[6], v[7]); *(v4u*)(WSP + e) = w; }
        for (size_t it = (size_t)gw * 64 + F.lane; it < (size_t)5 * MTOK; it += (size_t)NGW * 64) SQQ[it] = 0ull;
        GRID_BAR();
    }
    {
        PHASE_BEGIN();
        pg8::EpiIn E{0, IN8_DESCALE, U, GA, VG, CQKV, KR, b_gate, ROPE, SQQ, SQKV, SSUM, SSQ};
        { pg8::Gemm g{(const bf16*)XN8, (const bf16*)WIN8, MTOK, IN8_ROWS, D_MODEL / 2, D_MODEL / 2}; pg8::StaticOrder S; S.init(MTOK, IN8_ROWS, F.G, (int)blockIdx.x);
          pg8::gemm_phase<pg8::EpiIn, pg8::StaticOrder, true, true, true>(F.lds + RING_OFF, g, S, E, F.wave); }
        GRID_BAR();
    }
    {
        PHASE_BEGIN();
        { pg8::Gemm g{(const bf16*)CQKV, WUQ, MTOK, NQ_COLS, QL / 2, 512}; pg8::StaticOrder S; S.init(MTOK, NQ_COLS, F.G, (int)blockIdx.x);
          pg8::EpiQ E{Qb, SQQ, ROPE}; pg8::gemm_phase<pg8::EpiQ, pg8::StaticOrder, true, true, true>(F.lds + RING_OFF, g, S, E, F.wave); }
        { pg8::Gemm g{(const bf16*)(CQKV + QL), WUKV, MTOK, NKV_COLS, QL / 2, 512}; pg8::StaticOrder S; S.init(MTOK, NKV_COLS, F.G, (int)blockIdx.x);
          pg8::EpiKV E{Kb, Vb, SQKV}; pg8::gemm_phase<pg8::EpiKV, pg8::StaticOrder, true, true, true, true>(F.lds + RING_OFF, g, S, E, F.wave); }
        PHASE_BEGIN();
        for (int un = F.vcu; un < (MTOK / 128) * 8; un += F.G) sgu_unit(F, un, VG, U, WSP, sgu_ln_g, sgu_ln_b, b_spatial, SSUM, SSQ);
        GRID_BAR();
    }
    {
        PHASE_BEGIN();
        if (F.G == 256) { const int s = F.vcu & 7, bh = F.vcu >> 3;
#pragma unroll 1
            for (int i = 0; i < 4; ++i) { const int qb = (i == 0) ? s : (i == 1) ? 15 - s : (i == 2) ? 16 + s : 31 - s; att::attn_unit(bh, qb, Qb, Kb, KR, Vb, GA, U, (char*)lds + RING_OFF, F.lds + RING_OFF, F.wave); }
        } else {
#pragma unroll 1
            for (int un = F.vcu; un < 1024; un += F.G) att::attn_unit(un >> 5, 31 - (un & 31), Qb, Kb, KR, Vb, GA, U, (char*)lds + RING_OFF, F.lds + RING_OFF, F.wave);
        }
        GRID_BAR();
    }
    {
        PHASE_BEGIN();
        for (int it = gw * 64 + F.lane; it < MTOK; it += NGW * 64) SQQ[it] = 0ull;
        { f32x4 va[8], vb[8];
#pragma unroll 1
          for (int e = gw; e < NEXP; e += NGW) {
              if (e == gw) row8_load(va, peer_u + (size_t)e * D_MODEL, F.lane);
              row8_load(vb, peer_v + (size_t)e * D_MODEL, F.lane);
              row_to_fp8(va, PU, e, USC + e, F.lane, g_norm2);
              if (e + NGW < NEXP) row8_load(va, peer_u + (size_t)(e + NGW) * D_MODEL, F.lane);
              row_to_fp8(vb, PV, e, VSC + e, F.lane, nullptr); } }
        VM_WAIT(); __syncthreads();
        pg8::Gemm g{U, WOUT, MTOK, D_MODEL, D_MODEL, D_MODEL}; pg8::StaticOrder S; S.init(MTOK, D_MODEL, F.G, (int)blockIdx.x);
        pg8::EpiOut E{x, X1B, SQX1}; pg8::gemm_phase<pg8::EpiOut, pg8::StaticOrder, true, true>(F.lds + RING_OFF, g, S, E, F.wave);
        GRID_BAR();
    }
    {
        PHASE_BEGIN();
        pg8::Gemm g{X1B, WPQ, MTOK, D_MODEL, D_MODEL, D_MODEL}; pg8::StaticOrder S; S.init(MTOK, D_MODEL, F.G, (int)blockIdx.x);
        pg8::EpiPQ E{QP, SQX1}; pg8::gemm_phase<pg8::EpiPQ, pg8::StaticOrder, true, true>(F.lds + RING_OFF, g, S, E, F.wave);
        GRID_BAR();
    }
    {
        PHASE_BEGIN();
        { const int NH8 = (F.G % 8 == 0) ? 8 : 1, grp = (int)blockIdx.x % NH8, bi = (int)blockIdx.x / NH8, nbl = F.G / NH8;
#pragma unroll 1
          for (int h = grp; h < PHEADS; h += NH8) {
#pragma unroll
              for (int it = 0; it < 8; ++it) { const int id = it * 512 + F.tid, c = id & 15, n = (id >> 4) & 127, pp = id >> 11;
                  const v4u w = *(const v4u*)(KEYS + ((size_t)(h * 2 + pp) * NKEYS + n) * KD + 8 * c);
                  *(LAS v4u*)(F.lds + pp * 32768 + n * 256 + ((c ^ (n & 15)) << 4)) = w; }
              __syncthreads();
#pragma unroll 1
              for (int tg = bi * 8 + F.wave; tg < MTOK / 16; tg += nbl * 8) topk_unit(F, tg, h, QP, TOPI, TOPG);
              __syncthreads(); } }
        GRID_BAR();
    }
    {
        PHASE_BEGIN();
        const int NG = (F.G % 8 == 0) ? 8 : 1, grp = (int)blockIdx.x % NG, li = (int)blockIdx.x / NG, nl = F.G / NG;
        const int t0 = li * 8 + F.wave, ts = nl * 8, NTW = (MTOK - t0 + ts - 1) / ts;
#define LOAD_IDX(I, n) do { const int t_ = t0 + (n) * ts; I.i0 = __builtin_nontemporal_load(TOPI + (size_t)t_ * 128 + F.lane); I.i1 = __builtin_nontemporal_load(TOPI + (size_t)t_ * 128 + 64 + F.lane); } while (0)
#pragma unroll 1
        for (int sl = grp; sl < 16; sl += NG) {
            PeerIdx IA, IB; PeerRow RA, RB; v4u wA[16], wB[16];
            LOAD_IDX(IA, 0); pu_gather(t0, sl, F.lane, IA, wA, RA, X1B, PU); if (NTW > 1) LOAD_IDX(IB, 1);
#pragma unroll 1
            for (int n = 0; n < NTW; n += 2) {
                if (n + 2 < NTW) LOAD_IDX(IA, n + 2);
                if (n + 1 < NTW) pu_gather(t0 + (n + 1) * ts, sl, F.lane, IB, wB, RB, X1B, PU);
                pu_compute(t0 + n * ts, sl, F.lane, wA, RA, PART);
                if (n + 1 < NTW) {
                    if (n + 3 < NTW) LOAD_IDX(IB, n + 3);
                    if (n + 2 < NTW) pu_gather(t0 + (n + 2) * ts, sl, F.lane, IA, wA, RA, X1B, PU);
                    pu_compute(t0 + (n + 1) * ts, sl, F.lane, wB, RB, PART); }
            } }
#undef LOAD_IDX
        GRID_BAR();
#pragma unroll 1
        for (int t = gw; t < MTOK; t += NGW) peer_fin_token(t, F.lane, PART, TOPI, TOPG, USC, VSC, SQX1);
        GRID_BAR();
#define LOAD_IDXA(I, n) do { const int t_ = t0 + (n) * ts; I.i0 = __builtin_nontemporal_load(TOPI + (size_t)t_ * 128 + F.lane); I.i1 = __builtin_nontemporal_load(TOPI + (size_t)t_ * 128 + 64 + F.lane); \
            I.a0 = __builtin_nontemporal_load(TOPG + (size_t)t_ * 128 + F.lane); I.a1 = __builtin_nontemporal_load(TOPG + (size_t)t_ * 128 + 64 + F.lane); } while (0)
#pragma unroll 1
        for (int sl = grp; sl < 16; sl += NG) {
            PeerIdx IA, IB, IC; float xA[2], xB[2]; v4u wA[16], wB[16];
            LOAD_IDXA(IA, 0); pv_gather(t0, sl, F.lane, IA, wA, xA, X1B, PV); if (NTW > 1) LOAD_IDXA(IB, 1);
#pragma unroll 1
            for (int n = 0; n < NTW; n += 2) {
                if (n + 2 < NTW) LOAD_IDXA(IC, n + 2);
                if (n + 1 < NTW) pv_gather(t0 + (n + 1) * ts, sl, F.lane, IB, wB, xB, X1B, PV);
                pv_compute(t0 + n * ts, sl, F.lane, IA, wA, xA, X2, SQQ);
                IA = IC;
                if (n + 1 < NTW) {
                    if (n + 3 < NTW) LOAD_IDXA(IC, n + 3);
                    if (n + 2 < NTW) pv_gather(t0 + (n + 2) * ts, sl, F.lane, IA, wA, xA, X1B, PV);
                    pv_compute(t0 + (n + 1) * ts, sl, F.lane, IB, wB, xB, X2, SQQ);
                    IB = IC; }
            } }
#undef LOAD_IDXA
        GRID_BAR();
#pragma unroll 1
        for (int t = gw; t < MTOK; t += NGW) { const float rf = __builtin_amdgcn_rsqf(fx_get(SQQ + t) * (1.f / D_MODEL) + EPS);
            const f32x4* xr = (const f32x4*)(X2 + (size_t)t * D_MODEL) + F.lane; f32x4* orow = (f32x4*)(out + (size_t)t * D_MODEL) + F.lane;
#pragma unroll
            for (int j = 0; j < 8; ++j) { const f32x4 v = __builtin_nontemporal_load(xr + 64 * j), gg = *((const f32x4*)g_final + F.lane + 64 * j); f32x4 o4;
#pragma unroll
                for (int e = 0; e < 4; ++e) o4[e] = v[e] * rf * gg[e];
                __builtin_nontemporal_store(o4, orow + 64 * j); } }
    }
#undef GRID_BAR
}

extern "C" void kernel_launch(void* const* d_in, const int* in_sizes, int n_in, void* d_out, int out_size, void* d_ws, size_t ws_size, hipStream_t stream) {
    static int grid = 0;
    if (grid == 0) {
        if (n_in != 20 || in_sizes[0] != MTOK * D_MODEL || out_size != MTOK * D_MODEL || ws_size < WS_END) {
            fprintf(stderr, "kernel_launch: unexpected shapes (n_in %d, in0 %d, out %d, ws %zu); nothing launched\n", n_in, n_in > 0 ? in_sizes[0] : -1, out_size, ws_size); grid = -1; return; }
        int dev = 0, cus = 0;
        if (hipGetDevice(&dev) != hipSuccess || hipDeviceGetAttribute(&cus, hipDeviceAttributeMultiprocessorCount, dev) != hipSuccess) { fprintf(stderr, "kernel_launch: device query failed\n"); grid = -1; return; }
        if (hipFuncSetAttribute((const void*)mk_fwd, hipFuncAttributeMaxDynamicSharedMemorySize, LDS_BYTES) != hipSuccess) { fprintf(stderr, "kernel_launch: hipFuncSetAttribute failed\n"); grid = -1; return; }
        (void)hipGetLastError();
        grid = cus;
    }
    if (grid < 0) return;
    (void)hipMemsetAsync((char*)d_ws + WS_CTL, 0, CTL_ZERO_BYTES, stream);
    Args a{};
    for (int i = 0; i < 20; ++i) a.in[i] = (const float*)d_in[i];
    a.out = (float*)d_out; a.ws = (unsigned char*)d_ws;
    hipLaunchKernelGGL(mk_fwd, dim3(grid), dim3(512), LDS_BYTES, stream, a);
    const hipError_t le = hipPeekAtLastError();
    if (le != hipSuccess) fprintf(stderr, "kernel_launch: launch failed: %s\n", hipGetErrorName(le));
}
```

```cpp
#include <hip/hip_runtime.h>
#include <hip/hip_bf16.h>
#include <cstdio>
#include <cstdint>


constexpr int D_MODEL = 2048, NB = 2, SEQL = 8192, MTOK = NB * SEQL;
constexpr int NHEAD = 16, QL = 512, DN = 128, DR = 64, DVH = 128, DQK = 192;
constexpr int IN_COLS = 9280, IN16_ROWS = 2048, IN8_ROWS = 9472;
constexpr float Q8_SCALE = 64.f, K8_SCALE = 8.f, V8_SCALE = 8.f;
constexpr float XN8_SCALE = 8.f, WIN8_SCALE = 64.f, IN8_DESCALE = 1.f / 512.f;
constexpr int NQ_COLS = NHEAD * DQK, NKV_COLS = NHEAD * (DN + DVH);
constexpr int PHEADS = 8, NKEYS = 128, TOPK = 16, KD = 128, NEXP = 16384;
constexpr float EPS = 1e-6f;
constexpr float FXS = 16777216.f, FXI = 1.f / 16777216.f;
constexpr float C2Q = 0.07216878364870322f * 1.4426950408889634f;

constexpr size_t MiB = 1u << 20;
constexpr size_t WS_CTL = 0, CTL_ZERO_BYTES = 32 * 1024;
constexpr size_t WS_KEYS = 1 * MiB, WS_WSP = 1 * MiB + 512 * 1024;
constexpr size_t WS_WUQ = 2 * MiB, WS_WUKV = 5 * MiB, WS_WOUT = 9 * MiB, WS_WPQ = 17 * MiB;
constexpr size_t WS_ROPE = 27 * MiB;
constexpr size_t WS_WIN8 = 46 * MiB;
constexpr size_t WS_XN8 = 66 * MiB;
constexpr size_t WS_Q = 32 * MiB;
constexpr size_t WS_CQKV = 128 * MiB;
constexpr size_t WS_U = 160 * MiB;
constexpr size_t WS_VG = 224 * MiB;
constexpr size_t WS_GA = 288 * MiB;
constexpr size_t WS_V = 352 * MiB;
constexpr size_t WS_K = 416 * MiB;
constexpr size_t WS_KR = 504 * MiB;
constexpr size_t WS_X2 = 288 * MiB;
constexpr size_t WS_X1B = 96 * MiB;
constexpr size_t WS_PU = 32 * MiB, WS_PV = 64 * MiB;
constexpr size_t WS_X1Q = 160 * MiB, WS_XS = 192 * MiB;
constexpr size_t WS_PART = 288 * MiB;
constexpr size_t WS_PSC = 31 * MiB;
constexpr size_t WS_QP = 224 * MiB;
constexpr size_t WS_TOPI = 480 * MiB, WS_TOPG = 488 * MiB;
constexpr size_t WS_END = 512 * MiB;
constexpr int CW_BAR = 4096;
constexpr size_t CTL_STATS = 128 * 1024;
constexpr int RING_OFF = 0, RING_BYTES = 131072;
constexpr int LDSCTL_OFF = RING_BYTES, MISC_OFF = LDSCTL_OFF + 320;
constexpr int LDS_BYTES = 147456;

#define GAS __attribute__((address_space(1)))
#define LAS __attribute__((address_space(3)))
typedef unsigned short bf16;
typedef unsigned v4u __attribute__((ext_vector_type(4)));
typedef unsigned v2u __attribute__((ext_vector_type(2)));
typedef float f32x4 __attribute__((ext_vector_type(4)));
typedef float f32x16 __attribute__((ext_vector_type(16)));
typedef short bf16x8 __attribute__((ext_vector_type(8)));
typedef short s16x4 __attribute__((ext_vector_type(4)));
typedef int v8i __attribute__((ext_vector_type(8)));
typedef unsigned long long u64;
#define LDS_WAIT() asm volatile("s_waitcnt lgkmcnt(0)" ::: "memory")
#define VM_WAIT() asm volatile("s_waitcnt vmcnt(0)" ::: "memory")
#define SBAR() __builtin_amdgcn_sched_barrier(0)

typedef float f32x2_t __attribute__((ext_vector_type(2))); typedef __bf16 bf16x2_t __attribute__((ext_vector_type(2)));
__device__ __forceinline__ unsigned cvt_pk_bf16(float lo, float hi) { f32x2_t v = {lo, hi}; bf16x2_t b = __builtin_convertvector(v, bf16x2_t); return __builtin_bit_cast(unsigned, b); }
__device__ __forceinline__ unsigned pack_fp8x4(f32x4 v) {
    v = __builtin_elementwise_min(__builtin_elementwise_max(v, (f32x4){-448.f, -448.f, -448.f, -448.f}), (f32x4){448.f, 448.f, 448.f, 448.f});
    int p = 0; p = __builtin_amdgcn_cvt_pk_fp8_f32(v[0], v[1], p, false); p = __builtin_amdgcn_cvt_pk_fp8_f32(v[2], v[3], p, true); return (unsigned)p; }
__device__ __forceinline__ float bf_lo(unsigned w) { return __uint_as_float(w << 16); }
__device__ __forceinline__ float bf_hi(unsigned w) { return __uint_as_float(w & 0xffff0000u); }
__device__ __forceinline__ float gelu_t(float x) { const float t = x * (1.f + 0.044715f * x * x); const float e = __builtin_amdgcn_exp2f(-2.3022081986f * t); return x * __builtin_amdgcn_rcpf(1.f + e); }
__device__ __forceinline__ float sigmoid_f(float y) { return __builtin_amdgcn_rcpf(1.f + __builtin_amdgcn_exp2f(-1.4426950409f * y)); }
__device__ __forceinline__ void fx_add(u64* p, float v) { const long long q = __float2ll_rn(v * FXS); atomicAdd(p, (u64)q); }
__device__ __forceinline__ float fx_get(const u64* p) { return (float)((double)(long long)(*p) * (double)FXI); }
__device__ __forceinline__ int lane_id() { int l; asm volatile("v_mbcnt_lo_u32_b32 %0, -1, 0\n\tv_mbcnt_hi_u32_b32 %0, -1, %0" : "=v"(l)); return l; }

__device__ __forceinline__ float shx(float v, int o, int lane) { return __builtin_bit_cast(float, __builtin_amdgcn_ds_bpermute((lane ^ o) << 2, __builtin_bit_cast(int, v))); }
__device__ __forceinline__ float wave_sum(float v, int lane) {
#pragma unroll
    for (int o = 1; o < 64; o <<= 1) v += shx(v, o, lane);
    return v;
}

namespace pg8 {
#define PG8_LAS __attribute__((address_space(3)))
typedef unsigned short bf16_t;
constexpr int BM = 256, BK = 64, HALF = 128, HTB = HALF * BK * 2, STAGE_BYTES = 8 * HTB, NXCD = 8, WGM = 8;
__host__ __device__ __forceinline__ int lds_byte(int r, int c) { const int st = (r >> 4) * 2 + (c >> 5), rr = r & 15, cc = c & 31, ob = rr * 64 + cc * 2; return st * 1024 + (ob ^ (((ob >> 9) & 1) << 5)); }
__host__ __device__ __forceinline__ void stage_rc(int b, int& R, int& C) { const int st = b / 1024, sb = b % 1024, swz = sb ^ (((sb >> 9) & 1) << 5); R = (st >> 1) * 16 + swz / 64; C = (st & 1) * 32 + (swz % 64) / 2; }
__host__ __device__ __forceinline__ int perm32(int rho) { const int n = rho >> 4, i = rho & 15; return 8 * (i >> 2) + 4 * n + (i & 3); }
struct Unit { int pm, pn; };
struct Gemm { const bf16_t* A; const bf16_t* Bt; int M, N, K, lda; };
struct StaticOrder {
    int nM, nN, nwg, G, c;
    __host__ __device__ void init(int M, int N, int G_, int c_) { nM = M / BM; nN = N / BM; nwg = nM * nN; G = G_; c = c_; }
    __host__ __device__ bool next(int i, Unit& u) const {
        const long L = (long)i * G + c; if (L >= nwg) return false;
        int wgid = (int)L; { const int q = nwg / NXCD, r = nwg % NXCD, xcd = wgid % NXCD, off = wgid / NXCD; wgid = (xcd < r ? xcd * (q + 1) : r * (q + 1) + (xcd - r) * q) + off; }
        const int nig = WGM * nN, gid = wgid / nig, fm = gid * WGM, gsz = (nM - fm) < WGM ? (nM - fm) : WGM;
        u.pm = fm + ((wgid % nig) % gsz); u.pn = (wgid % nig) / gsz; return true;
    }
};
template <class Epi, class Sched, bool ALIGN_EPI = false, bool SP2 = false, bool F8 = false, bool SWAP1 = false>
__device__ __forceinline__ void gemm_phase(PG8_LAS unsigned char* lds, const Gemm g, const Sched& S, const Epi& E, const int wave) {
    int tid = wave * 64 + lane_id(); asm volatile("" : "+v"(tid));
    const int wid = __builtin_amdgcn_readfirstlane(tid >> 6), lane = tid & 63, wr = wid >> 2, wc = wid & 3, fr = lane & 15, fq = lane >> 4;
    const int K = g.K, nt = K / BK, lda = g.lda;
    unsigned voffA[2], voffB[2];
#pragma unroll
    for (int i = 0; i < 2; ++i) { int R, C; stage_rc(tid * 16 + i * 8192, R, C); const int Rb = Epi::PERM ? ((R & ~31) + perm32(R & 31)) : R;
        voffA[i] = (unsigned)(R * lda + C) * 2u; voffB[i] = (unsigned)(Rb * K + C) * 2u; }
    const size_t kstep = (size_t)(BK * 2);
    const size_t hstepA = (size_t)HALF * lda * 2, hstepB = (size_t)HALF * K * 2;
    const size_t tstepA = 2 * hstepA, tstepB = 2 * hstepB;
    const unsigned ldsw = (unsigned)wid * 1024u;
    const int aoff = lds_byte(wr * 64 + fr, fq * 8), boff = lds_byte(wc * 32 + fr, fq * 8);
#define PG8_SA(b, h) (((b) * 2 + (h)) * HTB)
#define PG8_SB(b, h) ((4 + (b) * 2 + (h)) * HTB)
#define PG8_STAGE(bufoff, gbase, voff) do { _Pragma("unroll") for (int _i = 0; _i < 2; ++_i) \
        { unsigned vo_ = (voff)[_i]; asm volatile("" : "+v"(vo_)); __builtin_amdgcn_global_load_lds((const unsigned*)((const char*)(gbase) + vo_), (PG8_LAS unsigned*)(lds + (bufoff) + ldsw + _i * 8192), 16, 0, 0); } } while (0)
#define PG8_LDA(dst, b, h) do { _Pragma("unroll") for (int m = 0; m < 4; ++m) _Pragma("unroll") for (int k = 0; k < 2; ++k) dst[m][k] = *(const PG8_LAS bf16x8*)(lds + PG8_SA(b, h) + aoff + m * 2048 + k * 1024); } while (0)
#define PG8_LDB(dst, b, h) do { _Pragma("unroll") for (int n = 0; n < 2; ++n) _Pragma("unroll") for (int k = 0; k < 2; ++k) dst[n][k] = *(const PG8_LAS bf16x8*)(lds + PG8_SB(b, h) + boff + n * 2048 + k * 1024); } while (0)
#define PG8_CAT(x) __builtin_bit_cast(v8i, __builtin_shufflevector((x)[0], (x)[1], 0, 1, 2, 3, 4, 5, 6, 7, 8, 9, 10, 11, 12, 13, 14, 15))
#define PG8_MMA(ai, bj, At, Bt) do { __builtin_amdgcn_s_setprio(1); _Pragma("unroll") for (int m = 0; m < 4; ++m) _Pragma("unroll") for (int n = 0; n < 2; ++n) { \
        if constexpr (F8 && SWAP1 && (bj) == 1) acc[ai][bj][m][n] = __builtin_amdgcn_mfma_scale_f32_16x16x128_f8f6f4(PG8_CAT(At[m]), PG8_CAT(Bt[n]), acc[ai][bj][m][n], 0, 0, 0, 0x7f7f7f7f, 0, 0x7f7f7f7f); \
        else if constexpr (F8) acc[ai][bj][m][n] = __builtin_amdgcn_mfma_scale_f32_16x16x128_f8f6f4(PG8_CAT(Bt[n]), PG8_CAT(At[m]), acc[ai][bj][m][n], 0, 0, 0, 0x7f7f7f7f, 0, 0x7f7f7f7f); \
        else { _Pragma("unroll") for (int k = 0; k < 2; ++k) acc[ai][bj][m][n] = __builtin_amdgcn_mfma_f32_16x16x32_bf16(Bt[n][k], At[m][k], acc[ai][bj][m][n], 0, 0, 0); } } __builtin_amdgcn_s_setprio(0); } while (0)
#define PG8_WAIT_V(n) asm volatile("s_waitcnt vmcnt(" #n ")" ::: "memory")
#define PG8_WAIT_L(n) asm volatile("s_waitcnt lgkmcnt(" #n ")" ::: "memory")
#define PG8_BAR __builtin_amdgcn_s_barrier()
#define PG8_SCHED __builtin_amdgcn_sched_barrier(0)
    Unit cur, nxt; int ui = 0;
    if (!S.next(0, cur)) return;
    f32x4 acc[2][2][4][2];
#pragma unroll
    for (int a = 0; a < 2; ++a)
#pragma unroll
        for (int b = 0; b < 2; ++b)
#pragma unroll
            for (int m = 0; m < 4; ++m)
#pragma unroll
                for (int n = 0; n < 2; ++n) acc[a][b][m][n] = (f32x4){0.f, 0.f, 0.f, 0.f};
    bf16x8 At[4][2], B0[2][2], B1[2][2];
    const char* cA = (const char*)g.A + (size_t)cur.pm * tstepA; const char* cB = (const char*)g.Bt + (size_t)cur.pn * tstepB;
    if constexpr (SP2) {
        PG8_STAGE(PG8_SB(0, 0), cB, voffB); PG8_STAGE(PG8_SB(0, 1), cB + hstepB, voffB); PG8_STAGE(PG8_SA(0, 0), cA, voffA); PG8_STAGE(PG8_SA(0, 1), cA + hstepA, voffA);
        if (wr == 1) PG8_BAR;
        PG8_WAIT_V(2); PG8_BAR;
        PG8_STAGE(PG8_SB(1, 0), cB + kstep, voffB); PG8_STAGE(PG8_SA(1, 0), cA + kstep, voffA); PG8_STAGE(PG8_SB(1, 1), cB + hstepB + kstep, voffB);
        PG8_WAIT_V(6); PG8_BAR;
    } else {
        PG8_STAGE(PG8_SB(0, 0), cB, voffB); PG8_STAGE(PG8_SA(0, 0), cA, voffA); PG8_STAGE(PG8_SB(0, 1), cB + hstepB, voffB); PG8_STAGE(PG8_SA(0, 1), cA + hstepA, voffA);
        if (wr == 1) PG8_BAR;
        PG8_WAIT_V(4); PG8_BAR;
        PG8_STAGE(PG8_SB(1, 0), cB + kstep, voffB); PG8_STAGE(PG8_SA(1, 0), cA + kstep, voffA); PG8_STAGE(PG8_SB(1, 1), cB + hstepB + kstep, voffB);
        PG8_WAIT_V(6); PG8_BAR;
    }
    for (;;) {
        const bool has_next = S.next(ui + 1, nxt);
        const char* nA = has_next ? (const char*)g.A + (size_t)nxt.pm * tstepA : cA; const char* nB = has_next ? (const char*)g.Bt + (size_t)nxt.pn * tstepB : cB;
#pragma unroll 1
        for (int t = 0; t < nt; t += 2) {
            const bool last = (t == nt - 2);
            const char* a1 = cA + (size_t)(t + 1) * kstep;
            const char* a2 = last ? nA : cA + (size_t)(t + 2) * kstep; const char* b2 = last ? nB : cB + (size_t)(t + 2) * kstep;
            const char* a3 = a2 + kstep; const char* b3 = b2 + kstep;
            if constexpr (SP2) {
            PG8_LDB(B0, 0, 0); PG8_LDB(B1, 0, 1); PG8_SCHED; PG8_LDA(At, 0, 0); PG8_STAGE(PG8_SA(1, 1), a1 + hstepA, voffA);
            PG8_WAIT_V(8); PG8_WAIT_L(0); PG8_BAR; PG8_MMA(0, 0, At, B0); PG8_MMA(0, 1, At, B1); PG8_BAR; PG8_SCHED;
            PG8_LDA(At, 0, 1); PG8_STAGE(PG8_SB(0, 0), b2, voffB); PG8_STAGE(PG8_SB(0, 1), b2 + hstepB, voffB); PG8_STAGE(PG8_SA(0, 0), a2, voffA);
            PG8_WAIT_V(8); PG8_WAIT_L(0); PG8_BAR; PG8_MMA(1, 0, At, B0); PG8_MMA(1, 1, At, B1); PG8_BAR; PG8_SCHED;
            PG8_LDB(B0, 1, 0); PG8_LDB(B1, 1, 1); PG8_SCHED; PG8_LDA(At, 1, 0); PG8_STAGE(PG8_SA(0, 1), a2 + hstepA, voffA);
            PG8_WAIT_V(8); PG8_WAIT_L(0); PG8_BAR; PG8_MMA(0, 0, At, B0); PG8_MMA(0, 1, At, B1); PG8_BAR; PG8_SCHED;
            PG8_LDA(At, 1, 1); PG8_STAGE(PG8_SB(1, 0), b3, voffB); PG8_STAGE(PG8_SB(1, 1), b3 + hstepB, voffB); PG8_STAGE(PG8_SA(1, 0), a3, voffA);
            PG8_WAIT_V(8); PG8_WAIT_L(0); PG8_BAR; PG8_MMA(1, 0, At, B0); PG8_MMA(1, 1, At, B1); PG8_BAR; PG8_SCHED;
            } else {
            PG8_LDB(B0, 0, 0); PG8_SCHED; PG8_LDA(At, 0, 0); PG8_STAGE(PG8_SA(1, 1), a1 + hstepA, voffA);
            PG8_WAIT_L(8); PG8_BAR; PG8_WAIT_L(0); PG8_MMA(0, 0, At, B0); PG8_BAR; PG8_SCHED;
            PG8_LDB(B1, 0, 1); PG8_STAGE(PG8_SB(0, 0), b2, voffB);
            PG8_BAR; PG8_WAIT_L(0); PG8_MMA(0, 1, At, B1); PG8_BAR;
            PG8_LDA(At, 0, 1); PG8_STAGE(PG8_SA(0, 0), a2, voffA);
            PG8_BAR; PG8_WAIT_L(0); PG8_MMA(1, 0, At, B0); PG8_BAR; PG8_SCHED;
            PG8_STAGE(PG8_SB(0, 1), b2 + hstepB, voffB);
            PG8_WAIT_V(6); PG8_BAR; PG8_MMA(1, 1, At, B1); PG8_BAR;
            PG8_LDB(B0, 1, 0); PG8_SCHED; PG8_LDA(At, 1, 0); PG8_STAGE(PG8_SA(0, 1), a2 + hstepA, voffA);
            PG8_WAIT_L(8); PG8_BAR; PG8_WAIT_L(0); PG8_MMA(0, 0, At, B0); PG8_BAR; PG8_SCHED;
            PG8_LDB(B1, 1, 1); PG8_STAGE(PG8_SB(1, 0), b3, voffB);
            PG8_BAR; PG8_WAIT_L(0); PG8_MMA(0, 1, At, B1); PG8_BAR;
            PG8_LDA(At, 1, 1); PG8_STAGE(PG8_SA(1, 0), a3, voffA);
            PG8_BAR; PG8_WAIT_L(0); PG8_MMA(1, 0, At, B0); PG8_BAR; PG8_SCHED;
            PG8_STAGE(PG8_SB(1, 1), b3 + hstepB, voffB);
            PG8_WAIT_V(6); PG8_BAR; PG8_MMA(1, 1, At, B1); PG8_BAR;
            }
        }
        if constexpr (ALIGN_EPI) { if (wr == 0) PG8_BAR; }
        { const int le = lane_id(); E(acc, cur, wr, wc, le & 15, le >> 4); }
        if (!has_next) break;
#pragma unroll
        for (int a = 0; a < 2; ++a)
#pragma unroll
            for (int b = 0; b < 2; ++b)
#pragma unroll
                for (int m = 0; m < 4; ++m)
#pragma unroll
                    for (int n = 0; n < 2; ++n) acc[a][b][m][n] = (f32x4){0.f, 0.f, 0.f, 0.f};
        cur = nxt; cA = nA; cB = nB; ++ui;
        if constexpr (ALIGN_EPI) { if (wr == 1) PG8_BAR; }
    }
    PG8_WAIT_V(0);
    if constexpr (!ALIGN_EPI) { if (wr == 0) PG8_BAR; }
    PG8_BAR;
#undef PG8_SA
#undef PG8_SB
#undef PG8_STAGE
#undef PG8_LDA
#undef PG8_LDB
#undef PG8_MMA
#undef PG8_CAT
#undef PG8_WAIT_V
#undef PG8_WAIT_L
#undef PG8_BAR
#undef PG8_SCHED
}

#define EPI_ROWS(ai, m) (u.pm * BM + wr * 64 + fr + (ai) * HALF + (m) * 16)
struct EpiIn {
    static constexpr bool PERM = true;
    int mode; float sc;
    bf16_t *U, *GA, *VG; unsigned char *CQKV, *KR; const float* bgate; const float* rope; u64 *sqq, *sqkv, *ssum, *ssq;
    __device__ __forceinline__ void operator()(const f32x4 (&acc)[2][2][4][2], const Unit& u, int wr, int wc, int fr, int fq) const {
        const int pn = u.pn, cw = wc * 32 + 8 * fq;
        if (mode == 1 || pn >= 29) {
            const int c0 = (mode == 1 ? pn : pn - 29) * 256 + cw;
#pragma unroll
            for (int ai = 0; ai < 2; ++ai)
#pragma unroll
                for (int m = 0; m < 4; ++m) { const int row = EPI_ROWS(ai, m); float s = 0.f, q = 0.f;
#pragma unroll
                    for (int bj = 0; bj < 2; ++bj) { f32x4 v0 = acc[ai][bj][m][0] * sc, v1 = acc[ai][bj][m][1] * sc;
#pragma unroll
                        for (int e = 0; e < 4; ++e) { v0[e] = gelu_t(v0[e]); v1[e] = gelu_t(v1[e]); }
                        s += (v0[0] + v0[1]) + (v0[2] + v0[3]) + (v1[0] + v1[1]) + (v1[2] + v1[3]);
                        q += (v0[0] * v0[0] + v0[1] * v0[1]) + (v0[2] * v0[2] + v0[3] * v0[3]) + (v1[0] * v1[0] + v1[1] * v1[1]) + (v1[2] * v1[2] + v1[3] * v1[3]);
                        v4u w; w.x = cvt_pk_bf16(v0[0], v0[1]); w.y = cvt_pk_bf16(v0[2], v0[3]); w.z = cvt_pk_bf16(v1[0], v1[1]); w.w = cvt_pk_bf16(v1[2], v1[3]);
                        __builtin_nontemporal_store(w, (v4u*)(VG + (size_t)row * 2048 + c0 + bj * HALF)); }
                    s += shx(s, 16, fq * 16 + fr); s += shx(s, 32, fq * 16 + fr); q += shx(q, 16, fq * 16 + fr); q += shx(q, 32, fq * 16 + fr);
                    if (fq == 0) { fx_add(ssum + row, s); fx_add(ssq + row, q); } }
        } else if (pn < 16) {
            const int c0 = pn * 128 + cw; const float* bg = bgate + 2048 + c0;
            const f32x4 b0 = *(const f32x4*)bg, b1 = *(const f32x4*)(bg + 4);
#pragma unroll
            for (int ai = 0; ai < 2; ++ai)
#pragma unroll
                for (int m = 0; m < 4; ++m) { const int row = EPI_ROWS(ai, m);
                    f32x4 v0 = acc[ai][0][m][0] * sc, v1 = acc[ai][0][m][1] * sc; const f32x4 g0 = acc[ai][1][m][0] * sc + b0, g1 = acc[ai][1][m][1] * sc + b1;
#pragma unroll
                    for (int e = 0; e < 4; ++e) { v0[e] = gelu_t(v0[e]) * sigmoid_f(g0[e]); v1[e] = gelu_t(v1[e]) * sigmoid_f(g1[e]); }
                    v4u w; w.x = cvt_pk_bf16(v0[0], v0[1]); w.y = cvt_pk_bf16(v0[2], v0[3]); w.z = cvt_pk_bf16(v1[0], v1[1]); w.w = cvt_pk_bf16(v1[2], v1[3]);
                    __builtin_nontemporal_store(w, (v4u*)(U + (size_t)row * 2048 + c0)); }
        } else if (pn < 24) {
            const int c0 = (pn - 16) * 256 + cw; const float* bg = bgate + c0;
            f32x4 bv[2][2];
#pragma unroll
            for (int bj = 0; bj < 2; ++bj) { bv[bj][0] = *(const f32x4*)(bg + bj * HALF); bv[bj][1] = *(const f32x4*)(bg + bj * HALF + 4); }
#pragma unroll
            for (int ai = 0; ai < 2; ++ai)
#pragma unroll
                for (int m = 0; m < 4; ++m) { const int row = EPI_ROWS(ai, m);
#pragma unroll
                    for (int bj = 0; bj < 2; ++bj) { f32x4 v0 = acc[ai][bj][m][0] * sc + bv[bj][0], v1 = acc[ai][bj][m][1] * sc + bv[bj][1];
#pragma unroll
                        for (int e = 0; e < 4; ++e) { v0[e] = sigmoid_f(v0[e]); v1[e] = sigmoid_f(v1[e]); }
                        v4u w; w.x = cvt_pk_bf16(v0[0], v0[1]); w.y = cvt_pk_bf16(v0[2], v0[3]); w.z = cvt_pk_bf16(v1[0], v1[1]); w.w = cvt_pk_bf16(v1[2], v1[3]);
                        __builtin_nontemporal_store(w, (v4u*)(GA + (size_t)row * 2048 + c0 + bj * HALF)); } }
        } else if (pn < 28) {
            const int pc = pn - 24; u64* sq = pc < 2 ? sqq : sqkv;
#pragma unroll
            for (int ai = 0; ai < 2; ++ai)
#pragma unroll
                for (int m = 0; m < 4; ++m) { const int row = EPI_ROWS(ai, m); float s = 0.f;
#pragma unroll
                    for (int bj = 0; bj < 2; ++bj) { const f32x4 v0 = acc[ai][bj][m][0] * sc, v1 = acc[ai][bj][m][1] * sc;
                        s += (v0[0] * v0[0] + v0[1] * v0[1]) + (v0[2] * v0[2] + v0[3] * v0[3]) + (v1[0] * v1[0] + v1[1] * v1[1]) + (v1[2] * v1[2] + v1[3] * v1[3]);
                        v2u w; w.x = pack_fp8x4(v0 * XN8_SCALE); w.y = pack_fp8x4(v1 * XN8_SCALE);
                        *(v2u*)(CQKV + (size_t)row * 1024 + pc * 256 + bj * HALF + cw) = w; }
                    s += shx(s, 16, fq * 16 + fr); s += shx(s, 32, fq * 16 + fr);
                    if (fq == 0) fx_add(sq + row, s); }
        } else {
            if (wc < 2) {
                const int i0 = cw >> 1;
#pragma unroll
                for (int ai = 0; ai < 2; ++ai)
#pragma unroll
                    for (int m = 0; m < 4; ++m) { const int row = EPI_ROWS(ai, m);
                        const f32x4 c4 = *(const f32x4*)(rope + (size_t)row * 32 + i0), s4 = *(const f32x4*)(rope + (size_t)MTOK * 32 + (size_t)row * 32 + i0);
                        const f32x4 v0 = acc[ai][0][m][0] * sc, v1 = acc[ai][0][m][1] * sc;
                        const f32x4 r0 = {v0[0] * c4[0] - v0[1] * s4[0], v0[0] * s4[0] + v0[1] * c4[0], v0[2] * c4[1] - v0[3] * s4[1], v0[2] * s4[1] + v0[3] * c4[1]};
                        const f32x4 r1 = {v1[0] * c4[2] - v1[1] * s4[2], v1[0] * s4[2] + v1[1] * c4[2], v1[2] * c4[3] - v1[3] * s4[3], v1[2] * s4[3] + v1[3] * c4[3]};
                        v2u w; w.x = pack_fp8x4(r0 * K8_SCALE); w.y = pack_fp8x4(r1 * K8_SCALE);
                        *(v2u*)(KR + (size_t)row * DR + cw) = w; }
            }
        }
    }
};
struct EpiQ {
    static constexpr bool PERM = true;
    unsigned char* Q; const u64* sqq; const float* rope;
    __device__ __forceinline__ void operator()(const f32x4 (&acc)[2][2][4][2], const Unit& u, int wr, int wc, int fr, int fq) const {
        const int cw = wc * 32 + 8 * fq;
#pragma unroll
        for (int ai = 0; ai < 2; ++ai)
#pragma unroll
            for (int m = 0; m < 4; ++m) { const int row = EPI_ROWS(ai, m); const int b = row >> 13, s = row & 8191;
                const float rq = __builtin_amdgcn_rsqf(fx_get(sqq + row) * (1.f / QL) + EPS) * (C2Q * IN8_DESCALE * Q8_SCALE);
#pragma unroll
                for (int bj = 0; bj < 2; ++bj) { const int colg = u.pn * 256 + bj * HALF + cw; const int head = colg / DQK, dd = colg - head * DQK;
                    f32x4 v0 = acc[ai][bj][m][0] * rq, v1 = acc[ai][bj][m][1] * rq;
                    if (dd >= DN) { const int i0 = (dd - DN) >> 1;
                        const f32x4 c4 = *(const f32x4*)(rope + (size_t)row * 32 + i0), s4 = *(const f32x4*)(rope + (size_t)MTOK * 32 + (size_t)row * 32 + i0);
                        const f32x4 r0 = {v0[0] * c4[0] - v0[1] * s4[0], v0[0] * s4[0] + v0[1] * c4[0], v0[2] * c4[1] - v0[3] * s4[1], v0[2] * s4[1] + v0[3] * c4[1]};
                        const f32x4 r1 = {v1[0] * c4[2] - v1[1] * s4[2], v1[0] * s4[2] + v1[1] * c4[2], v1[2] * c4[3] - v1[3] * s4[3], v1[2] * s4[3] + v1[3] * c4[3]};
                        v0 = r0; v1 = r1; }
                    v2u w; w.x = pack_fp8x4(v0); w.y = pack_fp8x4(v1);
                    *(v2u*)(Q + ((size_t)(b * NHEAD + head) * SEQL + s) * DQK + dd) = w; } }
    }
};
struct EpiKV {
    static constexpr bool PERM = true;
    unsigned char* Kb; unsigned char* Vt; const u64* sqkv;
    __device__ __forceinline__ void operator()(const f32x4 (&acc)[2][2][4][2], const Unit& u, int wr, int wc, int fr, int fq) const {
        const int cw = wc * 32 + 8 * fq, head = u.pn;
#pragma unroll
        for (int ai = 0; ai < 2; ++ai)
#pragma unroll
            for (int m = 0; m < 4; ++m) {
                { const int row = EPI_ROWS(ai, m); const int b = row >> 13, s = row & 8191;
                  const float rk = __builtin_amdgcn_rsqf(fx_get(sqkv + row) * (1.f / QL) + EPS) * (IN8_DESCALE * K8_SCALE); const size_t tr = (size_t)(b * NHEAD + head) * SEQL + s;
                  v2u w; w.x = pack_fp8x4(acc[ai][0][m][0] * rk); w.y = pack_fp8x4(acc[ai][0][m][1] * rk); *(v2u*)(Kb + tr * DN + cw) = w; }
                { const int row0 = u.pm * BM + wr * 64 + ai * HALF + m * 16 + 4 * fq; const int b = row0 >> 13, s0 = row0 & 8191;
                  f32x4 rk4;
#pragma unroll
                  for (int e = 0; e < 4; ++e) rk4[e] = __builtin_amdgcn_rsqf(fx_get(sqkv + row0 + e) * (1.f / QL) + EPS) * (IN8_DESCALE * V8_SCALE);
                  const int slot = (s0 & ~63) + 32 * (fq & 1) + 4 * (2 * m + (fq >> 1));
#pragma unroll
                  for (int n = 0; n < 2; ++n) { const int dv = wc * 32 + 8 * (fr >> 2) + 4 * n + (fr & 3);
                      *(unsigned*)(Vt + ((size_t)(b * NHEAD + head) * DVH + dv) * SEQL + slot) = pack_fp8x4(acc[ai][1][m][n] * rk4); } }
            }
    }
};
struct EpiOut {
    static constexpr bool PERM = false;
    const float* x; bf16_t* X1B; u64* sqx;
    __device__ __forceinline__ void operator()(const f32x4 (&acc)[2][2][4][2], const Unit& u, int wr, int wc, int fr, int fq) const {
        const int col0 = u.pn * BM + wc * 32 + 4 * fq;
#pragma unroll
        for (int ai = 0; ai < 2; ++ai)
#pragma unroll
            for (int m = 0; m < 4; ++m) { const int row = EPI_ROWS(ai, m); float s = 0.f;
#pragma unroll
                for (int bj = 0; bj < 2; ++bj)
#pragma unroll
                    for (int n = 0; n < 2; ++n) { const size_t off = (size_t)row * D_MODEL + col0 + bj * HALF + n * 16;
                        const f32x4 v = *(const f32x4*)(x + off) + acc[ai][bj][m][n];
                        s += (v[0] * v[0] + v[1] * v[1]) + (v[2] * v[2] + v[3] * v[3]);
                        v2u w; w.x = cvt_pk_bf16(v[0], v[1]); w.y = cvt_pk_bf16(v[2], v[3]); *(v2u*)(X1B + off) = w; }
                s += shx(s, 16, fq * 16 + fr); s += shx(s, 32, fq * 16 + fr);
                if (fq == 0) fx_add(sqx + row, s); }
    }
};
struct EpiPQ {
    static constexpr bool PERM = true;
    bf16_t* QP; const u64* sqx;
    __device__ __forceinline__ void operator()(const f32x4 (&acc)[2][2][4][2], const Unit& u, int wr, int wc, int fr, int fq) const {
        const int cw = u.pn * 256 + wc * 32 + 8 * fq;
#pragma unroll
        for (int ai = 0; ai < 2; ++ai)
#pragma unroll
            for (int m = 0; m < 4; ++m) { const int row = EPI_ROWS(ai, m);
                const float r2 = __builtin_amdgcn_rsqf(fx_get(sqx + row) * (1.f / D_MODEL) + EPS);
#pragma unroll
                for (int bj = 0; bj < 2; ++bj) { const f32x4 v0 = acc[ai][bj][m][0] * r2, v1 = acc[ai][bj][m][1] * r2;
                    v4u w; w.x = cvt_pk_bf16(v0[0], v0[1]); w.y = cvt_pk_bf16(v0[2], v0[3]); w.z = cvt_pk_bf16(v1[0], v1[1]); w.w = cvt_pk_bf16(v1[2], v1[3]);
                    __builtin_nontemporal_store(w, (v4u*)(QP + (size_t)row * D_MODEL + cw + bj * HALF)); } }
    }
};
#undef EPI_ROWS
}

typedef GAS unsigned gu32;
#define RLX_AGENT __ATOMIC_RELAXED, __HIP_MEMORY_SCOPE_AGENT
#define XB_TMO      128
#define XB_XCNT(j)  (256  + 64 * (j))
#define XB_XSUB(j)  (1280 + 64 * (j))
#define XB_XGEN(j)  (2304 + 64 * (j))
#define XB_TOP      3328
#define XB_TOPGEN   3392
#define XCD_BAR_WORDS 3456
#define XB_SPIN_CAP (1u << 18)
__device__ __forceinline__ unsigned xb_ld(unsigned* p)              { return __hip_atomic_load(p, __ATOMIC_RELAXED, __HIP_MEMORY_SCOPE_AGENT); }
__device__ __forceinline__ unsigned xb_add(unsigned* p, unsigned v) { return __hip_atomic_fetch_add(p, v, __ATOMIC_RELAXED, __HIP_MEMORY_SCOPE_AGENT); }
__device__ __forceinline__ unsigned xb_xcc_id() { return (unsigned)__builtin_amdgcn_s_getreg((3 << 11) | 20) & 0xFu; }
#define XB_SPIN(cond, bar) do { unsigned _sp = 0; while (cond) { __builtin_amdgcn_s_sleep(1); \
    if ((++_sp & 255u) == 0u) { if (xb_ld(&(bar)[XB_TMO])) break; if (_sp > XB_SPIN_CAP) { atomicAdd(&(bar)[XB_TMO], 1u); break; } } } } while (0)
struct XcdBarrier { unsigned* bar; unsigned x; volatile LAS unsigned* st; int wave; };
__device__ __forceinline__ XcdBarrier xcd_barrier_post(unsigned* bar, volatile LAS unsigned* st, int wave) {
    XcdBarrier b; b.bar = bar; b.x = xb_xcc_id(); b.st = st; b.wave = wave;
    if (wave == 0 && lane_id() == 0) (void)xb_add(&bar[XB_XCNT(b.x)], 1u);
    return b;
}
__device__ __forceinline__ void xcd_barrier_complete(unsigned* bar, unsigned x, unsigned& nloc, unsigned& nx) {
    const unsigned G = gridDim.x * gridDim.y * gridDim.z;
    unsigned sum, cnt, mine, sp = 0u;
    for (;;) {
        sum = 0u; cnt = 0u; mine = 0u;
#pragma unroll
        for (unsigned j = 0; j < 16; ++j) { const unsigned c = xb_ld(&bar[XB_XCNT(j)]); sum += c; cnt += (c > 0u) ? 1u : 0u; mine = (j == x) ? c : mine; }
        if (sum == G) break;
        __builtin_amdgcn_s_sleep(1);
        if ((++sp & 255u) == 0u) { if (xb_ld(&bar[XB_TMO])) break; if (sp > XB_SPIN_CAP) { atomicAdd(&bar[XB_TMO], 1u); break; } }
    }
    nloc = mine > 0u ? mine : 1u; nx = cnt > 0u ? cnt : 1u;
}
__device__ __forceinline__ void xcd_barrier(const XcdBarrier& b) {
    asm volatile("s_waitcnt vmcnt(0)" ::: "memory");
    __syncthreads();
    if (b.wave == 0 && lane_id() == 0) {
        unsigned* bar = b.bar;
        __builtin_amdgcn_s_waitcnt(0);
        unsigned nloc = b.st[0], nx = b.st[1];
        if (nloc == 0u) { xcd_barrier_complete(bar, b.x, nloc, nx); b.st[0] = nloc; b.st[1] = nx; }
        const unsigned old = xb_add(&bar[XB_XSUB(b.x)], 1u);
        const unsigned gen = old / nloc;
        if (old + 1u == (gen + 1u) * nloc) {
            __builtin_amdgcn_fence(__ATOMIC_RELEASE, "agent");
            asm volatile("s_waitcnt vmcnt(0)" ::: "memory");
            const unsigned og = xb_add(&bar[XB_TOP], 1u);
            const unsigned tg = og / nx;
            if (og + 1u == (tg + 1u) * nx) xb_add(&bar[XB_TOPGEN], 1u);
            else XB_SPIN(xb_ld(&bar[XB_TOPGEN]) == tg, bar);
            __builtin_amdgcn_fence(__ATOMIC_ACQUIRE, "agent");
            xb_add(&bar[XB_XGEN(b.x)], 1u);
            asm volatile("s_waitcnt vmcnt(0)" ::: "memory");
        } else {
            XB_SPIN(xb_ld(&bar[XB_XGEN(b.x)]) == gen, bar);
            __builtin_amdgcn_fence(__ATOMIC_ACQUIRE, "agent");
            asm volatile("s_waitcnt vmcnt(0)" ::: "memory");
        }
    }
    __syncthreads();
}

struct Args { const float* in[20]; float* out; unsigned char* ws; };
struct Frame {
    LAS unsigned char* lds; int tid, lane, wave, vcu, G;
};

__device__ __forceinline__ int colmap(int mode, int r) {
    if (mode == 0) return r;
    if (mode == 1) return 3136 + r;
    if (mode == 3) { if (r < 4096) { const int k = r >> 8, j = r & 255; return j < 128 ? 1088 + 128 * k + j : 7232 + 128 * k + (j - 128); } if (r < 6144) return 5184 + (r - 4096); if (r < 7168) return r - 6144;
        if (r < 7232) { const int j = r - 7168; return 1024 + (j >> 1) + 32 * (j & 1); } if (r < 7424) return -1; return 3136 + (r - 7424); }
    const int h = r / DQK, d = r - h * DQK; if (d < DN) return r; const int j = d - DN; return h * DQK + DN + (j >> 1) + 32 * (j & 1);
}
template <bool F8 = false>
__device__ __forceinline__ void p0_transpose_item(const float* W, int K, int N, bf16* WT, int ndst, int mode, const float* kscale, LAS float* scr, int item, int lane) {
    const int nblk = ndst / 32, kb = item / nblk, nb = item % nblk, k0 = 64 * kb, n0 = 32 * nb;
    const int src = colmap(mode, n0 + (lane & 31));
    const int s0 = colmap(mode, n0), s31 = colmap(mode, n0 + 31);
    if (s0 >= 0 && s31 == s0 + 31 && (s0 & 3) == 0) {
        const int kr = lane >> 3, n4 = lane & 7; f32x4 v[8];
#pragma unroll
        for (int i = 0; i < 8; ++i) v[i] = *(const f32x4*)(W + (size_t)(k0 + 8 * i + kr) * N + s0 + 4 * n4);
#pragma unroll
        for (int i = 0; i < 8; ++i) { const float ks = kscale ? kscale[k0 + 8 * i + kr] : 1.f; LAS float* d = scr + (8 * i + kr) * 33 + 4 * n4;
            d[0] = v[i][0] * ks; d[1] = v[i][1] * ks; d[2] = v[i][2] * ks; d[3] = v[i][3] * ks; }
    } else {
#pragma unroll 8
    for (int i = 0; i < 32; ++i) { const int kk = 2 * i + (lane >> 5); float v = 0.f;
        if (src >= 0) { v = W[(size_t)(k0 + kk) * N + src]; if (kscale) v *= kscale[k0 + kk]; }
        scr[kk * 33 + (lane & 31)] = v; }
    }
    LDS_WAIT(); asm volatile("" ::: "memory");
    const int c = lane & 7;
#pragma unroll
    for (int j = 0; j < 4; ++j) { const int n = (lane >> 3) + 8 * j; const LAS float* s = scr + (8 * c) * 33 + n;
        if constexpr (F8) { float t[8];
#pragma unroll
            for (int e = 0; e < 8; ++e) t[e] = fminf(fmaxf(s[e * 33] * WIN8_SCALE, -448.f), 448.f);
            int w0 = 0, w1 = 0; w0 = __builtin_amdgcn_cvt_pk_fp8_f32(t[0], t[1], w0, false); w0 = __builtin_amdgcn_cvt_pk_fp8_f32(t[2], t[3], w0, true); w1 = __builtin_amdgcn_cvt_pk_fp8_f32(t[4], t[5], w1, false); w1 = __builtin_amdgcn_cvt_pk_fp8_f32(t[6], t[7], w1, true);
            v2u o; o.x = (unsigned)w0; o.y = (unsigned)w1; *(v2u*)((unsigned char*)WT + (size_t)(n0 + n) * K + k0 + 8 * c) = o; continue; }
        v4u o; o.x = cvt_pk_bf16(s[0 * 33], s[1 * 33]); o.y = cvt_pk_bf16(s[2 * 33], s[3 * 33]); o.z = cvt_pk_bf16(s[4 * 33], s[5 * 33]); o.w = cvt_pk_bf16(s[6 * 33], s[7 * 33]);
        *(v4u*)(WT + (size_t)(n0 + n) * K + k0 + 8 * c) = o; }
    LDS_WAIT(); asm volatile("" ::: "memory");
}

__device__ __forceinline__ void sgu_unit(const Frame& F, int unit, const bf16* VG, bf16* U, const bf16* WSP, const float* lng, const float* lnb, const float* bsp, const u64* ssum, const u64* ssq) {
    const int chunk = unit >> 3, g = unit & 7, row0 = chunk * 128, c0 = g * 256;
    const int tid = F.tid, lane = F.lane, w = F.wave, fr = lane & 15, fq = lane >> 4;
    LAS unsigned* vt = (LAS unsigned*)F.lds;
    LAS float* st = (LAS float*)(F.lds + 256 * 272);
    if (tid < 128) { const float mean = fx_get(ssum + row0 + tid) * (1.f / D_MODEL), ex2 = fx_get(ssq + row0 + tid) * (1.f / D_MODEL);
        const float var = fmaxf(ex2 - mean * mean, 0.f); st[2 * tid] = mean; st[2 * tid + 1] = __builtin_amdgcn_rsqf(var + EPS); }
    __syncthreads();
#pragma unroll 1
    for (int q = 0; q < 4; ++q) {
        const int wi = w + 8 * q, c8 = lane & 7, rlo = lane >> 3, s2 = 8 * (wi & 7) + rlo, cg = 8 * (wi >> 3) + c8;
        const bf16* p = VG + (size_t)(row0 + 2 * s2) * D_MODEL + c0 + 8 * cg;
        const v4u a = *(const v4u*)p, b = *(const v4u*)(p + D_MODEL);
        const f32x4 g0 = *(const f32x4*)(lng + c0 + 8 * cg), g1 = *(const f32x4*)(lng + c0 + 8 * cg + 4), b0 = *(const f32x4*)(lnb + c0 + 8 * cg), b1 = *(const f32x4*)(lnb + c0 + 8 * cg + 4);
        const float m0 = st[4 * s2], r0 = st[4 * s2 + 1], m1 = st[4 * s2 + 2], r1 = st[4 * s2 + 3];
        const unsigned aw[4] = {a.x, a.y, a.z, a.w}, bw[4] = {b.x, b.y, b.z, b.w};
        const int pd = s2 ^ (c8 << 3);
#pragma unroll
        for (int j = 0; j < 8; ++j) { const float ga = j < 4 ? g0[j & 3] : g1[j & 3], be = j < 4 ? b0[j & 3] : b1[j & 3];
            const float x0 = (j & 1) ? bf_hi(aw[j >> 1]) : bf_lo(aw[j >> 1]), x1 = (j & 1) ? bf_hi(bw[j >> 1]) : bf_lo(bw[j >> 1]);
            vt[(8 * cg + j) * 68 + pd] = cvt_pk_bf16((x0 - m0) * r0 * ga + be, (x1 - m1) * r1 * ga + be); }
    }
    __syncthreads();
    f32x4 acc[2][8];
#pragma unroll
    for (int rt = 0; rt < 2; ++rt)
#pragma unroll
        for (int tt = 0; tt < 8; ++tt) acc[rt][tt] = (f32x4){0.f, 0.f, 0.f, 0.f};
    const bf16* wg = WSP + (size_t)g * 128 * 128;
#pragma unroll
    for (int kk = 0; kk < 4; ++kk) {
        bf16x8 af[2];
#pragma unroll
        for (int rt = 0; rt < 2; ++rt) { const int ch = 32 * w + 16 * rt + fr; const int d = 16 * kk + 4 * fq, pd = d ^ (((ch >> 3) & 7) << 3);
            af[rt] = *(const LAS bf16x8*)((const LAS unsigned char*)vt + ch * 272 + pd * 4); }
#pragma unroll
        for (int tt = 0; tt < 8; ++tt) { if (tt >= 2 * kk) {
            const bf16x8 bfr = *(const bf16x8*)(wg + (size_t)(16 * tt + fr) * 128 + 32 * kk + 8 * fq);
#pragma unroll
            for (int rt = 0; rt < 2; ++rt) acc[rt][tt] = __builtin_amdgcn_mfma_f32_16x16x32_bf16(af[rt], bfr, acc[rt][tt], 0, 0, 0); } }
    }
#pragma unroll
    for (int tt = 0; tt < 8; ++tt) { const int t = 16 * tt + fr; const float bs = bsp[g * 128 + t];
#pragma unroll
        for (int rt = 0; rt < 2; ++rt) { const size_t off = (size_t)(row0 + t) * D_MODEL + c0 + 32 * w + 16 * rt + 4 * fq;
            const v2u uu = *(const v2u*)(U + off);
            const f32x4 a = acc[rt][tt];
            v2u o; o.x = cvt_pk_bf16(bf_lo(uu.x) * (a[0] + bs), bf_hi(uu.x) * (a[1] + bs));
            o.y = cvt_pk_bf16(bf_lo(uu.y) * (a[2] + bs), bf_hi(uu.y) * (a[3] + bs));
            *(v2u*)(U + off) = o; } }
    __syncthreads();
}

namespace att {
constexpr int KT = 64 * 192, VT = 128 * 64;
constexpr int L_K = 0, L_V = 4 * KT, L_WS = 4 * KT + 4 * VT;
#define KSWZ(row, ch) ((row) * 192 + ((((ch) ^ (((row) >> 2) & 3))) << 4))
__device__ __forceinline__ int v_st(int k, int c) { const int kk = (k & ~0xC) | ((k & 4) << 1) | ((k & 8) >> 1); return ((kk >> 3) * 4 + (c >> 5)) * 512 + ((kk & 7) * 32 + (c & 31)) * 2; }
__device__ __forceinline__ int v_rd_base(int lane) { return ((lane & 3) << 3) | (((lane >> 2) & 3) << 6) | (((lane >> 4) & 1) << 5) | (((lane >> 5) & 1) << 8); }
constexpr int v_rd_off(int d0, int ks, int half) { return d0 * 512 + ks * 4096 + half * 2048; }
__device__ __forceinline__ int crow(int r, int hi) { return (r & 3) + 8 * (r >> 2) + 4 * hi; }
__device__ __forceinline__ void mask_tile(f32x16& p0, f32x16& p1, int dq) {
    const float NEG = -__builtin_inff();
#pragma unroll
    for (int r = 0; r < 16; ++r) { const int c = (r & 3) + 8 * (r >> 2); if (dq - c < 0) p0[r] = NEG; if (dq - c - 32 < 0) p1[r] = NEG; }
}
constexpr float THR = 8.f;
__device__ __forceinline__ void softmax_tile(f32x16& p0, f32x16& p1, float& m_reg, float& alpha, v8i& pk, bool first) {
    float pmax;
    { float a4[4];
#pragma unroll
      for (int c = 0; c < 4; ++c) { a4[c] = fmaxf(fmaxf(p0[4 * c], p0[4 * c + 1]), p0[4 * c + 2]); a4[c] = fmaxf(fmaxf(a4[c], p0[4 * c + 3]), p1[4 * c]);
          a4[c] = fmaxf(fmaxf(a4[c], p1[4 * c + 1]), p1[4 * c + 2]); a4[c] = fmaxf(a4[c], p1[4 * c + 3]); }
      pmax = fmaxf(fmaxf(a4[0], a4[1]), fmaxf(a4[2], a4[3])); }
    { auto rr = __builtin_amdgcn_permlane32_swap(__float_as_uint(pmax), __float_as_uint(pmax), false, false); pmax = fmaxf(__uint_as_float(rr[0]), __uint_as_float(rr[1])); }
    if (__builtin_expect(__all(pmax - m_reg <= THR) && !first, 1)) { alpha = 1.f; }
    else { float delta = first ? pmax - m_reg : fmaxf(pmax - m_reg, 0.f); if (!(delta > -1e30f)) delta = 0.f;
        alpha = first ? 1.f : __builtin_amdgcn_exp2f(-delta); m_reg += delta; }
#pragma unroll
    for (int r = 0; r < 16; ++r) { p0[r] = __builtin_amdgcn_exp2f(p0[r] - m_reg); p1[r] = __builtin_amdgcn_exp2f(p1[r] - m_reg); }
#pragma unroll
    for (int w = 0; w < 4; ++w) { int d0 = 0, d1 = 0; d0 = __builtin_amdgcn_cvt_pk_fp8_f32(p0[4 * w], p0[4 * w + 1], d0, false); d0 = __builtin_amdgcn_cvt_pk_fp8_f32(p0[4 * w + 2], p0[4 * w + 3], d0, true);
        d1 = __builtin_amdgcn_cvt_pk_fp8_f32(p1[4 * w], p1[4 * w + 1], d1, false); d1 = __builtin_amdgcn_cvt_pk_fp8_f32(p1[4 * w + 2], p1[4 * w + 3], d1, true); pk[w] = d0; pk[4 + w] = d1; }
}
template <int KB>
__device__ __forceinline__ void qkt(f32x16& p0, f32x16& p1, const char* K_lds, int r32, int hi, const v8i* qr) {
    p0 = f32x16{}; p1 = f32x16{};
    const char* k0 = K_lds + KB * KT + KSWZ(r32, 2 * hi); const char* k1 = K_lds + KB * KT + KSWZ(r32, 2 * hi + 1);
#pragma unroll
    for (int ks = 0; ks < 3; ++ks) {
        const v4u a0 = *reinterpret_cast<const v4u*>(k0 + ks * 64), a1 = *reinterpret_cast<const v4u*>(k1 + ks * 64);
        const v4u b0 = *reinterpret_cast<const v4u*>(k0 + ks * 64 + 32 * 192), b1 = *reinterpret_cast<const v4u*>(k1 + ks * 64 + 32 * 192);
        const v8i ka = {(int)a0.x, (int)a0.y, (int)a0.z, (int)a0.w, (int)a1.x, (int)a1.y, (int)a1.z, (int)a1.w};
        const v8i kb = {(int)b0.x, (int)b0.y, (int)b0.z, (int)b0.w, (int)b1.x, (int)b1.y, (int)b1.z, (int)b1.w};
        p0 = __builtin_amdgcn_mfma_scale_f32_32x32x64_f8f6f4(ka, qr[ks], p0, 0, 0, 0, 0x7c7c7c7c, 0, 0x79797979);
        p1 = __builtin_amdgcn_mfma_scale_f32_32x32x64_f8f6f4(kb, qr[ks], p1, 0, 0, 0, 0x7c7c7c7c, 0, 0x79797979); }
}
template <int VB>
__device__ __forceinline__ void pv_tile(f32x16* o, f32x16& lacc, const char* V_lds, int r32, int hi, v8i pk) {
    const int sw = (r32 >> 2) & 3;
    const char* v0 = V_lds + VB * VT + r32 * 64 + (((2 * hi) ^ sw) << 4); const char* v1 = V_lds + VB * VT + r32 * 64 + (((2 * hi + 1) ^ sw) << 4);
#pragma unroll
    for (int d0 = 0; d0 < 4; ++d0) { const v4u a = *reinterpret_cast<const v4u*>(v0 + d0 * 2048), b = *reinterpret_cast<const v4u*>(v1 + d0 * 2048);
        const v8i vb = {(int)a.x, (int)a.y, (int)a.z, (int)a.w, (int)b.x, (int)b.y, (int)b.z, (int)b.w};
        o[d0] = __builtin_amdgcn_mfma_scale_f32_32x32x64_f8f6f4(pk, vb, o[d0], 0, 0, 0, 0x7f7f7f7f, 0, 0x7c7c7c7c); if (d0 == 1) SBAR(); }
    { int c1 = 0x38383838; asm volatile("" : "+v"(c1)); const v8i ones = {c1, c1, c1, c1, c1, c1, c1, c1};
      lacc = __builtin_amdgcn_mfma_scale_f32_32x32x64_f8f6f4(pk, ones, lacc, 0, 0, 0, 0x7f7f7f7f, 0, 0x7f7f7f7f); }
}
__device__ __forceinline__ void attn_unit(int bh, int qb, const unsigned char* Q, const unsigned char* K, const unsigned char* KRp, const unsigned char* V, const bf16* GA, bf16* MG, char* lds, LAS unsigned char* lds3, const int wave0) {
    int tid = wave0 * 64 + lane_id(); asm volatile("" : "+v"(tid));
    const int wid = __builtin_amdgcn_readfirstlane(tid >> 6), lane = tid & 63, r32 = lane & 31, hi = lane >> 5;
    const int q0 = qb * 256, qlo = q0 + wid * 32, qm = qlo + r32 - 4 * hi;
    const unsigned char* Qw = Q + ((size_t)bh * SEQL + qlo + r32) * DQK;
    const unsigned char* Kh = K + (size_t)bh * SEQL * DN; const unsigned char* KRh = KRp + (size_t)(bh >> 4) * SEQL * DR; const unsigned char* Vh = V + (size_t)bh * SEQL * DVH;
    char* V_lds = lds + L_V; char* K_lds = lds + L_K;
    float* ws = (float*)(lds + L_WS) + wid * 64; float* li_l = ws, * al_l = ws + 32;
    v8i qr[3];
#pragma unroll
    for (int ks = 0; ks < 3; ++ks) { const v4u a = *reinterpret_cast<const v4u*>(Qw + ks * 64 + hi * 32), b = *reinterpret_cast<const v4u*>(Qw + ks * 64 + hi * 32 + 16);
        qr[ks] = (v8i){(int)a.x, (int)a.y, (int)a.z, (int)a.w, (int)b.x, (int)b.y, (int)b.z, (int)b.w}; }
    const int NT = 4 * (qb + 1);
    unsigned ksp[2], kst[2], vso;
#pragma unroll
    for (int i = 0; i < 2; ++i) { const int o = i * 8192 + tid * 16, row = (o / 192) & 63, pos = (o - (o / 192) * 192) >> 4, ch = pos ^ ((row >> 2) & 3);
        if (ch < 8) { ksp[i] = (unsigned)(Kh - Vh) + (unsigned)(row * DN + ch * 16); kst[i] = 64 * DN; } else { ksp[i] = (unsigned)(KRh - Vh) + (unsigned)(row * DR + (ch - 8) * 16); kst[i] = 64 * DR; } }
    { const int j = tid >> 2, c = (tid & 3) ^ ((j >> 2) & 3); vso = (unsigned)(j * SEQL + c * 16); }
    float m_reg = 0.f; f32x16 lacc = {}; f32x16 o[4] = {};
    const unsigned ldw = (unsigned)wid * 1024u;
#define SOFF(x) ({ unsigned o_ = (x); asm volatile("" : "+v"(o_)); (const unsigned*)((const char*)Vh + o_); })
#define SDMA(t, bf) do { \
        __builtin_amdgcn_global_load_lds(SOFF(ksp[0] + (unsigned)(t) * kst[0]), (LAS unsigned*)(lds3 + L_K + (bf) * KT + ldw), 16, 0, 0); \
        if (wid < 4) __builtin_amdgcn_global_load_lds(SOFF(ksp[1] + (unsigned)(t) * kst[1]), (LAS unsigned*)(lds3 + L_K + (bf) * KT + 8192 + ldw), 16, 0, 0); \
        __builtin_amdgcn_global_load_lds(SOFF(vso + (unsigned)(t) * 64u), (LAS unsigned*)(lds3 + L_V + (bf) * VT + ldw), 16, 0, 0); } while (0)
#define TILE(t, BF) do { f32x16 p0, p1; float alpha; v8i pk; \
        __builtin_amdgcn_s_setprio(1); qkt<BF>(p0, p1, K_lds, r32, hi, qr); __builtin_amdgcn_s_setprio(0); \
        { const int kb_ = (t) * 64; if (kb_ + 63 > qlo) mask_tile(p0, p1, qm - kb_); } \
        softmax_tile(p0, p1, m_reg, alpha, pk, (t) == 0); \
        if (__any(alpha < 1.f)) { if (hi == 0) al_l[r32] = alpha; asm volatile("s_waitcnt lgkmcnt(0)" ::: "memory"); \
            _Pragma("unroll") for (int r = 0; r < 16; ++r) { const float a_ = al_l[crow(r, hi)]; lacc[r] *= a_; _Pragma("unroll") for (int d_ = 0; d_ < 4; ++d_) o[d_][r] *= a_; } } \
        __builtin_amdgcn_s_setprio(1); pv_tile<BF>(o, lacc, V_lds, r32, hi, pk); __builtin_amdgcn_s_setprio(0); SBAR(); } while (0)
    SDMA(0, 0); SDMA(1, 1); VM_WAIT(); __syncthreads();
    for (int t = 0; t < NT; t += 4) {
        SDMA(t + 2, 2); SDMA(t + 3, 3); SBAR();
        TILE(t, 0); TILE(t + 1, 1);
        VM_WAIT(); __syncthreads();
        if (t + 4 < NT) { SDMA(t + 4, 0); SDMA(t + 5, 1); } SBAR();
        TILE(t + 2, 2); TILE(t + 3, 3);
        VM_WAIT(); __syncthreads(); }
#undef TILE
#undef SDMA
#undef SOFF
    float* stg = (float*)lds + wid * 4096;
    float rli[16];
#pragma unroll
    for (int r = 0; r < 16; ++r) rli[r] = __builtin_amdgcn_rcpf(lacc[r]);
    const int le = lane_id(), r32e = le & 31, hie = le >> 5;
#pragma unroll
    for (int r = 0; r < 16; ++r) { const int orow = crow(r, hie);
#pragma unroll
        for (int d0 = 0; d0 < 4; ++d0) stg[orow * 128 + d0 * 32 + r32e] = o[d0][r] * rli[r]; }
    asm volatile("s_waitcnt lgkmcnt(0)" ::: "memory");
    const int b = bh >> 4, h = bh & 15;
#pragma unroll 4
    for (int it = 0; it < 16; ++it) { const int row = 2 * it + hie, c4 = r32e * 4;
        const f32x4 ov = *(const f32x4*)(stg + row * 128 + c4);
        const size_t off = ((size_t)b * SEQL + qlo + row) * D_MODEL + h * DVH + c4;
        const v2u ga = *(const v2u*)(GA + off), ob = *(const v2u*)(MG + off);
        v2u w; w.x = cvt_pk_bf16(bf_lo(ga.x) * ov[0] + bf_lo(ob.x), bf_hi(ga.x) * ov[1] + bf_hi(ob.x)); w.y = cvt_pk_bf16(bf_lo(ga.y) * ov[2] + bf_lo(ob.y), bf_hi(ga.y) * ov[3] + bf_hi(ob.y));
        *(v2u*)(MG + off) = w; }
    __syncthreads();
}
#undef KSWZ
}

__device__ __forceinline__ void ce_desc(float& a, float& b) { const float hi = fmaxf(a, b), lo = fminf(a, b); a = hi; b = lo; }
template <int N> __device__ __forceinline__ void bitonic_sort_desc(float (&v)[N]) {
#pragma unroll
    for (int k = 2; k <= N; k <<= 1)
#pragma unroll
        for (int j = k >> 1; j > 0; j >>= 1)
#pragma unroll
            for (int i = 0; i < N; ++i) { const int l = i ^ j; if (l > i) { if ((i & k) == 0) ce_desc(v[i], v[l]); else ce_desc(v[l], v[i]); } }
}
template <int N> __device__ __forceinline__ void bitonic_merge_desc(float (&v)[N]) {
#pragma unroll
    for (int j = N >> 1; j > 0; j >>= 1)
#pragma unroll
        for (int i = 0; i < N; ++i) { const int l = i ^ j; if (l > i) ce_desc(v[i], v[l]); }
}
__device__ __forceinline__ void merge_top16(float (&a)[16], const float (&b)[16]) {
#pragma unroll
    for (int i = 0; i < 16; ++i) a[i] = fmaxf(a[i], b[15 - i]);
    bitonic_merge_desc<16>(a);
}
__device__ __forceinline__ void topk_unit(const Frame& F, int tg, int h, const bf16* QP, int* TOPI, float* TOPG) {
    const int lane = F.lane, fr = lane & 15, fq = lane >> 4;
    const int t0 = tg * 16;
    LAS float* sl = (LAS float*)(F.lds + 65536) + F.wave * 512;
    float s01[2][16];
#pragma unroll
    for (int p = 0; p < 2; ++p) {
        f32x4 acc[8];
#pragma unroll
        for (int mt = 0; mt < 8; ++mt) acc[mt] = (f32x4){0.f, 0.f, 0.f, 0.f};
        const bf16* qp = QP + (size_t)(t0 + fr) * D_MODEL + h * 256 + p * 128 + 8 * fq;
        const LAS unsigned char* kp = F.lds + p * 32768 + fr * 256;
#pragma unroll
        for (int kk = 0; kk < 4; ++kk) { const bf16x8 bq = *(const bf16x8*)(qp + 32 * kk);
#pragma unroll
            for (int mt = 0; mt < 8; ++mt) { const bf16x8 ak = *(const LAS bf16x8*)(kp + mt * 4096 + (((4 * kk + fq) ^ fr) << 4));
                acc[mt] = __builtin_amdgcn_mfma_f32_16x16x32_bf16(ak, bq, acc[mt], 0, 0, 0); } }
        float a[16], b[16];
#pragma unroll
        for (int mt = 0; mt < 8; ++mt)
#pragma unroll
            for (int e = 0; e < 4; ++e) { const unsigned n = (unsigned)(16 * mt + 4 * fq + e); const float pk = __uint_as_float((__float_as_uint(acc[mt][e]) & ~0x7Fu) | n);
                if (mt < 4) a[mt * 4 + e] = pk; else b[(mt - 4) * 4 + e] = pk; }
        bitonic_sort_desc<16>(a); bitonic_sort_desc<16>(b); merge_top16(a, b);
#pragma unroll
        for (int i = 0; i < 16; ++i) b[i] = shx(a[i], 16, F.lane);
        merge_top16(a, b);
#pragma unroll
        for (int i = 0; i < 16; ++i) b[i] = shx(a[i], 32, F.lane);
        merge_top16(a, b);
#pragma unroll
        for (int i = 0; i < 16; ++i) s01[p][i] = a[i];
    }
    if (fq == 0) {
#pragma unroll
        for (int p = 0; p < 2; ++p)
#pragma unroll
            for (int i = 0; i < 16; ++i) sl[fr * 32 + p * 16 + i] = s01[p][i];
    }
    float c[4][16];
#pragma unroll
    for (int gidx = 0; gidx < 4; ++gidx)
#pragma unroll
        for (int i = 0; i < 16; ++i) c[gidx][i] = -3.0e38f;
#define CAND(n, i, j) do { const float v_ = __uint_as_float(__float_as_uint(s01[0][i]) & ~0x7Fu) + __uint_as_float(__float_as_uint(s01[1][j]) & ~0x7Fu); \
        c[(n) >> 4][(n) & 15] = __uint_as_float((__float_as_uint(v_) & ~0xFFu) | (unsigned)((i) * 16 + (j))); } while (0)
    CAND(0, 0, 0); CAND(1, 0, 1); CAND(2, 0, 2); CAND(3, 0, 3); CAND(4, 0, 4); CAND(5, 0, 5); CAND(6, 0, 6); CAND(7, 0, 7);
    CAND(8, 0, 8); CAND(9, 0, 9); CAND(10, 0, 10); CAND(11, 0, 11); CAND(12, 0, 12); CAND(13, 0, 13); CAND(14, 0, 14); CAND(15, 0, 15);
    CAND(16, 1, 0); CAND(17, 1, 1); CAND(18, 1, 2); CAND(19, 1, 3); CAND(20, 1, 4); CAND(21, 1, 5); CAND(22, 1, 6); CAND(23, 1, 7);
    CAND(24, 2, 0); CAND(25, 2, 1); CAND(26, 2, 2); CAND(27, 2, 3); CAND(28, 2, 4);
    CAND(29, 3, 0); CAND(30, 3, 1); CAND(31, 3, 2); CAND(32, 3, 3);
    CAND(33, 4, 0); CAND(34, 4, 1); CAND(35, 4, 2);
    CAND(36, 5, 0); CAND(37, 5, 1); CAND(38, 6, 0); CAND(39, 6, 1); CAND(40, 7, 0); CAND(41, 7, 1);
    CAND(42, 8, 0); CAND(43, 9, 0); CAND(44, 10, 0); CAND(45, 11, 0); CAND(46, 12, 0); CAND(47, 13, 0); CAND(48, 14, 0); CAND(49, 15, 0);
#undef CAND
    bitonic_sort_desc<16>(c[0]); bitonic_sort_desc<16>(c[1]); bitonic_sort_desc<16>(c[2]); bitonic_sort_desc<16>(c[3]);
    merge_top16(c[0], c[1]); merge_top16(c[2], c[3]); merge_top16(c[0], c[2]);
    LDS_WAIT(); asm volatile("" ::: "memory");
    float sc[16]; int ix[16]; float mx = -3.0e38f;
#pragma unroll
    for (int w = 0; w < 16; ++w) { const unsigned id = __float_as_uint(c[0][w]) & 0xFFu; const unsigned u0 = __float_as_uint(sl[fr * 32 + (id >> 4)]), u1 = __float_as_uint(sl[fr * 32 + 16 + (id & 15)]);
        sc[w] = __uint_as_float(u0 & ~0x7Fu) + __uint_as_float(u1 & ~0x7Fu); ix[w] = (int)((u0 & 0x7Fu) * NKEYS + (u1 & 0x7Fu)); mx = fmaxf(mx, sc[w]); }
    float sum = 0.f;
#pragma unroll
    for (int w = 0; w < 16; ++w) { sc[w] = __builtin_amdgcn_exp2f((sc[w] - mx) * 1.4426950409f); sum += sc[w]; }
    const float rs = __builtin_amdgcn_rcpf(sum);
    if (fq == 0) { int* ti = TOPI + (size_t)(t0 + fr) * 128 + h * 16; float* tgp = TOPG + (size_t)(t0 + fr) * 128 + h * 16;
#pragma unroll
        for (int w = 0; w < 16; ++w) { ti[w] = ix[w]; tgp[w] = sc[w] * rs; } }
    LDS_WAIT(); asm volatile("" ::: "memory");
}

typedef float f32x2 __attribute__((ext_vector_type(2)));
struct PeerIdx { int i0, i1; float a0, a1; };
struct PeerRow { v4u x; float xs; };
__device__ __forceinline__ void pu_gather(int t, int sl, int lane, const PeerIdx& I, v4u (&wu)[16], PeerRow& R, const unsigned char* XQ, const float* XS, const unsigned char* PU8) {
    const int r = lane & 7, g = lane >> 3;
    const unsigned char* sb = PU8 + (size_t)sl * NEXP * 128;
#pragma unroll
    for (int k = 0; k < 16; ++k) { const int e = __shfl(k < 8 ? I.i0 : I.i1, (8 * k + g) & 63); unsigned o_ = (unsigned)(e * 128 + 16 * r); asm volatile("" : "+v"(o_)); wu[k] = *(const v4u*)(sb + o_); }
    R.x = __builtin_nontemporal_load((const v4u*)(XQ + (size_t)t * D_MODEL + 128 * sl + 16 * r)); R.xs = XS[(size_t)t * 16 + sl];
}
__device__ __forceinline__ void pu_compute(int t, int sl, int lane, const v4u (&wu)[16], const PeerRow& R, float* PART) {
    const int r = lane & 7, g = lane >> 3;
    float d[16];
#pragma unroll
    for (int k = 0; k < 16; ++k) { int a_ = __builtin_amdgcn_sdot4((int)wu[k].x, (int)R.x.x, 0, false); a_ = __builtin_amdgcn_sdot4((int)wu[k].y, (int)R.x.y, a_, false);
        a_ = __builtin_amdgcn_sdot4((int)wu[k].z, (int)R.x.z, a_, false); a_ = __builtin_amdgcn_sdot4((int)wu[k].w, (int)R.x.w, a_, false); d[k] = (float)a_; }
    const bool b0 = lane & 1, b1 = lane & 2, b2 = lane & 4;
    float res[2];
#pragma unroll
    for (int hf = 0; hf < 2; ++hf) { float e1[4], f1[2];
#pragma unroll
        for (int m = 0; m < 4; ++m) e1[m] = (b0 ? d[8 * hf + 2 * m + 1] : d[8 * hf + 2 * m]) + shx(b0 ? d[8 * hf + 2 * m] : d[8 * hf + 2 * m + 1], 1, lane);
#pragma unroll
        for (int n = 0; n < 2; ++n) f1[n] = (b1 ? e1[2 * n + 1] : e1[2 * n]) + shx(b1 ? e1[2 * n] : e1[2 * n + 1], 2, lane);
        res[hf] = (b2 ? f1[1] : f1[0]) + shx(b2 ? f1[0] : f1[1], 4, lane); }
    float* po = PART + ((size_t)t * 16 + sl) * 128 + 8 * r + g;
    __builtin_nontemporal_store(res[0] * R.xs, po); __builtin_nontemporal_store(res[1] * R.xs, po + 64);
}
__device__ __forceinline__ void peer_fin_token(int t, int lane, const float* PART, const int* TOPI, float* TOPG, const float* USC, const float* VSC, const u64* sqx) {
    const float r2 = __builtin_amdgcn_rsqf(fx_get(sqx + t) * (1.f / D_MODEL) + EPS);
    float s0 = 0.f, s1 = 0.f;
#pragma unroll
    for (int sl = 0; sl < 16; ++sl) { s0 += __builtin_nontemporal_load(PART + ((size_t)t * 16 + sl) * 128 + lane); s1 += __builtin_nontemporal_load(PART + ((size_t)t * 16 + sl) * 128 + 64 + lane); }
    const int e0 = TOPI[(size_t)t * 128 + lane], e1 = TOPI[(size_t)t * 128 + 64 + lane];
    float* gp = TOPG + (size_t)t * 128;
    gp[lane] = gelu_t(s0 * USC[e0] * r2) * gp[lane] * VSC[e0]; gp[64 + lane] = gelu_t(s1 * USC[e1] * r2) * gp[64 + lane] * VSC[e1];
}
__device__ __forceinline__ void pv_gather(int t, int sl, int lane, const PeerIdx& I, v4u (&wv)[16], float (&xv)[2], const bf16* X, const unsigned char* PV8) {
    const int r = lane & 7, g = lane >> 3;
    const unsigned char* sb = PV8 + (size_t)sl * NEXP * 128;
#pragma unroll
    for (int k = 0; k < 16; ++k) { const int e = __shfl(k < 8 ? I.i0 : I.i1, (8 * k + g) & 63); unsigned o_ = (unsigned)(e * 128 + 16 * r); asm volatile("" : "+v"(o_)); wv[k] = *(const v4u*)(sb + o_); }
    const bf16* xp = X + (size_t)t * D_MODEL + 128 * sl + 16 * r + g; xv[0] = __uint_as_float((unsigned)xp[0] << 16); xv[1] = __uint_as_float((unsigned)xp[8] << 16);
}
__device__ __forceinline__ void pv_compute(int t, int sl, int lane, const PeerIdx& I, const v4u (&wv)[16], const float (&xv)[2], float* X, u64* ssq2) {
    const int r = lane & 7, g = lane >> 3;
    float oa[16];
    { f32x2 o2[8]; float ak[16];
#pragma unroll
      for (int e = 0; e < 8; ++e) o2[e] = (f32x2){0.f, 0.f};
#pragma unroll
      for (int k = 0; k < 16; ++k) ak[k] = __shfl(k < 8 ? I.a0 : I.a1, (8 * k + g) & 63);
#pragma unroll
      for (int k = 0; k < 16; ++k) { const f32x2 a2 = {ak[k], ak[k]};
#pragma unroll
          for (int q = 0; q < 4; ++q) { const int w_ = (int)(q == 0 ? wv[k].x : q == 1 ? wv[k].y : q == 2 ? wv[k].z : wv[k].w);
              o2[2 * q] += __builtin_amdgcn_cvt_pk_f32_fp8(w_, false) * a2; o2[2 * q + 1] += __builtin_amdgcn_cvt_pk_f32_fp8(w_, true) * a2; } }
#pragma unroll
      for (int e = 0; e < 8; ++e) { oa[2 * e] = o2[e][0]; oa[2 * e + 1] = o2[e][1]; } }
    const bool c0 = lane & 8, c1 = lane & 16, c2 = lane & 32;
    float p1[8], p2[4], p3[2];
#pragma unroll
    for (int m = 0; m < 8; ++m) p1[m] = (c0 ? oa[2 * m + 1] : oa[2 * m]) + shx(c0 ? oa[2 * m] : oa[2 * m + 1], 8, lane);
#pragma unroll
    for (int n = 0; n < 4; ++n) p2[n] = (c1 ? p1[2 * n + 1] : p1[2 * n]) + shx(c1 ? p1[2 * n] : p1[2 * n + 1], 16, lane);
#pragma unroll
    for (int q = 0; q < 2; ++q) p3[q] = (c2 ? p2[2 * q + 1] : p2[2 * q]) + shx(c2 ? p2[2 * q] : p2[2 * q + 1], 32, lane);
    float* xp = X + (size_t)t * D_MODEL + 128 * sl + 16 * r + g;
    const float y0 = xv[0] + p3[0], y1 = xv[1] + p3[1];
    xp[0] = y0; xp[8] = y1;
    const float ss = wave_sum(y0 * y0 + y1 * y1, lane);
    if (lane == 0) fx_add(ssq2 + t, ss);
}
__device__ __forceinline__ void row8_load(f32x4 (&v)[8], const float* src, int lane) {
    const f32x4* xr = (const f32x4*)src + lane;
#pragma unroll
    for (int j = 0; j < 8; ++j) v[j] = __builtin_nontemporal_load(xr + 64 * j);
}
__device__ __forceinline__ unsigned pack_i8x4(f32x4 v) {
    int i[4];
#pragma unroll
    for (int e = 0; e < 4; ++e) i[e] = (int)__builtin_rintf(__builtin_amdgcn_fmed3f(v[e], -127.f, 127.f));
    const unsigned lo = __builtin_amdgcn_perm((unsigned)i[1], (unsigned)i[0], 0x0c0c0400u), hi = __builtin_amdgcn_perm((unsigned)i[3], (unsigned)i[2], 0x0c0c0400u);
    return __builtin_amdgcn_perm(hi, lo, 0x05040100u); }
template <bool I8>
__device__ __forceinline__ void row_to_fp8(f32x4 (&v)[8], unsigned char* tab, int e, float* inv_scale, int lane, const f32x4* colmul) {
    float am = 0.f;
#pragma unroll
    for (int j = 0; j < 8; ++j) { if (colmul) v[j] = v[j] * colmul[j];
        am = fmaxf(am, fmaxf(fmaxf(fabsf(v[j][0]), fabsf(v[j][1])), fmaxf(fabsf(v[j][2]), fabsf(v[j][3])))); }
#pragma unroll
    for (int o = 1; o < 64; o <<= 1) am = fmaxf(am, shx(am, o, lane));
    am = fmaxf(am, 1e-30f); const float sc = (I8 ? 127.f : 256.f) / am;
#pragma unroll
    for (int j = 0; j < 8; ++j) { int w = 0; if constexpr (I8) w = (int)pack_i8x4(v[j] * sc); else { w = __builtin_amdgcn_cvt_pk_fp8_f32(v[j][0] * sc, v[j][1] * sc, w, false); w = __builtin_amdgcn_cvt_pk_fp8_f32(v[j][2] * sc, v[j][3] * sc, w, true); } const int dw = lane + 64 * j; unsigned o_ = (unsigned)(dw >> 5) * (unsigned)(NEXP * 128) + (unsigned)(dw & 31) * 4u; asm volatile("" : "+v"(o_)); *(unsigned*)(tab + (size_t)e * 128 + o_) = (unsigned)w; }
    if (lane == 0) *inv_scale = am * (I8 ? 1.f / 127.f : 1.f / 256.f);
}

__global__ void __launch_bounds__(512, 2) mk_fwd(Args args) {
    extern __shared__ __attribute__((aligned(16))) unsigned char lds[];
    Frame F;
    F.lds = (LAS unsigned char*)lds;
    F.wave = __builtin_amdgcn_readfirstlane((int)threadIdx.x >> 6); F.lane = lane_id(); F.tid = F.wave * 64 + F.lane;
    F.G = gridDim.x; { const int bx = blockIdx.x; F.vcu = (F.G % 8 == 0) ? (bx % 8) * (F.G / 8) + bx / 8 : bx; }
    unsigned char* ws = args.ws;
    gu32* ctl = (gu32*)(ws + WS_CTL);
    volatile LAS unsigned* MISC = (volatile LAS unsigned*)(F.lds + MISC_OFF);
    for (int u = F.tid; u < (LDS_BYTES - LDSCTL_OFF) / 4; u += 512) ((LAS unsigned*)(F.lds + LDSCTL_OFF))[u] = 0u;
    __syncthreads();
    XcdBarrier bar; bar.bar = (unsigned*)(ctl + CW_BAR); bar.x = 0; bar.st = nullptr;
    bar = xcd_barrier_post((unsigned*)(ctl + CW_BAR), MISC + 8, F.wave);
#define GRID_BAR() xcd_barrier(bar)
#define PHASE_BEGIN() do { F.lane = lane_id(); asm volatile("" : "+v"(F.lane)); F.tid = F.wave * 64 + F.lane; } while (0)
    const float* x = args.in[0]; const int* positions = (const int*)args.in[1]; const float* g_norm1 = args.in[2]; const float* w_in = args.in[3];
    const float* g_q_a = args.in[4]; const float* w_uq = args.in[5]; const float* g_kv_a = args.in[6]; const float* w_ukv = args.in[7];
    const float* sgu_ln_g = args.in[8]; const float* sgu_ln_b = args.in[9]; const float* w_spatial = args.in[10]; const float* b_spatial = args.in[11];
    const float* b_gate = args.in[12]; const float* w_out = args.in[13]; const float* g_norm2 = args.in[14]; const float* w_peer_q = args.in[15];
    const float* peer_keys = args.in[16]; const float* peer_u = args.in[17]; const float* peer_v = args.in[18]; const float* g_final = args.in[19];
    float* out = args.out;
    bf16* KEYS = (bf16*)(ws + WS_KEYS); bf16* WSP = (bf16*)(ws + WS_WSP); bf16* WUQ = (bf16*)(ws + WS_WUQ); bf16* WUKV = (bf16*)(ws + WS_WUKV);
    bf16* WOUT = (bf16*)(ws + WS_WOUT); bf16* WPQ = (bf16*)(ws + WS_WPQ); float* ROPE = (float*)(ws + WS_ROPE);
    unsigned char* XN8 = ws + WS_XN8; unsigned char* WIN8 = ws + WS_WIN8; unsigned char* CQKV = ws + WS_CQKV; bf16* U = (bf16*)(ws + WS_U); bf16* VG = (bf16*)(ws + WS_VG);
    unsigned char* Vb = ws + WS_V; unsigned char* Kb = ws + WS_K; unsigned char* KR = ws + WS_KR; unsigned char* Qb = ws + WS_Q; bf16* GA = (bf16*)(ws + WS_GA); float* X2 = (float*)(ws + WS_X2);
    bf16* X1B = (bf16*)(ws + WS_X1B); unsigned char* PU = ws + WS_PU; unsigned char* PV = ws + WS_PV; float* USC = (float*)(ws + WS_PSC); float* VSC = USC + NEXP; float* PART = (float*)(ws + WS_PART); bf16* QP = (bf16*)(ws + WS_QP);
    int* TOPI = (int*)(ws + WS_TOPI); float* TOPG = (float*)(ws + WS_TOPG); unsigned char* X1Q = ws + WS_X1Q; float* XS = (float*)(ws + WS_XS);
    u64* SQQ = (u64*)(ws + CTL_STATS); u64* SQKV = SQQ + MTOK; u64* SSUM = SQKV + MTOK; u64* SSQ = SSUM + MTOK; u64* SQX1 = SSQ + MTOK;
    const int gw = F.vcu * 8 + F.wave, NGW = F.G * 8;

    {
        LAS float* scr = (LAS float*)(F.lds + RING_OFF + F.wave * 16384);
        constexpr int I_IN8 = (D_MODEL / 64) * (IN8_ROWS / 32), I_UQ = (QL / 64) * (NQ_COLS / 32), I_UKV = (QL / 64) * (NKV_COLS / 32), I_O = (D_MODEL / 64) * (D_MODEL / 32);
        constexpr int NITEMS = I_IN8 + I_UQ + I_UKV + 2 * I_O;
        for (int it = gw; it < NITEMS; it += NGW) {
            int r = it;
            if (r < I_IN8) { p0_transpose_item<true>(w_in, D_MODEL, IN_COLS, (bf16*)WIN8, IN8_ROWS, 3, nullptr, scr, r, F.lane); continue; } r -= I_IN8;
            if (r < I_UQ) { p0_transpose_item<true>(w_uq, QL, NQ_COLS, WUQ, NQ_COLS, 2, g_q_a, scr, r, F.lane); continue; } r -= I_UQ;
            if (r < I_UKV) { p0_transpose_item<true>(w_ukv, QL, NKV_COLS, WUKV, NKV_COLS, 0, g_kv_a, scr, r, F.lane); continue; } r -= I_UKV;
            if (r < I_O) { p0_transpose_item(w_out, D_MODEL, D_MODEL, WOUT, D_MODEL, 0, nullptr, scr, r, F.lane); continue; } r -= I_O;
            p0_transpose_item(w_peer_q, D_MODEL, D_MODEL, WPQ, D_MODEL, 0, g_norm2, scr, r, F.lane);
        }
        {
#define XN_LOAD(v, m_) do { const f32x4* xr_ = (const f32x4*)(x + (size_t)(m_) * D_MODEL) + F.lane; _Pragma("unroll") for (int j = 0; j < 8; ++j) v[j] = __builtin_nontemporal_load(xr_ + 64 * j); } while (0)
#define XN_DO(v, m_) do { float s_ = 0.f; _Pragma("unroll") for (int j = 0; j < 8; ++j) s_ += (v[j][0] * v[j][0] + v[j][1] * v[j][1]) + (v[j][2] * v[j][2] + v[j][3] * v[j][3]); \
            const float r_ = __builtin_amdgcn_rsqf(wave_sum(s_, F.lane) * (1.f / D_MODEL) + EPS); \
            _Pragma("unroll") for (int j = 0; j < 8; ++j) { const f32x4 h_ = v[j] * r_ * gn[j]; \
                const f32x4 h8_ = __builtin_elementwise_min(__builtin_elementwise_max(h_ * XN8_SCALE, (f32x4){-448.f, -448.f, -448.f, -448.f}), (f32x4){448.f, 448.f, 448.f, 448.f}); \
                int p_ = 0; p_ = __builtin_amdgcn_cvt_pk_fp8_f32(h8_[0], h8_[1], p_, false); p_ = __builtin_amdgcn_cvt_pk_fp8_f32(h8_[2], h8_[3], p_, true); ((unsigned*)(XN8 + (size_t)(m_) * D_MODEL))[F.lane + 64 * j] = (unsigned)p_; } } while (0)
            f32x4 gn[8];
#pragma unroll
            for (int j = 0; j < 8; ++j) gn[j] = *((const f32x4*)g_norm1 + F.lane + 64 * j);
            f32x4 va[8], vb[8]; int m = gw; if (m < MTOK) XN_LOAD(va, m);
#pragma unroll 1
            for (; m < MTOK; m += 2 * NGW) {
                if (m + NGW < MTOK) XN_LOAD(vb, m + NGW);
                XN_DO(va, m);
                if (m + NGW < MTOK) { if (m + 2 * NGW < MTOK) XN_LOAD(va, m + 2 * NGW); XN_DO(vb, m + NGW); } }
#undef XN_LOAD
#undef XN_DO
        }
        for (int it = gw; it < MTOK / 2; it += NGW) { const int row = 2 * it + (F.lane >> 5), i = F.lane & 31;
            const float freq = exp2f(-(float)i * (13.287712379549449f / 32.f)); const float ang = (float)positions[row] * freq;
            const double ad = (double)ang; const double k = __builtin_rint(ad * 0.15915494309189535); const float red = (float)(ad - k * 6.283185307179586);
            ROPE[(size_t)row * 32 + i] = __cosf(red); ROPE[(size_t)MTOK * 32 + (size_t)row * 32 + i] = __sinf(red); }
        for (int it = gw; it < (PHEADS * 2 * NKEYS * KD) / 512; it += NGW) { const size_t e = (size_t)it * 512 + 8 * F.lane; const f32x4 a = *(const f32x4*)(peer_keys + e), b = *(const f32x4*)(peer_keys + e + 4);
            v4u w; w.x = cvt_pk_bf16(a[0], a[1]); w.y = cvt_pk_bf16(a[2], a[3]); w.z = cvt_pk_bf16(b[0], b[1]); w.w = cvt_pk_bf16(b[2], b[3]); *(v4u*)(KEYS + e) = w; }
        for (int it = gw; it < (8 * 128 * 128) / 512; it += NGW) { const size_t e = (size_t)it * 512 + 8 * F.lane; const int t = (int)((e >> 7) & 127), s0 = (int)(e & 127);
            const f32x4 a = *(const f32x4*)(w_spatial + e), b = *(const f32x4*)(w_spatial + e + 4); float v[8] = {a[0], a[1], a[2], a[3], b[0], b[1], b[2], b[3]};
#pragma unroll
            for (int j = 0; j < 8; ++j) if (s0 + j > t) v[j] = 0.f;
            v4u w; w.x = cvt_pk_bf16(v[0], v[1]); w.y = cvt_pk_bf16(v[2], v[3]); w.z = cvt_pk_bf16(v[4], v[5]); w.w = cvt_pk_bf16(v[6], v[7]); *(v4u*)(WSP + e) = w; }
        for (size_t it = (size_t)gw * 64 + F.lane; it < (size_t)5 * MTOK; it += (size_t)NGW * 64) SQQ[it] = 0ull;
        GRID_BAR();
    }
    {
        PHASE_BEGIN();
        pg8::EpiIn E{0, IN8_DESCALE, U, GA, VG, CQKV, KR, b_gate, ROPE, SQQ, SQKV, SSUM, SSQ};
        { pg8::Gemm g{(const bf16*)XN8, (const bf16*)WIN8, MTOK, IN8_ROWS, D_MODEL / 2, D_MODEL / 2}; pg8::StaticOrder S; S.init(MTOK, IN8_ROWS, F.G, (int)blockIdx.x);
          pg8::gemm_phase<pg8::EpiIn, pg8::StaticOrder, true, true, true>(F.lds + RING_OFF, g, S, E, F.wave); }
        GRID_BAR();
    }
    {
        PHASE_BEGIN();
        { pg8::Gemm g{(const bf16*)CQKV, WUQ, MTOK, NQ_COLS, QL / 2, 512}; pg8::StaticOrder S; S.init(MTOK, NQ_COLS, F.G, (int)blockIdx.x);
          pg8::EpiQ E{Qb, SQQ, ROPE}; pg8::gemm_phase<pg8::EpiQ, pg8::StaticOrder, true, true, true>(F.lds + RING_OFF, g, S, E, F.wave); }
        { pg8::Gemm g{(const bf16*)(CQKV + QL), WUKV, MTOK, NKV_COLS, QL / 2, 512}; pg8::StaticOrder S; S.init(MTOK, NKV_COLS, F.G, (int)blockIdx.x);
          pg8::EpiKV E{Kb, Vb, SQKV}; pg8::gemm_phase<pg8::EpiKV, pg8::StaticOrder, true, true, true, true>(F.lds + RING_OFF, g, S, E, F.wave); }
        PHASE_BEGIN();
        for (int un = F.vcu; un < (MTOK / 128) * 8; un += F.G) sgu_unit(F, un, VG, U, WSP, sgu_ln_g, sgu_ln_b, b_spatial, SSUM, SSQ);
        GRID_BAR();
    }
    {
        PHASE_BEGIN();
        if (F.G == 256) { const int s = F.vcu & 7, bh = F.vcu >> 3;
#pragma unroll 1
            for (int i = 0; i < 4; ++i) { const int qb = (i == 0) ? s : (i == 1) ? 15 - s : (i == 2) ? 16 + s : 31 - s; att::attn_unit(bh, qb, Qb, Kb, KR, Vb, GA, U, (char*)lds + RING_OFF, F.lds + RING_OFF, F.wave); }
        } else {
#pragma unroll 1
            for (int un = F.vcu; un < 1024; un += F.G) att::attn_unit(un >> 5, 31 - (un & 31), Qb, Kb, KR, Vb, GA, U, (char*)lds + RING_OFF, F.lds + RING_OFF, F.wave);
        }
        GRID_BAR();
    }
    {
        PHASE_BEGIN();
        for (int it = gw * 64 + F.lane; it < MTOK; it += NGW * 64) SQQ[it] = 0ull;
        { f32x4 va[8], vb[8];
#define CONV_ROWS(SRC, TAB, SC, I8_, CM) do { int e = gw; if (e < NEXP) row8_load(va, SRC + (size_t)e * D_MODEL, F.lane); \
          _Pragma("unroll 1") for (; e < NEXP; e += 2 * NGW) { \
              if (e + NGW < NEXP) row8_load(vb, SRC + (size_t)(e + NGW) * D_MODEL, F.lane); \
              row_to_fp8<I8_>(va, TAB, e, SC + e, F.lane, CM); \
              if (e + NGW < NEXP) { if (e + 2 * NGW < NEXP) row8_load(va, SRC + (size_t)(e + 2 * NGW) * D_MODEL, F.lane); row_to_fp8<I8_>(vb, TAB, e + NGW, SC + e + NGW, F.lane, CM); } } } while (0)
          f32x4 gn2[8];
#pragma unroll
          for (int j = 0; j < 8; ++j) gn2[j] = *((const f32x4*)g_norm2 + F.lane + 64 * j);
          CONV_ROWS(peer_u, PU, USC, true, gn2);
          CONV_ROWS(peer_v, PV, VSC, false, (const f32x4*)nullptr);
#undef CONV_ROWS
        }
        VM_WAIT(); __syncthreads();
        pg8::Gemm g{U, WOUT, MTOK, D_MODEL, D_MODEL, D_MODEL}; pg8::StaticOrder S; S.init(MTOK, D_MODEL, F.G, (int)blockIdx.x);
        pg8::EpiOut E{x, X1B, SQX1}; pg8::gemm_phase<pg8::EpiOut, pg8::StaticOrder, true, true>(F.lds + RING_OFF, g, S, E, F.wave);
        GRID_BAR();
    }
    {
        PHASE_BEGIN();
        pg8::Gemm g{X1B, WPQ, MTOK, D_MODEL, D_MODEL, D_MODEL}; pg8::StaticOrder S; S.init(MTOK, D_MODEL, F.G, (int)blockIdx.x);
        pg8::EpiPQ E{QP, SQX1}; pg8::gemm_phase<pg8::EpiPQ, pg8::StaticOrder, true, true>(F.lds + RING_OFF, g, S, E, F.wave);
        GRID_BAR();
    }
    {
        PHASE_BEGIN();
#pragma unroll 1
        for (int t = gw; t < MTOK; t += NGW) { const bf16* xp = X1B + (size_t)t * D_MODEL + 32 * F.lane; v4u xw[4];
#pragma unroll
            for (int j = 0; j < 4; ++j) xw[j] = *(const v4u*)(xp + 8 * j);
            float xf[32]; float am = 0.f;
#pragma unroll
            for (int j = 0; j < 4; ++j) { const unsigned w4[4] = {xw[j].x, xw[j].y, xw[j].z, xw[j].w};
#pragma unroll
                for (int q = 0; q < 4; ++q) { xf[8 * j + 2 * q] = bf_lo(w4[q]); xf[8 * j + 2 * q + 1] = bf_hi(w4[q]); am = fmaxf(am, fmaxf(fabsf(xf[8 * j + 2 * q]), fabsf(xf[8 * j + 2 * q + 1]))); } }
            am = fmaxf(am, shx(am, 1, F.lane)); am = fmaxf(am, shx(am, 2, F.lane)); am = fmaxf(am, 1e-30f);
            const float sc = 127.f / am; v4u q0, q1;
            q0.x = pack_i8x4((f32x4){xf[0], xf[1], xf[2], xf[3]} * sc); q0.y = pack_i8x4((f32x4){xf[4], xf[5], xf[6], xf[7]} * sc); q0.z = pack_i8x4((f32x4){xf[8], xf[9], xf[10], xf[11]} * sc); q0.w = pack_i8x4((f32x4){xf[12], xf[13], xf[14], xf[15]} * sc);
            q1.x = pack_i8x4((f32x4){xf[16], xf[17], xf[18], xf[19]} * sc); q1.y = pack_i8x4((f32x4){xf[20], xf[21], xf[22], xf[23]} * sc); q1.z = pack_i8x4((f32x4){xf[24], xf[25], xf[26], xf[27]} * sc); q1.w = pack_i8x4((f32x4){xf[28], xf[29], xf[30], xf[31]} * sc);
            unsigned char* qp = X1Q + (size_t)t * D_MODEL + 32 * F.lane; *(v4u*)qp = q0; *(v4u*)(qp + 16) = q1;
            if ((F.lane & 3) == 0) XS[(size_t)t * 16 + (F.lane >> 2)] = am * (1.f / 127.f); }
        { const int NH8 = (F.G % 8 == 0) ? 8 : 1, grp = (int)blockIdx.x % NH8, bi = (int)blockIdx.x / NH8, nbl = F.G / NH8;
#pragma unroll 1
          for (int h = grp; h < PHEADS; h += NH8) {
#pragma unroll
              for (int it = 0; it < 8; ++it) { const int id = it * 512 + F.tid, c = id & 15, n = (id >> 4) & 127, pp = id >> 11;
                  const v4u w = *(const v4u*)(KEYS + ((size_t)(h * 2 + pp) * NKEYS + n) * KD + 8 * c);
                  *(LAS v4u*)(F.lds + pp * 32768 + n * 256 + ((c ^ (n & 15)) << 4)) = w; }
              __syncthreads();
#pragma unroll 1
              for (int tg = bi * 8 + F.wave; tg < MTOK / 16; tg += nbl * 8) topk_unit(F, tg, h, QP, TOPI, TOPG);
              __syncthreads(); } }
        GRID_BAR();
    }
    {
        PHASE_BEGIN();
        const int NG = (F.G % 8 == 0) ? 8 : 1, grp = (int)blockIdx.x % NG, li = (int)blockIdx.x / NG, nl = F.G / NG;
        const int t0 = li * 8 + F.wave, ts = nl * 8, NTW = (MTOK - t0 + ts - 1) / ts;
#define LOAD_IDX(I, n) do { const int t_ = t0 + (n) * ts; I.i0 = __builtin_nontemporal_load(TOPI + (size_t)t_ * 128 + F.lane); I.i1 = __builtin_nontemporal_load(TOPI + (size_t)t_ * 128 + 64 + F.lane); } while (0)
#pragma unroll 1
        for (int sl = grp; sl < 16; sl += NG) {
            PeerIdx IA, IB; PeerRow RA, RB; v4u wA[16], wB[16];
            LOAD_IDX(IA, 0); pu_gather(t0, sl, F.lane, IA, wA, RA, X1Q, XS, PU); if (NTW > 1) LOAD_IDX(IB, 1);
#pragma unroll 1
            for (int n = 0; n < NTW; n += 2) {
                if (n + 2 < NTW) LOAD_IDX(IA, n + 2);
                if (n + 1 < NTW) pu_gather(t0 + (n + 1) * ts, sl, F.lane, IB, wB, RB, X1Q, XS, PU);
                pu_compute(t0 + n * ts, sl, F.lane, wA, RA, PART);
                if (n + 1 < NTW) {
                    if (n + 3 < NTW) LOAD_IDX(IB, n + 3);
                    if (n + 2 < NTW) pu_gather(t0 + (n + 2) * ts, sl, F.lane, IA, wA, RA, X1Q, XS, PU);
                    pu_compute(t0 + (n + 1) * ts, sl, F.lane, wB, RB, PART); }
            } }
#undef LOAD_IDX
        GRID_BAR();
#pragma unroll 1
        for (int t = gw; t < MTOK; t += NGW) peer_fin_token(t, F.lane, PART, TOPI, TOPG, USC, VSC, SQX1);
        GRID_BAR();
#define LOAD_IDXA(I, n) do { const int t_ = t0 + (n) * ts; I.i0 = __builtin_nontemporal_load(TOPI + (size_t)t_ * 128 + F.lane); I.i1 = __builtin_nontemporal_load(TOPI + (size_t)t_ * 128 + 64 + F.lane); \
            I.a0 = __builtin_nontemporal_load(TOPG + (size_t)t_ * 128 + F.lane); I.a1 = __builtin_nontemporal_load(TOPG + (size_t)t_ * 128 + 64 + F.lane); } while (0)
#pragma unroll 1
        for (int sl = grp; sl < 16; sl += NG) {
            PeerIdx IA, IB, IC; float xA[2], xB[2]; v4u wA[16], wB[16];
            LOAD_IDXA(IA, 0); pv_gather(t0, sl, F.lane, IA, wA, xA, X1B, PV); if (NTW > 1) LOAD_IDXA(IB, 1);
#pragma unroll 1
            for (int n = 0; n < NTW; n += 2) {
                if (n + 2 < NTW) LOAD_IDXA(IC, n + 2);
                if (n + 1 < NTW) pv_gather(t0 + (n + 1) * ts, sl, F.lane, IB, wB, xB, X1B, PV);
                pv_compute(t0 + n * ts, sl, F.lane, IA, wA, xA, X2, SQQ);
                IA = IC;
                if (n + 1 < NTW) {
                    if (n + 3 < NTW) LOAD_IDXA(IC, n + 3);
                    if (n + 2 < NTW) pv_gather(t0 + (n + 2) * ts, sl, F.lane, IA, wA, xA, X1B, PV);
                    pv_compute(t0 + (n + 1) * ts, sl, F.lane, IB, wB, xB, X2, SQQ);
                    IB = IC; }
            } }
#undef LOAD_IDXA
        GRID_BAR();
#pragma unroll 1
        for (int t = gw; t < MTOK; t += NGW) { const float rf = __builtin_amdgcn_rsqf(fx_get(SQQ + t) * (1.f / D_MODEL) + EPS);
            const f32x4* xr = (const f32x4*)(X2 + (size_t)t * D_MODEL) + F.lane; f32x4* orow = (f32x4*)(out + (size_t)t * D_MODEL) + F.lane;
#pragma unroll
            for (int j = 0; j < 8; ++j) { const f32x4 v = __builtin_nontemporal_load(xr + 64 * j), gg = *((const f32x4*)g_final + F.lane + 64 * j); f32x4 o4;
#pragma unroll
                for (int e = 0; e < 4; ++e) o4[e] = v[e] * rf * gg[e];
                __builtin_nontemporal_store(o4, orow + 64 * j); } }
    }
#undef GRID_BAR
}

extern "C" void kernel_launch(void* const* d_in, const int* in_sizes, int n_in, void* d_out, int out_size, void* d_ws, size_t ws_size, hipStream_t stream) {
    static int grid = 0;
    if (grid == 0) {
        if (n_in != 20 || in_sizes[0] != MTOK * D_MODEL || out_size != MTOK * D_MODEL || ws_size < WS_END) {
            fprintf(stderr, "kernel_launch: unexpected shapes (n_in %d, in0 %d, out %d, ws %zu); nothing launched\n", n_in, n_in > 0 ? in_sizes[0] : -1, out_size, ws_size); grid = -1; return; }
        int dev = 0, cus = 0;
        if (hipGetDevice(&dev) != hipSuccess || hipDeviceGetAttribute(&cus, hipDeviceAttributeMultiprocessorCount, dev) != hipSuccess) { fprintf(stderr, "kernel_launch: device query failed\n"); grid = -1; return; }
        if (hipFuncSetAttribute((const void*)mk_fwd, hipFuncAttributeMaxDynamicSharedMemorySize, LDS_BYTES) != hipSuccess) { fprintf(stderr, "kernel_launch: hipFuncSetAttribute failed\n"); grid = -1; return; }
        (void)hipGetLastError();
        grid = cus;
    }
    if (grid < 0) return;
    (void)hipMemsetAsync((char*)d_ws + WS_CTL, 0, CTL_ZERO_BYTES, stream);
    Args a{};
    for (int i = 0; i < 20; ++i) a.in[i] = (const float*)d_in[i];
    a.out = (float*)d_out; a.ws = (unsigned char*)d_ws;
    hipLaunchKernelGGL(mk_fwd, dim3(grid), dim3(512), LDS_BYTES, stream, a);
    const hipError_t le = hipPeekAtLastError();
    if (le != hipSuccess) fprintf(stderr, "kernel_launch: launch failed: %s\n", hipGetErrorName(le));
}
```

```cpp
#include <hip/hip_runtime.h>
#include <hip/hip_bf16.h>
#include <cstdio>
#include <cstdint>


constexpr int D_MODEL = 2048, NB = 2, SEQL = 8192, MTOK = NB * SEQL;
constexpr int NHEAD = 16, QL = 512, DN = 128, DR = 64, DVH = 128, DQK = 192;
constexpr int IN_COLS = 9280, IN16_ROWS = 2048, IN8_ROWS = 9472;
constexpr float Q8_SCALE = 64.f, K8_SCALE = 8.f, V8_SCALE = 8.f;
constexpr float XN8_SCALE = 8.f, WIN8_SCALE = 64.f, IN8_DESCALE = 1.f / 512.f;
constexpr int NQ_COLS = NHEAD * DQK, NKV_COLS = NHEAD * (DN + DVH);
constexpr int PHEADS = 8, NKEYS = 128, TOPK = 16, KD = 128, NEXP = 16384;
constexpr float EPS = 1e-6f;
constexpr float FXS = 16777216.f, FXI = 1.f / 16777216.f;
constexpr float C2Q = 0.07216878364870322f * 1.4426950408889634f;

constexpr size_t MiB = 1u << 20;
constexpr size_t WS_CTL = 0, CTL_ZERO_BYTES = 32 * 1024;
constexpr size_t WS_KEYS = 1 * MiB, WS_WSP = 1 * MiB + 512 * 1024;
constexpr size_t WS_WUQ = 2 * MiB, WS_WUKV = 5 * MiB, WS_WOUT = 9 * MiB, WS_WPQ = 17 * MiB;
constexpr size_t WS_ROPE = 27 * MiB;
constexpr size_t WS_WIN8 = 46 * MiB;
constexpr size_t WS_XN8 = 66 * MiB;
constexpr size_t WS_Q = 32 * MiB;
constexpr size_t WS_CQKV = 128 * MiB;
constexpr size_t WS_U = 160 * MiB;
constexpr size_t WS_VG = 224 * MiB;
constexpr size_t WS_GA = 288 * MiB;
constexpr size_t WS_V = 352 * MiB;
constexpr size_t WS_K = 416 * MiB;
constexpr size_t WS_KR = 504 * MiB;
constexpr size_t WS_X2 = 288 * MiB;
constexpr size_t WS_X1B = 96 * MiB;
constexpr size_t WS_PU = 32 * MiB, WS_PV = 64 * MiB;
constexpr size_t WS_X1Q = 160 * MiB, WS_XS = 192 * MiB;
constexpr size_t WS_PART = 288 * MiB;
constexpr size_t WS_PSC = 31 * MiB;
constexpr size_t WS_QP = 224 * MiB;
constexpr size_t WS_TOPI = 480 * MiB, WS_TOPG = 488 * MiB;
constexpr size_t WS_END = 512 * MiB;
constexpr int CW_BAR = 4096;
constexpr size_t CTL_STATS = 128 * 1024;
constexpr int RING_OFF = 0, RING_BYTES = 131072;
constexpr int LDSCTL_OFF = RING_BYTES, MISC_OFF = LDSCTL_OFF + 320;
constexpr int LDS_BYTES = 147456;

#define GAS __attribute__((address_space(1)))
#define LAS __attribute__((address_space(3)))
typedef unsigned short bf16;
typedef unsigned v4u __attribute__((ext_vector_type(4)));
typedef unsigned v2u __attribute__((ext_vector_type(2)));
typedef float f32x4 __attribute__((ext_vector_type(4)));
typedef float f32x16 __attribute__((ext_vector_type(16)));
typedef short bf16x8 __attribute__((ext_vector_type(8)));
typedef short s16x4 __attribute__((ext_vector_type(4)));
typedef int v8i __attribute__((ext_vector_type(8)));
typedef unsigned long long u64;
#define LDS_WAIT() asm volatile("s_waitcnt lgkmcnt(0)" ::: "memory")
#define VM_WAIT() asm volatile("s_waitcnt vmcnt(0)" ::: "memory")
#define SBAR() __builtin_amdgcn_sched_barrier(0)

typedef float f32x2_t __attribute__((ext_vector_type(2))); typedef __bf16 bf16x2_t __attribute__((ext_vector_type(2)));
__device__ __forceinline__ unsigned cvt_pk_bf16(float lo, float hi) { f32x2_t v = {lo, hi}; bf16x2_t b = __builtin_convertvector(v, bf16x2_t); return __builtin_bit_cast(unsigned, b); }
__device__ __forceinline__ unsigned pack_fp8x4(f32x4 v) {
    v = __builtin_elementwise_min(__builtin_elementwise_max(v, (f32x4){-448.f, -448.f, -448.f, -448.f}), (f32x4){448.f, 448.f, 448.f, 448.f});
    int p = 0; p = __builtin_amdgcn_cvt_pk_fp8_f32(v[0], v[1], p, false); p = __builtin_amdgcn_cvt_pk_fp8_f32(v[2], v[3], p, true); return (unsigned)p; }
__device__ __forceinline__ float bf_lo(unsigned w) { return __uint_as_float(w << 16); }
__device__ __forceinline__ float bf_hi(unsigned w) { return __uint_as_float(w & 0xffff0000u); }
__device__ __forceinline__ float gelu_t(float x) { const float t = x * (1.f + 0.044715f * x * x); const float e = __builtin_amdgcn_exp2f(-2.3022081986f * t); return x * __builtin_amdgcn_rcpf(1.f + e); }
__device__ __forceinline__ float sigmoid_f(float y) { return __builtin_amdgcn_rcpf(1.f + __builtin_amdgcn_exp2f(-1.4426950409f * y)); }
__device__ __forceinline__ void fx_add(u64* p, float v) { const long long q = __float2ll_rn(v * FXS); atomicAdd(p, (u64)q); }
__device__ __forceinline__ float fx_get(const u64* p) { return (float)((double)(long long)(*p) * (double)FXI); }
__device__ __forceinline__ int lane_id() { int l; asm volatile("v_mbcnt_lo_u32_b32 %0, -1, 0\n\tv_mbcnt_hi_u32_b32 %0, -1, %0" : "=v"(l)); return l; }

__device__ __forceinline__ float shx(float v, int o, int lane) { return __builtin_bit_cast(float, __builtin_amdgcn_ds_bpermute((lane ^ o) << 2, __builtin_bit_cast(int, v))); }
__device__ __forceinline__ float wave_sum(float v, int lane) {
#pragma unroll
    for (int o = 1; o < 64; o <<= 1) v += shx(v, o, lane);
    return v;
}

namespace pg8 {
#define PG8_LAS __attribute__((address_space(3)))
typedef unsigned short bf16_t;
constexpr int BM = 256, BK = 64, HALF = 128, HTB = HALF * BK * 2, STAGE_BYTES = 8 * HTB, NXCD = 8, WGM = 8;
__host__ __device__ __forceinline__ int lds_byte(int r, int c) { const int st = (r >> 4) * 2 + (c >> 5), rr = r & 15, cc = c & 31, ob = rr * 64 + cc * 2; return st * 1024 + (ob ^ (((ob >> 9) & 1) << 5)); }
__host__ __device__ __forceinline__ void stage_rc(int b, int& R, int& C) { const int st = b / 1024, sb = b % 1024, swz = sb ^ (((sb >> 9) & 1) << 5); R = (st >> 1) * 16 + swz / 64; C = (st & 1) * 32 + (swz % 64) / 2; }
__host__ __device__ __forceinline__ int perm32(int rho) { const int n = rho >> 4, i = rho & 15; return 8 * (i >> 2) + 4 * n + (i & 3); }
struct Unit { int pm, pn; };
struct Gemm { const bf16_t* A; const bf16_t* Bt; int M, N, K, lda; };
struct StaticOrder {
    int nM, nN, nwg, G, c;
    __host__ __device__ void init(int M, int N, int G_, int c_) { nM = M / BM; nN = N / BM; nwg = nM * nN; G = G_; c = c_; }
    __host__ __device__ bool next(int i, Unit& u) const {
        const long L = (long)i * G + c; if (L >= nwg) return false;
        int wgid = (int)L; { const int q = nwg / NXCD, r = nwg % NXCD, xcd = wgid % NXCD, off = wgid / NXCD; wgid = (xcd < r ? xcd * (q + 1) : r * (q + 1) + (xcd - r) * q) + off; }
        const int nig = WGM * nN, gid = wgid / nig, fm = gid * WGM, gsz = (nM - fm) < WGM ? (nM - fm) : WGM;
        u.pm = fm + ((wgid % nig) % gsz); u.pn = (wgid % nig) / gsz; return true;
    }
};
template <class Epi, class Sched, bool ALIGN_EPI = false, bool SP2 = false, bool F8 = false, bool SWAP1 = false>
__device__ __forceinline__ void gemm_phase(PG8_LAS unsigned char* lds, const Gemm g, const Sched& S, const Epi& E, const int wave) {
    int tid = wave * 64 + lane_id(); asm volatile("" : "+v"(tid));
    const int wid = __builtin_amdgcn_readfirstlane(tid >> 6), lane = tid & 63, wr = wid >> 2, wc = wid & 3, fr = lane & 15, fq = lane >> 4;
    const int K = g.K, nt = K / BK, lda = g.lda;
    unsigned voffA[2], voffB[2];
#pragma unroll
    for (int i = 0; i < 2; ++i) { int R, C; stage_rc(tid * 16 + i * 8192, R, C); const int Rb = Epi::PERM ? ((R & ~31) + perm32(R & 31)) : R;
        voffA[i] = (unsigned)(R * lda + C) * 2u; voffB[i] = (unsigned)(Rb * K + C) * 2u; }
    const size_t kstep = (size_t)(BK * 2);
    const size_t hstepA = (size_t)HALF * lda * 2, hstepB = (size_t)HALF * K * 2;
    const size_t tstepA = 2 * hstepA, tstepB = 2 * hstepB;
    const unsigned ldsw = (unsigned)wid * 1024u;
    const int aoff = lds_byte(wr * 64 + fr, fq * 8), boff = lds_byte(wc * 32 + fr, fq * 8);
#define PG8_SA(b, h) (((b) * 2 + (h)) * HTB)
#define PG8_SB(b, h) ((4 + (b) * 2 + (h)) * HTB)
#define PG8_STAGE(bufoff, gbase, voff) do { _Pragma("unroll") for (int _i = 0; _i < 2; ++_i) \
        { unsigned vo_ = (voff)[_i]; asm volatile("" : "+v"(vo_)); __builtin_amdgcn_global_load_lds((const unsigned*)((const char*)(gbase) + vo_), (PG8_LAS unsigned*)(lds + (bufoff) + ldsw + _i * 8192), 16, 0, 0); } } while (0)
#define PG8_LDA(dst, b, h) do { _Pragma("unroll") for (int m = 0; m < 4; ++m) _Pragma("unroll") for (int k = 0; k < 2; ++k) dst[m][k] = *(const PG8_LAS bf16x8*)(lds + PG8_SA(b, h) + aoff + m * 2048 + k * 1024); } while (0)
#define PG8_LDB(dst, b, h) do { _Pragma("unroll") for (int n = 0; n < 2; ++n) _Pragma("unroll") for (int k = 0; k < 2; ++k) dst[n][k] = *(const PG8_LAS bf16x8*)(lds + PG8_SB(b, h) + boff + n * 2048 + k * 1024); } while (0)
#define PG8_CAT(x) __builtin_bit_cast(v8i, __builtin_shufflevector((x)[0], (x)[1], 0, 1, 2, 3, 4, 5, 6, 7, 8, 9, 10, 11, 12, 13, 14, 15))
#define PG8_MMA(ai, bj, At, Bt) do { __builtin_amdgcn_s_setprio(1); _Pragma("unroll") for (int m = 0; m < 4; ++m) _Pragma("unroll") for (int n = 0; n < 2; ++n) { \
        if constexpr (F8 && SWAP1 && (bj) == 1) acc[ai][bj][m][n] = __builtin_amdgcn_mfma_scale_f32_16x16x128_f8f6f4(PG8_CAT(At[m]), PG8_CAT(Bt[n]), acc[ai][bj][m][n], 0, 0, 0, 0x7f7f7f7f, 0, 0x7f7f7f7f); \
        else if constexpr (F8) acc[ai][bj][m][n] = __builtin_amdgcn_mfma_scale_f32_16x16x128_f8f6f4(PG8_CAT(Bt[n]), PG8_CAT(At[m]), acc[ai][bj][m][n], 0, 0, 0, 0x7f7f7f7f, 0, 0x7f7f7f7f); \
        else { _Pragma("unroll") for (int k = 0; k < 2; ++k) acc[ai][bj][m][n] = __builtin_amdgcn_mfma_f32_16x16x32_bf16(Bt[n][k], At[m][k], acc[ai][bj][m][n], 0, 0, 0); } } __builtin_amdgcn_s_setprio(0); } while (0)
#define PG8_WAIT_V(n) asm volatile("s_waitcnt vmcnt(" #n ")" ::: "memory")
#define PG8_WAIT_L(n) asm volatile("s_waitcnt lgkmcnt(" #n ")" ::: "memory")
#define PG8_BAR __builtin_amdgcn_s_barrier()
#define PG8_SCHED __builtin_amdgcn_sched_barrier(0)
    Unit cur, nxt; int ui = 0;
    if (!S.next(0, cur)) return;
    f32x4 acc[2][2][4][2];
#pragma unroll
    for (int a = 0; a < 2; ++a)
#pragma unroll
        for (int b = 0; b < 2; ++b)
#pragma unroll
            for (int m = 0; m < 4; ++m)
#pragma unroll
                for (int n = 0; n < 2; ++n) acc[a][b][m][n] = (f32x4){0.f, 0.f, 0.f, 0.f};
    bf16x8 At[4][2], B0[2][2], B1[2][2];
    const char* cA = (const char*)g.A + (size_t)cur.pm * tstepA; const char* cB = (const char*)g.Bt + (size_t)cur.pn * tstepB;
    if constexpr (SP2) {
        PG8_STAGE(PG8_SB(0, 0), cB, voffB); PG8_STAGE(PG8_SB(0, 1), cB + hstepB, voffB); PG8_STAGE(PG8_SA(0, 0), cA, voffA); PG8_STAGE(PG8_SA(0, 1), cA + hstepA, voffA);
        if (wr == 1) PG8_BAR;
        PG8_WAIT_V(2); PG8_BAR;
        PG8_STAGE(PG8_SB(1, 0), cB + kstep, voffB); PG8_STAGE(PG8_SA(1, 0), cA + kstep, voffA); PG8_STAGE(PG8_SB(1, 1), cB + hstepB + kstep, voffB);
        PG8_WAIT_V(6); PG8_BAR;
    } else {
        PG8_STAGE(PG8_SB(0, 0), cB, voffB); PG8_STAGE(PG8_SA(0, 0), cA, voffA); PG8_STAGE(PG8_SB(0, 1), cB + hstepB, voffB); PG8_STAGE(PG8_SA(0, 1), cA + hstepA, voffA);
        if (wr == 1) PG8_BAR;
        PG8_WAIT_V(4); PG8_BAR;
        PG8_STAGE(PG8_SB(1, 0), cB + kstep, voffB); PG8_STAGE(PG8_SA(1, 0), cA + kstep, voffA); PG8_STAGE(PG8_SB(1, 1), cB + hstepB + kstep, voffB);
        PG8_WAIT_V(6); PG8_BAR;
    }
    for (;;) {
        const bool has_next = S.next(ui + 1, nxt);
        const char* nA = has_next ? (const char*)g.A + (size_t)nxt.pm * tstepA : cA; const char* nB = has_next ? (const char*)g.Bt + (size_t)nxt.pn * tstepB : cB;
#pragma unroll 1
        for (int t = 0; t < nt; t += 2) {
            const bool last = (t == nt - 2);
            const char* a1 = cA + (size_t)(t + 1) * kstep;
            const char* a2 = last ? nA : cA + (size_t)(t + 2) * kstep; const char* b2 = last ? nB : cB + (size_t)(t + 2) * kstep;
            const char* a3 = a2 + kstep; const char* b3 = b2 + kstep;
            if constexpr (SP2) {
            PG8_LDB(B0, 0, 0); PG8_LDB(B1, 0, 1); PG8_SCHED; PG8_LDA(At, 0, 0); PG8_STAGE(PG8_SA(1, 1), a1 + hstepA, voffA);
            PG8_WAIT_V(8); PG8_WAIT_L(0); PG8_BAR; PG8_MMA(0, 0, At, B0); PG8_MMA(0, 1, At, B1); PG8_BAR; PG8_SCHED;
            PG8_LDA(At, 0, 1); PG8_STAGE(PG8_SB(0, 0), b2, voffB); PG8_STAGE(PG8_SB(0, 1), b2 + hstepB, voffB); PG8_STAGE(PG8_SA(0, 0), a2, voffA);
            PG8_WAIT_V(8); PG8_WAIT_L(0); PG8_BAR; PG8_MMA(1, 0, At, B0); PG8_MMA(1, 1, At, B1); PG8_BAR; PG8_SCHED;
            PG8_LDB(B0, 1, 0); PG8_LDB(B1, 1, 1); PG8_SCHED; PG8_LDA(At, 1, 0); PG8_STAGE(PG8_SA(0, 1), a2 + hstepA, voffA);
            PG8_WAIT_V(8); PG8_WAIT_L(0); PG8_BAR; PG8_MMA(0, 0, At, B0); PG8_MMA(0, 1, At, B1); PG8_BAR; PG8_SCHED;
            PG8_LDA(At, 1, 1); PG8_STAGE(PG8_SB(1, 0), b3, voffB); PG8_STAGE(PG8_SB(1, 1), b3 + hstepB, voffB); PG8_STAGE(PG8_SA(1, 0), a3, voffA);
            PG8_WAIT_V(8); PG8_WAIT_L(0); PG8_BAR; PG8_MMA(1, 0, At, B0); PG8_MMA(1, 1, At, B1); PG8_BAR; PG8_SCHED;
            } else {
            PG8_LDB(B0, 0, 0); PG8_SCHED; PG8_LDA(At, 0, 0); PG8_STAGE(PG8_SA(1, 1), a1 + hstepA, voffA);
            PG8_WAIT_L(8); PG8_BAR; PG8_WAIT_L(0); PG8_MMA(0, 0, At, B0); PG8_BAR; PG8_SCHED;
            PG8_LDB(B1, 0, 1); PG8_STAGE(PG8_SB(0, 0), b2, voffB);
            PG8_BAR; PG8_WAIT_L(0); PG8_MMA(0, 1, At, B1); PG8_BAR;
            PG8_LDA(At, 0, 1); PG8_STAGE(PG8_SA(0, 0), a2, voffA);
            PG8_BAR; PG8_WAIT_L(0); PG8_MMA(1, 0, At, B0); PG8_BAR; PG8_SCHED;
            PG8_STAGE(PG8_SB(0, 1), b2 + hstepB, voffB);
            PG8_WAIT_V(6); PG8_BAR; PG8_MMA(1, 1, At, B1); PG8_BAR;
            PG8_LDB(B0, 1, 0); PG8_SCHED; PG8_LDA(At, 1, 0); PG8_STAGE(PG8_SA(0, 1), a2 + hstepA, voffA);
            PG8_WAIT_L(8); PG8_BAR; PG8_WAIT_L(0); PG8_MMA(0, 0, At, B0); PG8_BAR; PG8_SCHED;
            PG8_LDB(B1, 1, 1); PG8_STAGE(PG8_SB(1, 0), b3, voffB);
            PG8_BAR; PG8_WAIT_L(0); PG8_MMA(0, 1, At, B1); PG8_BAR;
            PG8_LDA(At, 1, 1); PG8_STAGE(PG8_SA(1, 0), a3, voffA);
            PG8_BAR; PG8_WAIT_L(0); PG8_MMA(1, 0, At, B0); PG8_BAR; PG8_SCHED;
            PG8_STAGE(PG8_SB(1, 1), b3 + hstepB, voffB);
            PG8_WAIT_V(6); PG8_BAR; PG8_MMA(1, 1, At, B1); PG8_BAR;
            }
        }
        if constexpr (ALIGN_EPI) { if (wr == 0) PG8_BAR; }
        { const int le = lane_id(); E(acc, cur, wr, wc, le & 15, le >> 4); }
        if (!has_next) break;
#pragma unroll
        for (int a = 0; a < 2; ++a)
#pragma unroll
            for (int b = 0; b < 2; ++b)
#pragma unroll
                for (int m = 0; m < 4; ++m)
#pragma unroll
                    for (int n = 0; n < 2; ++n) acc[a][b][m][n] = (f32x4){0.f, 0.f, 0.f, 0.f};
        cur = nxt; cA = nA; cB = nB; ++ui;
        if constexpr (ALIGN_EPI) { if (wr == 1) PG8_BAR; }
    }
    PG8_WAIT_V(0);
    if constexpr (!ALIGN_EPI) { if (wr == 0) PG8_BAR; }
    PG8_BAR;
#undef PG8_SA
#undef PG8_SB
#undef PG8_STAGE
#undef PG8_LDA
#undef PG8_LDB
#undef PG8_MMA
#undef PG8_CAT
#undef PG8_WAIT_V
#undef PG8_WAIT_L
#undef PG8_BAR
#undef PG8_SCHED
}

#define EPI_ROWS(ai, m) (u.pm * BM + wr * 64 + fr + (ai) * HALF + (m) * 16)
struct EpiIn {
    static constexpr bool PERM = true;
    int mode; float sc;
    bf16_t *U, *GA, *VG; unsigned char *CQKV, *KR; const float* bgate; const float* rope; u64 *sqq, *sqkv, *ssum, *ssq;
    __device__ __forceinline__ void operator()(const f32x4 (&acc)[2][2][4][2], const Unit& u, int wr, int wc, int fr, int fq) const {
        const int pn = u.pn, cw = wc * 32 + 8 * fq;
        if (mode == 1 || pn >= 29) {
            const int c0 = (mode == 1 ? pn : pn - 29) * 256 + cw;
#pragma unroll
            for (int ai = 0; ai < 2; ++ai)
#pragma unroll
                for (int m = 0; m < 4; ++m) { const int row = EPI_ROWS(ai, m); float s = 0.f, q = 0.f;
#pragma unroll
                    for (int bj = 0; bj < 2; ++bj) { f32x4 v0 = acc[ai][bj][m][0] * sc, v1 = acc[ai][bj][m][1] * sc;
#pragma unroll
                        for (int e = 0; e < 4; ++e) { v0[e] = gelu_t(v0[e]); v1[e] = gelu_t(v1[e]); }
                        s += (v0[0] + v0[1]) + (v0[2] + v0[3]) + (v1[0] + v1[1]) + (v1[2] + v1[3]);
                        q += (v0[0] * v0[0] + v0[1] * v0[1]) + (v0[2] * v0[2] + v0[3] * v0[3]) + (v1[0] * v1[0] + v1[1] * v1[1]) + (v1[2] * v1[2] + v1[3] * v1[3]);
                        v4u w; w.x = cvt_pk_bf16(v0[0], v0[1]); w.y = cvt_pk_bf16(v0[2], v0[3]); w.z = cvt_pk_bf16(v1[0], v1[1]); w.w = cvt_pk_bf16(v1[2], v1[3]);
                        __builtin_nontemporal_store(w, (v4u*)(VG + (size_t)row * 2048 + c0 + bj * HALF)); }
                    s += shx(s, 16, fq * 16 + fr); s += shx(s, 32, fq * 16 + fr); q += shx(q, 16, fq * 16 + fr); q += shx(q, 32, fq * 16 + fr);
                    if (fq == 0) { fx_add(ssum + row, s); fx_add(ssq + row, q); } }
        } else if (pn < 16) {
            const int c0 = pn * 128 + cw; const float* bg = bgate + 2048 + c0;
            const f32x4 b0 = *(const f32x4*)bg, b1 = *(const f32x4*)(bg + 4);
#pragma unroll
            for (int ai = 0; ai < 2; ++ai)
#pragma unroll
                for (int m = 0; m < 4; ++m) { const int row = EPI_ROWS(ai, m);
                    f32x4 v0 = acc[ai][0][m][0] * sc, v1 = acc[ai][0][m][1] * sc; const f32x4 g0 = acc[ai][1][m][0] * sc + b0, g1 = acc[ai][1][m][1] * sc + b1;
#pragma unroll
                    for (int e = 0; e < 4; ++e) { v0[e] = gelu_t(v0[e]) * sigmoid_f(g0[e]); v1[e] = gelu_t(v1[e]) * sigmoid_f(g1[e]); }
                    v4u w; w.x = cvt_pk_bf16(v0[0], v0[1]); w.y = cvt_pk_bf16(v0[2], v0[3]); w.z = cvt_pk_bf16(v1[0], v1[1]); w.w = cvt_pk_bf16(v1[2], v1[3]);
                    __builtin_nontemporal_store(w, (v4u*)(U + (size_t)row * 2048 + c0)); }
        } else if (pn < 24) {
            const int c0 = (pn - 16) * 256 + cw; const float* bg = bgate + c0;
            f32x4 bv[2][2];
#pragma unroll
            for (int bj = 0; bj < 2; ++bj) { bv[bj][0] = *(const f32x4*)(bg + bj * HALF); bv[bj][1] = *(const f32x4*)(bg + bj * HALF + 4); }
#pragma unroll
            for (int ai = 0; ai < 2; ++ai)
#pragma unroll
                for (int m = 0; m < 4; ++m) { const int row = EPI_ROWS(ai, m);
#pragma unroll
                    for (int bj = 0; bj < 2; ++bj) { f32x4 v0 = acc[ai][bj][m][0] * sc + bv[bj][0], v1 = acc[ai][bj][m][1] * sc + bv[bj][1];
#pragma unroll
                        for (int e = 0; e < 4; ++e) { v0[e] = sigmoid_f(v0[e]); v1[e] = sigmoid_f(v1[e]); }
                        v4u w; w.x = cvt_pk_bf16(v0[0], v0[1]); w.y = cvt_pk_bf16(v0[2], v0[3]); w.z = cvt_pk_bf16(v1[0], v1[1]); w.w = cvt_pk_bf16(v1[2], v1[3]);
                        __builtin_nontemporal_store(w, (v4u*)(GA + (size_t)row * 2048 + c0 + bj * HALF)); } }
        } else if (pn < 28) {
            const int pc = pn - 24; u64* sq = pc < 2 ? sqq : sqkv;
#pragma unroll
            for (int ai = 0; ai < 2; ++ai)
#pragma unroll
                for (int m = 0; m < 4; ++m) { const int row = EPI_ROWS(ai, m); float s = 0.f;
#pragma unroll
                    for (int bj = 0; bj < 2; ++bj) { const f32x4 v0 = acc[ai][bj][m][0] * sc, v1 = acc[ai][bj][m][1] * sc;
                        s += (v0[0] * v0[0] + v0[1] * v0[1]) + (v0[2] * v0[2] + v0[3] * v0[3]) + (v1[0] * v1[0] + v1[1] * v1[1]) + (v1[2] * v1[2] + v1[3] * v1[3]);
                        v2u w; w.x = pack_fp8x4(v0 * XN8_SCALE); w.y = pack_fp8x4(v1 * XN8_SCALE);
                        *(v2u*)(CQKV + (size_t)row * 1024 + pc * 256 + bj * HALF + cw) = w; }
                    s += shx(s, 16, fq * 16 + fr); s += shx(s, 32, fq * 16 + fr);
                    if (fq == 0) fx_add(sq + row, s); }
        } else {
            if (wc < 2) {
                const int i0 = cw >> 1;
#pragma unroll
                for (int ai = 0; ai < 2; ++ai)
#pragma unroll
                    for (int m = 0; m < 4; ++m) { const int row = EPI_ROWS(ai, m);
                        const f32x4 c4 = *(const f32x4*)(rope + (size_t)row * 32 + i0), s4 = *(const f32x4*)(rope + (size_t)MTOK * 32 + (size_t)row * 32 + i0);
                        const f32x4 v0 = acc[ai][0][m][0] * sc, v1 = acc[ai][0][m][1] * sc;
                        const f32x4 r0 = {v0[0] * c4[0] - v0[1] * s4[0], v0[0] * s4[0] + v0[1] * c4[0], v0[2] * c4[1] - v0[3] * s4[1], v0[2] * s4[1] + v0[3] * c4[1]};
                        const f32x4 r1 = {v1[0] * c4[2] - v1[1] * s4[2], v1[0] * s4[2] + v1[1] * c4[2], v1[2] * c4[3] - v1[3] * s4[3], v1[2] * s4[3] + v1[3] * c4[3]};
                        v2u w; w.x = pack_fp8x4(r0 * K8_SCALE); w.y = pack_fp8x4(r1 * K8_SCALE);
                        *(v2u*)(KR + (size_t)row * DR + cw) = w; }
            }
        }
    }
};
struct EpiQ {
    static constexpr bool PERM = true;
    unsigned char* Q; const u64* sqq; const float* rope;
    __device__ __forceinline__ void operator()(const f32x4 (&acc)[2][2][4][2], const Unit& u, int wr, int wc, int fr, int fq) const {
        const int cw = wc * 32 + 8 * fq;
#pragma unroll
        for (int ai = 0; ai < 2; ++ai)
#pragma unroll
            for (int m = 0; m < 4; ++m) { const int row = EPI_ROWS(ai, m); const int b = row >> 13, s = row & 8191;
                const float rq = __builtin_amdgcn_rsqf(fx_get(sqq + row) * (1.f / QL) + EPS) * (C2Q * IN8_DESCALE * Q8_SCALE);
#pragma unroll
                for (int bj = 0; bj < 2; ++bj) { const int colg = u.pn * 256 + bj * HALF + cw; const int head = colg / DQK, dd = colg - head * DQK;
                    f32x4 v0 = acc[ai][bj][m][0] * rq, v1 = acc[ai][bj][m][1] * rq;
                    if (dd >= DN) { const int i0 = (dd - DN) >> 1;
                        const f32x4 c4 = *(const f32x4*)(rope + (size_t)row * 32 + i0), s4 = *(const f32x4*)(rope + (size_t)MTOK * 32 + (size_t)row * 32 + i0);
                        const f32x4 r0 = {v0[0] * c4[0] - v0[1] * s4[0], v0[0] * s4[0] + v0[1] * c4[0], v0[2] * c4[1] - v0[3] * s4[1], v0[2] * s4[1] + v0[3] * c4[1]};
                        const f32x4 r1 = {v1[0] * c4[2] - v1[1] * s4[2], v1[0] * s4[2] + v1[1] * c4[2], v1[2] * c4[3] - v1[3] * s4[3], v1[2] * s4[3] + v1[3] * c4[3]};
                        v0 = r0; v1 = r1; }
                    v2u w; w.x = pack_fp8x4(v0); w.y = pack_fp8x4(v1);
                    *(v2u*)(Q + ((size_t)(b * NHEAD + head) * SEQL + s) * DQK + dd) = w; } }
    }
};
struct EpiKV {
    static constexpr bool PERM = true;
    unsigned char* Kb; unsigned char* Vt; const u64* sqkv;
    __device__ __forceinline__ void operator()(const f32x4 (&acc)[2][2][4][2], const Unit& u, int wr, int wc, int fr, int fq) const {
        const int cw = wc * 32 + 8 * fq, head = u.pn;
#pragma unroll
        for (int ai = 0; ai < 2; ++ai)
#pragma unroll
            for (int m = 0; m < 4; ++m) {
                { const int row = EPI_ROWS(ai, m); const int b = row >> 13, s = row & 8191;
                  const float rk = __builtin_amdgcn_rsqf(fx_get(sqkv + row) * (1.f / QL) + EPS) * (IN8_DESCALE * K8_SCALE); const size_t tr = (size_t)(b * NHEAD + head) * SEQL + s;
                  v2u w; w.x = pack_fp8x4(acc[ai][0][m][0] * rk); w.y = pack_fp8x4(acc[ai][0][m][1] * rk); *(v2u*)(Kb + tr * DN + cw) = w; }
                { const int row0 = u.pm * BM + wr * 64 + ai * HALF + m * 16 + 4 * fq; const int b = row0 >> 13, s0 = row0 & 8191;
                  f32x4 rk4;
#pragma unroll
                  for (int e = 0; e < 4; ++e) rk4[e] = __builtin_amdgcn_rsqf(fx_get(sqkv + row0 + e) * (1.f / QL) + EPS) * (IN8_DESCALE * V8_SCALE);
                  const int slot = (s0 & ~63) + 32 * (fq & 1) + 4 * (2 * m + (fq >> 1));
#pragma unroll
                  for (int n = 0; n < 2; ++n) { const int dv = wc * 32 + 8 * (fr >> 2) + 4 * n + (fr & 3);
                      *(unsigned*)(Vt + ((size_t)(b * NHEAD + head) * DVH + dv) * SEQL + slot) = pack_fp8x4(acc[ai][1][m][n] * rk4); } }
            }
    }
};
struct EpiOut {
    static constexpr bool PERM = false;
    const float* x; bf16_t* X1B; u64* sqx;
    __device__ __forceinline__ void operator()(const f32x4 (&acc)[2][2][4][2], const Unit& u, int wr, int wc, int fr, int fq) const {
        const int col0 = u.pn * BM + wc * 32 + 4 * fq;
#pragma unroll
        for (int ai = 0; ai < 2; ++ai)
#pragma unroll
            for (int m = 0; m < 4; ++m) { const int row = EPI_ROWS(ai, m); float s = 0.f;
#pragma unroll
                for (int bj = 0; bj < 2; ++bj)
#pragma unroll
                    for (int n = 0; n < 2; ++n) { const size_t off = (size_t)row * D_MODEL + col0 + bj * HALF + n * 16;
                        const f32x4 v = *(const f32x4*)(x + off) + acc[ai][bj][m][n];
                        s += (v[0] * v[0] + v[1] * v[1]) + (v[2] * v[2] + v[3] * v[3]);
                        v2u w; w.x = cvt_pk_bf16(v[0], v[1]); w.y = cvt_pk_bf16(v[2], v[3]); *(v2u*)(X1B + off) = w; }
                s += shx(s, 16, fq * 16 + fr); s += shx(s, 32, fq * 16 + fr);
                if (fq == 0) fx_add(sqx + row, s); }
    }
};
struct EpiPQ {
    static constexpr bool PERM = true;
    bf16_t* QP; const u64* sqx;
    __device__ __forceinline__ void operator()(const f32x4 (&acc)[2][2][4][2], const Unit& u, int wr, int wc, int fr, int fq) const {
        const int cw = u.pn * 256 + wc * 32 + 8 * fq;
#pragma unroll
        for (int ai = 0; ai < 2; ++ai)
#pragma unroll
            for (int m = 0; m < 4; ++m) { const int row = EPI_ROWS(ai, m);
                const float r2 = __builtin_amdgcn_rsqf(fx_get(sqx + row) * (1.f / D_MODEL) + EPS);
#pragma unroll
                for (int bj = 0; bj < 2; ++bj) { const f32x4 v0 = acc[ai][bj][m][0] * r2, v1 = acc[ai][bj][m][1] * r2;
                    v4u w; w.x = cvt_pk_bf16(v0[0], v0[1]); w.y = cvt_pk_bf16(v0[2], v0[3]); w.z = cvt_pk_bf16(v1[0], v1[1]); w.w = cvt_pk_bf16(v1[2], v1[3]);
                    __builtin_nontemporal_store(w, (v4u*)(QP + (size_t)row * D_MODEL + cw + bj * HALF)); } }
    }
};
#undef EPI_ROWS
}

typedef GAS unsigned gu32;
#define RLX_AGENT __ATOMIC_RELAXED, __HIP_MEMORY_SCOPE_AGENT
#define XB_TMO      128
#define XB_XCNT(j)  (256  + 64 * (j))
#define XB_XSUB(j)  (1280 + 64 * (j))
#define XB_XGEN(j)  (2304 + 64 * (j))
#define XB_TOP      3328
#define XB_TOPGEN   3392
#define XCD_BAR_WORDS 3456
#define XB_SPIN_CAP (1u << 18)
__device__ __forceinline__ unsigned xb_ld(unsigned* p)              { return __hip_atomic_load(p, __ATOMIC_RELAXED, __HIP_MEMORY_SCOPE_AGENT); }
__device__ __forceinline__ unsigned xb_add(unsigned* p, unsigned v) { return __hip_atomic_fetch_add(p, v, __ATOMIC_RELAXED, __HIP_MEMORY_SCOPE_AGENT); }
__device__ __forceinline__ unsigned xb_xcc_id() { return (unsigned)__builtin_amdgcn_s_getreg((3 << 11) | 20) & 0xFu; }
#define XB_SPIN(cond, bar) do { unsigned _sp = 0; while (cond) { __builtin_amdgcn_s_sleep(1); \
    if ((++_sp & 255u) == 0u) { if (xb_ld(&(bar)[XB_TMO])) break; if (_sp > XB_SPIN_CAP) { atomicAdd(&(bar)[XB_TMO], 1u); break; } } } } while (0)
struct XcdBarrier { unsigned* bar; unsigned x; volatile LAS unsigned* st; int wave; };
__device__ __forceinline__ XcdBarrier xcd_barrier_post(unsigned* bar, volatile LAS unsigned* st, int wave) {
    XcdBarrier b; b.bar = bar; b.x = xb_xcc_id(); b.st = st; b.wave = wave;
    if (wave == 0 && lane_id() == 0) (void)xb_add(&bar[XB_XCNT(b.x)], 1u);
    return b;
}
__device__ __forceinline__ void xcd_barrier_complete(unsigned* bar, unsigned x, unsigned& nloc, unsigned& nx) {
    const unsigned G = gridDim.x * gridDim.y * gridDim.z;
    unsigned sum, cnt, mine, sp = 0u;
    for (;;) {
        sum = 0u; cnt = 0u; mine = 0u;
#pragma unroll
        for (unsigned j = 0; j < 16; ++j) { const unsigned c = xb_ld(&bar[XB_XCNT(j)]); sum += c; cnt += (c > 0u) ? 1u : 0u; mine = (j == x) ? c : mine; }
        if (sum == G) break;
        __builtin_amdgcn_s_sleep(1);
        if ((++sp & 255u) == 0u) { if (xb_ld(&bar[XB_TMO])) break; if (sp > XB_SPIN_CAP) { atomicAdd(&bar[XB_TMO], 1u); break; } }
    }
    nloc = mine > 0u ? mine : 1u; nx = cnt > 0u ? cnt : 1u;
}
__device__ __forceinline__ void xcd_barrier(const XcdBarrier& b) {
    asm volatile("s_waitcnt vmcnt(0)" ::: "memory");
    __syncthreads();
    if (b.wave == 0 && lane_id() == 0) {
        unsigned* bar = b.bar;
        __builtin_amdgcn_s_waitcnt(0);
        unsigned nloc = b.st[0], nx = b.st[1];
        if (nloc == 0u) { xcd_barrier_complete(bar, b.x, nloc, nx); b.st[0] = nloc; b.st[1] = nx; }
        const unsigned old = xb_add(&bar[XB_XSUB(b.x)], 1u);
        const unsigned gen = old / nloc;
        if (old + 1u == (gen + 1u) * nloc) {
            __builtin_amdgcn_fence(__ATOMIC_RELEASE, "agent");
            asm volatile("s_waitcnt vmcnt(0)" ::: "memory");
            const unsigned og = xb_add(&bar[XB_TOP], 1u);
            const unsigned tg = og / nx;
            if (og + 1u == (tg + 1u) * nx) xb_add(&bar[XB_TOPGEN], 1u);
            else XB_SPIN(xb_ld(&bar[XB_TOPGEN]) == tg, bar);
            __builtin_amdgcn_fence(__ATOMIC_ACQUIRE, "agent");
            xb_add(&bar[XB_XGEN(b.x)], 1u);
            asm volatile("s_waitcnt vmcnt(0)" ::: "memory");
        } else {
            XB_SPIN(xb_ld(&bar[XB_XGEN(b.x)]) == gen, bar);
            __builtin_amdgcn_fence(__ATOMIC_ACQUIRE, "agent");
            asm volatile("s_waitcnt vmcnt(0)" ::: "memory");
        }
    }
    __syncthreads();
}

struct Args { const float* in[20]; float* out; unsigned char* ws; };
struct Frame {
    LAS unsigned char* lds; int tid, lane, wave, vcu, G;
};

__device__ __forceinline__ int colmap(int mode, int r) {
    if (mode == 0) return r;
    if (mode == 1) return 3136 + r;
    if (mode == 3) { if (r < 4096) { const int k = r >> 8, j = r & 255; return j < 128 ? 1088 + 128 * k + j : 7232 + 128 * k + (j - 128); } if (r < 6144) return 5184 + (r - 4096); if (r < 7168) return r - 6144;
        if (r < 7232) { const int j = r - 7168; return 1024 + (j >> 1) + 32 * (j & 1); } if (r < 7424) return -1; return 3136 + (r - 7424); }
    const int h = r / DQK, d = r - h * DQK; if (d < DN) return r; const int j = d - DN; return h * DQK + DN + (j >> 1) + 32 * (j & 1);
}
template <bool F8 = false>
__device__ __forceinline__ void p0_transpose_item(const float* W, int K, int N, bf16* WT, int ndst, int mode, const float* kscale, LAS float* scr, int item, int lane) {
    const int nblk = ndst / 32, kb = item / nblk, nb = item % nblk, k0 = 64 * kb, n0 = 32 * nb;
    const int src = colmap(mode, n0 + (lane & 31));
    const int s0 = colmap(mode, n0), s31 = colmap(mode, n0 + 31);
    if (s0 >= 0 && s31 == s0 + 31 && (s0 & 3) == 0) {
        const int kr = lane >> 3, n4 = lane & 7; f32x4 v[8];
#pragma unroll
        for (int i = 0; i < 8; ++i) v[i] = *(const f32x4*)(W + (size_t)(k0 + 8 * i + kr) * N + s0 + 4 * n4);
#pragma unroll
        for (int i = 0; i < 8; ++i) { const float ks = kscale ? kscale[k0 + 8 * i + kr] : 1.f; LAS float* d = scr + (8 * i + kr) * 33 + 4 * n4;
            d[0] = v[i][0] * ks; d[1] = v[i][1] * ks; d[2] = v[i][2] * ks; d[3] = v[i][3] * ks; }
    } else {
#pragma unroll 8
    for (int i = 0; i < 32; ++i) { const int kk = 2 * i + (lane >> 5); float v = 0.f;
        if (src >= 0) { v = W[(size_t)(k0 + kk) * N + src]; if (kscale) v *= kscale[k0 + kk]; }
        scr[kk * 33 + (lane & 31)] = v; }
    }
    LDS_WAIT(); asm volatile("" ::: "memory");
    const int c = lane & 7;
#pragma unroll
    for (int j = 0; j < 4; ++j) { const int n = (lane >> 3) + 8 * j; const LAS float* s = scr + (8 * c) * 33 + n;
        if constexpr (F8) { float t[8];
#pragma unroll
            for (int e = 0; e < 8; ++e) t[e] = fminf(fmaxf(s[e * 33] * WIN8_SCALE, -448.f), 448.f);
            int w0 = 0, w1 = 0; w0 = __builtin_amdgcn_cvt_pk_fp8_f32(t[0], t[1], w0, false); w0 = __builtin_amdgcn_cvt_pk_fp8_f32(t[2], t[3], w0, true); w1 = __builtin_amdgcn_cvt_pk_fp8_f32(t[4], t[5], w1, false); w1 = __builtin_amdgcn_cvt_pk_fp8_f32(t[6], t[7], w1, true);
            v2u o; o.x = (unsigned)w0; o.y = (unsigned)w1; *(v2u*)((unsigned char*)WT + (size_t)(n0 + n) * K + k0 + 8 * c) = o; continue; }
        v4u o; o.x = cvt_pk_bf16(s[0 * 33], s[1 * 33]); o.y = cvt_pk_bf16(s[2 * 33], s[3 * 33]); o.z = cvt_pk_bf16(s[4 * 33], s[5 * 33]); o.w = cvt_pk_bf16(s[6 * 33], s[7 * 33]);
        *(v4u*)(WT + (size_t)(n0 + n) * K + k0 + 8 * c) = o; }
    LDS_WAIT(); asm volatile("" ::: "memory");
}

__device__ __forceinline__ void sgu_unit(const Frame& F, int unit, const bf16* VG, bf16* U, const bf16* WSP, const float* lng, const float* lnb, const float* bsp, const u64* ssum, const u64* ssq) {
    const int chunk = unit >> 3, g = unit & 7, row0 = chunk * 128, c0 = g * 256;
    const int tid = F.tid, lane = F.lane, w = F.wave, fr = lane & 15, fq = lane >> 4;
    LAS unsigned* vt = (LAS unsigned*)F.lds;
    LAS float* st = (LAS float*)(F.lds + 256 * 272);
    if (tid < 128) { const float mean = fx_get(ssum + row0 + tid) * (1.f / D_MODEL), ex2 = fx_get(ssq + row0 + tid) * (1.f / D_MODEL);
        const float var = fmaxf(ex2 - mean * mean, 0.f); st[2 * tid] = mean; st[2 * tid + 1] = __builtin_amdgcn_rsqf(var + EPS); }
    __syncthreads();
#pragma unroll 1
    for (int q = 0; q < 4; ++q) {
        const int wi = w + 8 * q, c8 = lane & 7, rlo = lane >> 3, s2 = 8 * (wi & 7) + rlo, cg = 8 * (wi >> 3) + c8;
        const bf16* p = VG + (size_t)(row0 + 2 * s2) * D_MODEL + c0 + 8 * cg;
        const v4u a = *(const v4u*)p, b = *(const v4u*)(p + D_MODEL);
        const f32x4 g0 = *(const f32x4*)(lng + c0 + 8 * cg), g1 = *(const f32x4*)(lng + c0 + 8 * cg + 4), b0 = *(const f32x4*)(lnb + c0 + 8 * cg), b1 = *(const f32x4*)(lnb + c0 + 8 * cg + 4);
        const float m0 = st[4 * s2], r0 = st[4 * s2 + 1], m1 = st[4 * s2 + 2], r1 = st[4 * s2 + 3];
        const unsigned aw[4] = {a.x, a.y, a.z, a.w}, bw[4] = {b.x, b.y, b.z, b.w};
        const int pd = s2 ^ (c8 << 3);
#pragma unroll
        for (int j = 0; j < 8; ++j) { const float ga = j < 4 ? g0[j & 3] : g1[j & 3], be = j < 4 ? b0[j & 3] : b1[j & 3];
            const float x0 = (j & 1) ? bf_hi(aw[j >> 1]) : bf_lo(aw[j >> 1]), x1 = (j & 1) ? bf_hi(bw[j >> 1]) : bf_lo(bw[j >> 1]);
            vt[(8 * cg + j) * 68 + pd] = cvt_pk_bf16((x0 - m0) * r0 * ga + be, (x1 - m1) * r1 * ga + be); }
    }
    __syncthreads();
    f32x4 acc[2][8];
#pragma unroll
    for (int rt = 0; rt < 2; ++rt)
#pragma unroll
        for (int tt = 0; tt < 8; ++tt) acc[rt][tt] = (f32x4){0.f, 0.f, 0.f, 0.f};
    const bf16* wg = WSP + (size_t)g * 128 * 128;
#pragma unroll
    for (int kk = 0; kk < 4; ++kk) {
        bf16x8 af[2];
#pragma unroll
        for (int rt = 0; rt < 2; ++rt) { const int ch = 32 * w + 16 * rt + fr; const int d = 16 * kk + 4 * fq, pd = d ^ (((ch >> 3) & 7) << 3);
            af[rt] = *(const LAS bf16x8*)((const LAS unsigned char*)vt + ch * 272 + pd * 4); }
#pragma unroll
        for (int tt = 0; tt < 8; ++tt) { if (tt >= 2 * kk) {
            const bf16x8 bfr = *(const bf16x8*)(wg + (size_t)(16 * tt + fr) * 128 + 32 * kk + 8 * fq);
#pragma unroll
            for (int rt = 0; rt < 2; ++rt) acc[rt][tt] = __builtin_amdgcn_mfma_f32_16x16x32_bf16(af[rt], bfr, acc[rt][tt], 0, 0, 0); } }
    }
#pragma unroll
    for (int tt = 0; tt < 8; ++tt) { const int t = 16 * tt + fr; const float bs = bsp[g * 128 + t];
#pragma unroll
        for (int rt = 0; rt < 2; ++rt) { const size_t off = (size_t)(row0 + t) * D_MODEL + c0 + 32 * w + 16 * rt + 4 * fq;
            const v2u uu = *(const v2u*)(U + off);
            const f32x4 a = acc[rt][tt];
            v2u o; o.x = cvt_pk_bf16(bf_lo(uu.x) * (a[0] + bs), bf_hi(uu.x) * (a[1] + bs));
            o.y = cvt_pk_bf16(bf_lo(uu.y) * (a[2] + bs), bf_hi(uu.y) * (a[3] + bs));
            *(v2u*)(U + off) = o; } }
    __syncthreads();
}

namespace att {
constexpr int KT = 64 * 192, VT = 128 * 64;
constexpr int L_K = 0, L_V = 4 * KT, L_WS = 4 * KT + 4 * VT;
#define KSWZ(row, ch) ((row) * 192 + ((((ch) ^ (((row) >> 2) & 3))) << 4))
__device__ __forceinline__ int v_st(int k, int c) { const int kk = (k & ~0xC) | ((k & 4) << 1) | ((k & 8) >> 1); return ((kk >> 3) * 4 + (c >> 5)) * 512 + ((kk & 7) * 32 + (c & 31)) * 2; }
__device__ __forceinline__ int v_rd_base(int lane) { return ((lane & 3) << 3) | (((lane >> 2) & 3) << 6) | (((lane >> 4) & 1) << 5) | (((lane >> 5) & 1) << 8); }
constexpr int v_rd_off(int d0, int ks, int half) { return d0 * 512 + ks * 4096 + half * 2048; }
__device__ __forceinline__ int crow(int r, int hi) { return (r & 3) + 8 * (r >> 2) + 4 * hi; }
__device__ __forceinline__ void mask_tile(f32x16& p0, f32x16& p1, int dq) {
    const float NEG = -__builtin_inff();
#pragma unroll
    for (int r = 0; r < 16; ++r) { const int c = (r & 3) + 8 * (r >> 2); if (dq - c < 0) p0[r] = NEG; if (dq - c - 32 < 0) p1[r] = NEG; }
}
constexpr float THR = 8.f;
__device__ __forceinline__ void softmax_tile(f32x16& p0, f32x16& p1, float& m_reg, float& alpha, v8i& pk, bool first) {
    float pmax;
    { float a4[4];
#pragma unroll
      for (int c = 0; c < 4; ++c) { a4[c] = fmaxf(fmaxf(p0[4 * c], p0[4 * c + 1]), p0[4 * c + 2]); a4[c] = fmaxf(fmaxf(a4[c], p0[4 * c + 3]), p1[4 * c]);
          a4[c] = fmaxf(fmaxf(a4[c], p1[4 * c + 1]), p1[4 * c + 2]); a4[c] = fmaxf(a4[c], p1[4 * c + 3]); }
      pmax = fmaxf(fmaxf(a4[0], a4[1]), fmaxf(a4[2], a4[3])); }
    { auto rr = __builtin_amdgcn_permlane32_swap(__float_as_uint(pmax), __float_as_uint(pmax), false, false); pmax = fmaxf(__uint_as_float(rr[0]), __uint_as_float(rr[1])); }
    if (__builtin_expect(__all(pmax - m_reg <= THR) && !first, 1)) { alpha = 1.f; }
    else { float delta = first ? pmax - m_reg : fmaxf(pmax - m_reg, 0.f); if (!(delta > -1e30f)) delta = 0.f;
        alpha = first ? 1.f : __builtin_amdgcn_exp2f(-delta); m_reg += delta; }
#pragma unroll
    for (int r = 0; r < 16; ++r) { p0[r] = __builtin_amdgcn_exp2f(p0[r] - m_reg); p1[r] = __builtin_amdgcn_exp2f(p1[r] - m_reg); }
#pragma unroll
    for (int w = 0; w < 4; ++w) { int d0 = 0, d1 = 0; d0 = __builtin_amdgcn_cvt_pk_fp8_f32(p0[4 * w], p0[4 * w + 1], d0, false); d0 = __builtin_amdgcn_cvt_pk_fp8_f32(p0[4 * w + 2], p0[4 * w + 3], d0, true);
        d1 = __builtin_amdgcn_cvt_pk_fp8_f32(p1[4 * w], p1[4 * w + 1], d1, false); d1 = __builtin_amdgcn_cvt_pk_fp8_f32(p1[4 * w + 2], p1[4 * w + 3], d1, true); pk[w] = d0; pk[4 + w] = d1; }
}
template <int KB>
__device__ __forceinline__ void qkt(f32x16& p0, f32x16& p1, const char* K_lds, int r32, int hi, const v8i* qr) {
    p0 = f32x16{}; p1 = f32x16{};
    const char* k0 = K_lds + KB * KT + KSWZ(r32, 2 * hi); const char* k1 = K_lds + KB * KT + KSWZ(r32, 2 * hi + 1);
#pragma unroll
    for (int ks = 0; ks < 3; ++ks) {
        const v4u a0 = *reinterpret_cast<const v4u*>(k0 + ks * 64), a1 = *reinterpret_cast<const v4u*>(k1 + ks * 64);
        const v4u b0 = *reinterpret_cast<const v4u*>(k0 + ks * 64 + 32 * 192), b1 = *reinterpret_cast<const v4u*>(k1 + ks * 64 + 32 * 192);
        const v8i ka = {(int)a0.x, (int)a0.y, (int)a0.z, (int)a0.w, (int)a1.x, (int)a1.y, (int)a1.z, (int)a1.w};
        const v8i kb = {(int)b0.x, (int)b0.y, (int)b0.z, (int)b0.w, (int)b1.x, (int)b1.y, (int)b1.z, (int)b1.w};
        p0 = __builtin_amdgcn_mfma_scale_f32_32x32x64_f8f6f4(ka, qr[ks], p0, 0, 0, 0, 0x7c7c7c7c, 0, 0x79797979);
        p1 = __builtin_amdgcn_mfma_scale_f32_32x32x64_f8f6f4(kb, qr[ks], p1, 0, 0, 0, 0x7c7c7c7c, 0, 0x79797979); }
}
template <int VB>
__device__ __forceinline__ void pv_tile(f32x16* o, f32x16& lacc, const char* V_lds, int r32, int hi, v8i pk) {
    const int sw = (r32 >> 2) & 3;
    const char* v0 = V_lds + VB * VT + r32 * 64 + (((2 * hi) ^ sw) << 4); const char* v1 = V_lds + VB * VT + r32 * 64 + (((2 * hi + 1) ^ sw) << 4);
#pragma unroll
    for (int d0 = 0; d0 < 4; ++d0) { const v4u a = *reinterpret_cast<const v4u*>(v0 + d0 * 2048), b = *reinterpret_cast<const v4u*>(v1 + d0 * 2048);
        const v8i vb = {(int)a.x, (int)a.y, (int)a.z, (int)a.w, (int)b.x, (int)b.y, (int)b.z, (int)b.w};
        o[d0] = __builtin_amdgcn_mfma_scale_f32_32x32x64_f8f6f4(pk, vb, o[d0], 0, 0, 0, 0x7f7f7f7f, 0, 0x7c7c7c7c); if (d0 == 1) SBAR(); }
    { int c1 = 0x38383838; asm volatile("" : "+v"(c1)); const v8i ones = {c1, c1, c1, c1, c1, c1, c1, c1};
      lacc = __builtin_amdgcn_mfma_scale_f32_32x32x64_f8f6f4(pk, ones, lacc, 0, 0, 0, 0x7f7f7f7f, 0, 0x7f7f7f7f); }
}
__device__ __forceinline__ void attn_unit(int bh, int qb, const unsigned char* Q, const unsigned char* K, const unsigned char* KRp, const unsigned char* V, const bf16* GA, bf16* MG, char* lds, LAS unsigned char* lds3, const int wave0) {
    int tid = wave0 * 64 + lane_id(); asm volatile("" : "+v"(tid));
    const int wid = __builtin_amdgcn_readfirstlane(tid >> 6), lane = tid & 63, r32 = lane & 31, hi = lane >> 5;
    const int q0 = qb * 256, qlo = q0 + wid * 32, qm = qlo + r32 - 4 * hi;
    const unsigned char* Qw = Q + ((size_t)bh * SEQL + qlo + r32) * DQK;
    const unsigned char* Kh = K + (size_t)bh * SEQL * DN; const unsigned char* KRh = KRp + (size_t)(bh >> 4) * SEQL * DR; const unsigned char* Vh = V + (size_t)bh * SEQL * DVH;
    char* V_lds = lds + L_V; char* K_lds = lds + L_K;
    float* ws = (float*)(lds + L_WS) + wid * 64; float* li_l = ws, * al_l = ws + 32;
    v8i qr[3];
#pragma unroll
    for (int ks = 0; ks < 3; ++ks) { const v4u a = *reinterpret_cast<const v4u*>(Qw + ks * 64 + hi * 32), b = *reinterpret_cast<const v4u*>(Qw + ks * 64 + hi * 32 + 16);
        qr[ks] = (v8i){(int)a.x, (int)a.y, (int)a.z, (int)a.w, (int)b.x, (int)b.y, (int)b.z, (int)b.w}; }
    const int NT = 4 * (qb + 1);
    unsigned ksp[2], kst[2], vso;
#pragma unroll
    for (int i = 0; i < 2; ++i) { const int o = i * 8192 + tid * 16, row = (o / 192) & 63, pos = (o - (o / 192) * 192) >> 4, ch = pos ^ ((row >> 2) & 3);
        if (ch < 8) { ksp[i] = (unsigned)(Kh - Vh) + (unsigned)(row * DN + ch * 16); kst[i] = 64 * DN; } else { ksp[i] = (unsigned)(KRh - Vh) + (unsigned)(row * DR + (ch - 8) * 16); kst[i] = 64 * DR; } }
    { const int j = tid >> 2, c = (tid & 3) ^ ((j >> 2) & 3); vso = (unsigned)(j * SEQL + c * 16); }
    float m_reg = 0.f; f32x16 lacc = {}; f32x16 o[4] = {};
    const unsigned ldw = (unsigned)wid * 1024u;
#define SOFF(x) ({ unsigned o_ = (x); asm volatile("" : "+v"(o_)); (const unsigned*)((const char*)Vh + o_); })
#define SDMA(t, bf) do { \
        __builtin_amdgcn_global_load_lds(SOFF(ksp[0] + (unsigned)(t) * kst[0]), (LAS unsigned*)(lds3 + L_K + (bf) * KT + ldw), 16, 0, 0); \
        if (wid < 4) __builtin_amdgcn_global_load_lds(SOFF(ksp[1] + (unsigned)(t) * kst[1]), (LAS unsigned*)(lds3 + L_K + (bf) * KT + 8192 + ldw), 16, 0, 0); \
        __builtin_amdgcn_global_load_lds(SOFF(vso + (unsigned)(t) * 64u), (LAS unsigned*)(lds3 + L_V + (bf) * VT + ldw), 16, 0, 0); } while (0)
#define TILE(t, BF) do { f32x16 p0, p1; float alpha; v8i pk; \
        __builtin_amdgcn_s_setprio(1); qkt<BF>(p0, p1, K_lds, r32, hi, qr); __builtin_amdgcn_s_setprio(0); \
        { const int kb_ = (t) * 64; if (kb_ + 63 > qlo) mask_tile(p0, p1, qm - kb_); } \
        softmax_tile(p0, p1, m_reg, alpha, pk, (t) == 0); \
        if (__any(alpha < 1.f)) { if (hi == 0) al_l[r32] = alpha; asm volatile("s_waitcnt lgkmcnt(0)" ::: "memory"); \
            _Pragma("unroll") for (int r = 0; r < 16; ++r) { const float a_ = al_l[crow(r, hi)]; lacc[r] *= a_; _Pragma("unroll") for (int d_ = 0; d_ < 4; ++d_) o[d_][r] *= a_; } } \
        __builtin_amdgcn_s_setprio(1); pv_tile<BF>(o, lacc, V_lds, r32, hi, pk); __builtin_amdgcn_s_setprio(0); SBAR(); } while (0)
    SDMA(0, 0); SDMA(1, 1); VM_WAIT(); __syncthreads();
    for (int t = 0; t < NT; t += 4) {
        SDMA(t + 2, 2); SDMA(t + 3, 3); SBAR();
        TILE(t, 0); TILE(t + 1, 1);
        VM_WAIT(); __syncthreads();
        if (t + 4 < NT) { SDMA(t + 4, 0); SDMA(t + 5, 1); } SBAR();
        TILE(t + 2, 2); TILE(t + 3, 3);
        VM_WAIT(); __syncthreads(); }
#undef TILE
#undef SDMA
#undef SOFF
    float* stg = (float*)lds + wid * 4096;
    float rli[16];
#pragma unroll
    for (int r = 0; r < 16; ++r) rli[r] = __builtin_amdgcn_rcpf(lacc[r]);
    const int le = lane_id(), r32e = le & 31, hie = le >> 5;
#pragma unroll
    for (int r = 0; r < 16; ++r) { const int orow = crow(r, hie);
#pragma unroll
        for (int d0 = 0; d0 < 4; ++d0) stg[orow * 128 + d0 * 32 + r32e] = o[d0][r] * rli[r]; }
    asm volatile("s_waitcnt lgkmcnt(0)" ::: "memory");
    const int b = bh >> 4, h = bh & 15;
#pragma unroll 4
    for (int it = 0; it < 16; ++it) { const int row = 2 * it + hie, c4 = r32e * 4;
        const f32x4 ov = *(const f32x4*)(stg + row * 128 + c4);
        const size_t off = ((size_t)b * SEQL + qlo + row) * D_MODEL + h * DVH + c4;
        const v2u ga = *(const v2u*)(GA + off), ob = *(const v2u*)(MG + off);
        v2u w; w.x = cvt_pk_bf16(bf_lo(ga.x) * ov[0] + bf_lo(ob.x), bf_hi(ga.x) * ov[1] + bf_hi(ob.x)); w.y = cvt_pk_bf16(bf_lo(ga.y) * ov[2] + bf_lo(ob.y), bf_hi(ga.y) * ov[3] + bf_hi(ob.y));
        *(v2u*)(MG + off) = w; }
    __syncthreads();
}
#undef KSWZ
}

__device__ __forceinline__ void ce_desc(float& a, float& b) { const float hi = fmaxf(a, b), lo = fminf(a, b); a = hi; b = lo; }
template <int N> __device__ __forceinline__ void bitonic_sort_desc(float (&v)[N]) {
#pragma unroll
    for (int k = 2; k <= N; k <<= 1)
#pragma unroll
        for (int j = k >> 1; j > 0; j >>= 1)
#pragma unroll
            for (int i = 0; i < N; ++i) { const int l = i ^ j; if (l > i) { if ((i & k) == 0) ce_desc(v[i], v[l]); else ce_desc(v[l], v[i]); } }
}
template <int N> __device__ __forceinline__ void bitonic_merge_desc(float (&v)[N]) {
#pragma unroll
    for (int j = N >> 1; j > 0; j >>= 1)
#pragma unroll
        for (int i = 0; i < N; ++i) { const int l = i ^ j; if (l > i) ce_desc(v[i], v[l]); }
}
__device__ __forceinline__ void merge_top16(float (&a)[16], const float (&b)[16]) {
#pragma unroll
    for (int i = 0; i < 16; ++i) a[i] = fmaxf(a[i], b[15 - i]);
    bitonic_merge_desc<16>(a);
}
__device__ __forceinline__ void topk_unit(const Frame& F, int tg, int h, const bf16* QP, int* TOPI, float* TOPG) {
    const int lane = F.lane, fr = lane & 15, fq = lane >> 4;
    const int t0 = tg * 16;
    LAS float* sl = (LAS float*)(F.lds + 65536) + F.wave * 512;
    float s01[2][16];
#pragma unroll
    for (int p = 0; p < 2; ++p) {
        f32x4 acc[8];
#pragma unroll
        for (int mt = 0; mt < 8; ++mt) acc[mt] = (f32x4){0.f, 0.f, 0.f, 0.f};
        const bf16* qp = QP + (size_t)(t0 + fr) * D_MODEL + h * 256 + p * 128 + 8 * fq;
        const LAS unsigned char* kp = F.lds + p * 32768 + fr * 256;
#pragma unroll
        for (int kk = 0; kk < 4; ++kk) { const bf16x8 bq = *(const bf16x8*)(qp + 32 * kk);
#pragma unroll
            for (int mt = 0; mt < 8; ++mt) { const bf16x8 ak = *(const LAS bf16x8*)(kp + mt * 4096 + (((4 * kk + fq) ^ fr) << 4));
                acc[mt] = __builtin_amdgcn_mfma_f32_16x16x32_bf16(ak, bq, acc[mt], 0, 0, 0); } }
        float a[16], b[16];
#pragma unroll
        for (int mt = 0; mt < 8; ++mt)
#pragma unroll
            for (int e = 0; e < 4; ++e) { const unsigned n = (unsigned)(16 * mt + 4 * fq + e); const float pk = __uint_as_float((__float_as_uint(acc[mt][e]) & ~0x7Fu) | n);
                if (mt < 4) a[mt * 4 + e] = pk; else b[(mt - 4) * 4 + e] = pk; }
        bitonic_sort_desc<16>(a); bitonic_sort_desc<16>(b); merge_top16(a, b);
#pragma unroll
        for (int i = 0; i < 16; ++i) b[i] = shx(a[i], 16, F.lane);
        merge_top16(a, b);
#pragma unroll
        for (int i = 0; i < 16; ++i) b[i] = shx(a[i], 32, F.lane);
        merge_top16(a, b);
#pragma unroll
        for (int i = 0; i < 16; ++i) s01[p][i] = a[i];
    }
    if (fq == 0) {
#pragma unroll
        for (int p = 0; p < 2; ++p)
#pragma unroll
            for (int i = 0; i < 16; ++i) sl[fr * 32 + p * 16 + i] = s01[p][i];
    }
    float c[4][16];
#pragma unroll
    for (int gidx = 0; gidx < 4; ++gidx)
#pragma unroll
        for (int i = 0; i < 16; ++i) c[gidx][i] = -3.0e38f;
#define CAND(n, i, j) do { const float v_ = __uint_as_float(__float_as_uint(s01[0][i]) & ~0x7Fu) + __uint_as_float(__float_as_uint(s01[1][j]) & ~0x7Fu); \
        c[(n) >> 4][(n) & 15] = __uint_as_float((__float_as_uint(v_) & ~0xFFu) | (unsigned)((i) * 16 + (j))); } while (0)
    CAND(0, 0, 0); CAND(1, 0, 1); CAND(2, 0, 2); CAND(3, 0, 3); CAND(4, 0, 4); CAND(5, 0, 5); CAND(6, 0, 6); CAND(7, 0, 7);
    CAND(8, 0, 8); CAND(9, 0, 9); CAND(10, 0, 10); CAND(11, 0, 11); CAND(12, 0, 12); CAND(13, 0, 13); CAND(14, 0, 14); CAND(15, 0, 15);
    CAND(16, 1, 0); CAND(17, 1, 1); CAND(18, 1, 2); CAND(19, 1, 3); CAND(20, 1, 4); CAND(21, 1, 5); CAND(22, 1, 6); CAND(23, 1, 7);
    CAND(24, 2, 0); CAND(25, 2, 1); CAND(26, 2, 2); CAND(27, 2, 3); CAND(28, 2, 4);
    CAND(29, 3, 0); CAND(30, 3, 1); CAND(31, 3, 2); CAND(32, 3, 3);
    CAND(33, 4, 0); CAND(34, 4, 1); CAND(35, 4, 2);
    CAND(36, 5, 0); CAND(37, 5, 1); CAND(38, 6, 0); CAND(39, 6, 1); CAND(40, 7, 0); CAND(41, 7, 1);
    CAND(42, 8, 0); CAND(43, 9, 0); CAND(44, 10, 0); CAND(45, 11, 0); CAND(46, 12, 0); CAND(47, 13, 0); CAND(48, 14, 0); CAND(49, 15, 0);
#undef CAND
    bitonic_sort_desc<16>(c[0]); bitonic_sort_desc<16>(c[1]); bitonic_sort_desc<16>(c[2]); bitonic_sort_desc<16>(c[3]);
    merge_top16(c[0], c[1]); merge_top16(c[2], c[3]); merge_top16(c[0], c[2]);
    LDS_WAIT(); asm volatile("" ::: "memory");
    float sc[16]; int ix[16]; float mx = -3.0e38f;
#pragma unroll
    for (int w = 0; w < 16; ++w) { const unsigned id = __float_as_uint(c[0][w]) & 0xFFu; const unsigned u0 = __float_as_uint(sl[fr * 32 + (id >> 4)]), u1 = __float_as_uint(sl[fr * 32 + 16 + (id & 15)]);
        sc[w] = __uint_as_float(u0 & ~0x7Fu) + __uint_as_float(u1 & ~0x7Fu); ix[w] = (int)((u0 & 0x7Fu) * NKEYS + (u1 & 0x7Fu)); mx = fmaxf(mx, sc[w]); }
    float sum = 0.f;
#pragma unroll
    for (int w = 0; w < 16; ++w) { sc[w] = __builtin_amdgcn_exp2f((sc[w] - mx) * 1.4426950409f); sum += sc[w]; }
    const float rs = __builtin_amdgcn_rcpf(sum);
    if (fq == 0) { int* ti = TOPI + (size_t)(t0 + fr) * 128 + h * 16; float* tgp = TOPG + (size_t)(t0 + fr) * 128 + h * 16;
#pragma unroll
        for (int w = 0; w < 16; ++w) { ti[w] = ix[w]; tgp[w] = sc[w] * rs; } }
    LDS_WAIT(); asm volatile("" ::: "memory");
}

typedef float f32x2 __attribute__((ext_vector_type(2)));
struct PeerIdx { int i0, i1; float a0, a1; };
struct PeerRow { v4u x; float xs; };
__device__ __forceinline__ void pu_gather(int t, int sl, int lane, const PeerIdx& I, v4u (&wu)[16], PeerRow& R, const unsigned char* XQ, const float* XS, const unsigned char* PU8) {
    const int r = lane & 7, g = lane >> 3;
    const unsigned char* sb = PU8 + (size_t)sl * NEXP * 128;
#pragma unroll
    for (int k = 0; k < 16; ++k) { const int e = __shfl(k < 8 ? I.i0 : I.i1, (8 * k + g) & 63); unsigned o_ = (unsigned)(e * 128 + 16 * r); asm volatile("" : "+v"(o_)); wu[k] = *(const v4u*)(sb + o_); }
    R.x = __builtin_nontemporal_load((const v4u*)(XQ + (size_t)t * D_MODEL + 128 * sl + 16 * r)); R.xs = XS[(size_t)t * 16 + sl];
}
__device__ __forceinline__ void pu_compute(int t, int sl, int lane, const v4u (&wu)[16], const PeerRow& R, float* PART) {
    const int r = lane & 7, g = lane >> 3;
    float d[16];
#pragma unroll
    for (int k = 0; k < 16; ++k) { int a_ = __builtin_amdgcn_sdot4((int)wu[k].x, (int)R.x.x, 0, false); a_ = __builtin_amdgcn_sdot4((int)wu[k].y, (int)R.x.y, a_, false);
        a_ = __builtin_amdgcn_sdot4((int)wu[k].z, (int)R.x.z, a_, false); a_ = __builtin_amdgcn_sdot4((int)wu[k].w, (int)R.x.w, a_, false); d[k] = (float)a_; }
    const bool b0 = lane & 1, b1 = lane & 2, b2 = lane & 4;
    float res[2];
#pragma unroll
    for (int hf = 0; hf < 2; ++hf) { float e1[4], f1[2];
#pragma unroll
        for (int m = 0; m < 4; ++m) e1[m] = (b0 ? d[8 * hf + 2 * m + 1] : d[8 * hf + 2 * m]) + shx(b0 ? d[8 * hf + 2 * m] : d[8 * hf + 2 * m + 1], 1, lane);
#pragma unroll
        for (int n = 0; n < 2; ++n) f1[n] = (b1 ? e1[2 * n + 1] : e1[2 * n]) + shx(b1 ? e1[2 * n] : e1[2 * n + 1], 2, lane);
        res[hf] = (b2 ? f1[1] : f1[0]) + shx(b2 ? f1[0] : f1[1], 4, lane); }
    float* po = PART + ((size_t)t * 16 + sl) * 128 + 8 * r + g;
    __builtin_nontemporal_store(res[0] * R.xs, po); __builtin_nontemporal_store(res[1] * R.xs, po + 64);
}
__device__ __forceinline__ void peer_fin_token(int t, int lane, const float* PART, const int* TOPI, float* TOPG, const float* USC, const float* VSC, const u64* sqx) {
    const float r2 = __builtin_amdgcn_rsqf(fx_get(sqx + t) * (1.f / D_MODEL) + EPS);
    float s0 = 0.f, s1 = 0.f;
#pragma unroll
    for (int sl = 0; sl < 16; ++sl) { s0 += __builtin_nontemporal_load(PART + ((size_t)t * 16 + sl) * 128 + lane); s1 += __builtin_nontemporal_load(PART + ((size_t)t * 16 + sl) * 128 + 64 + lane); }
    const int e0 = TOPI[(size_t)t * 128 + lane], e1 = TOPI[(size_t)t * 128 + 64 + lane];
    float* gp = TOPG + (size_t)t * 128;
    gp[lane] = gelu_t(s0 * USC[e0] * r2) * gp[lane] * VSC[e0]; gp[64 + lane] = gelu_t(s1 * USC[e1] * r2) * gp[64 + lane] * VSC[e1];
}
__device__ __forceinline__ void pv_gather(int t, int sl, int lane, const PeerIdx& I, v4u (&wv)[16], float (&xv)[2], const bf16* X, const unsigned char* PV8) {
    const int r = lane & 7, g = lane >> 3;
    const unsigned char* sb = PV8 + (size_t)sl * NEXP * 128;
#pragma unroll
    for (int k = 0; k < 16; ++k) { const int e = __shfl(k < 8 ? I.i0 : I.i1, (8 * k + g) & 63); unsigned o_ = (unsigned)(e * 128 + 16 * r); asm volatile("" : "+v"(o_)); wv[k] = *(const v4u*)(sb + o_); }
    const int cb = 16 * r + ((lane & 8) ? 8 : 0) + ((lane & 16) ? 4 : 0) + ((lane & 32) ? 2 : 0);
    const unsigned xw = *(const unsigned*)(X + (size_t)t * D_MODEL + 128 * sl + cb); xv[0] = bf_lo(xw); xv[1] = bf_hi(xw);
}
__device__ __forceinline__ void pv_compute(int t, int sl, int lane, const PeerIdx& I, const v4u (&wv)[16], const float (&xv)[2], bf16* X, u64* ssq2) {
    const int r = lane & 7, g = lane >> 3;
    float oa[16];
    { f32x2 o2[8]; float ak[16];
#pragma unroll
      for (int e = 0; e < 8; ++e) o2[e] = (f32x2){0.f, 0.f};
#pragma unroll
      for (int k = 0; k < 16; ++k) ak[k] = __shfl(k < 8 ? I.a0 : I.a1, (8 * k + g) & 63);
#pragma unroll
      for (int k = 0; k < 16; ++k) { const f32x2 a2 = {ak[k], ak[k]};
#pragma unroll
          for (int q = 0; q < 4; ++q) { const int w_ = (int)(q == 0 ? wv[k].x : q == 1 ? wv[k].y : q == 2 ? wv[k].z : wv[k].w);
              o2[2 * q] += __builtin_amdgcn_cvt_pk_f32_fp8(w_, false) * a2; o2[2 * q + 1] += __builtin_amdgcn_cvt_pk_f32_fp8(w_, true) * a2; } }
#pragma unroll
      for (int e = 0; e < 8; ++e) { oa[2 * e] = o2[e][0]; oa[2 * e + 1] = o2[e][1]; } }
    const bool c0 = lane & 8, c1 = lane & 16, c2 = lane & 32;
    float p1[8], p2[4], p3[2];
#pragma unroll
    for (int m = 0; m < 8; ++m) p1[m] = (c0 ? oa[m + 8] : oa[m]) + shx(c0 ? oa[m] : oa[m + 8], 8, lane);
#pragma unroll
    for (int n = 0; n < 4; ++n) p2[n] = (c1 ? p1[n + 4] : p1[n]) + shx(c1 ? p1[n] : p1[n + 4], 16, lane);
#pragma unroll
    for (int q = 0; q < 2; ++q) p3[q] = (c2 ? p2[q + 2] : p2[q]) + shx(c2 ? p2[q] : p2[q + 2], 32, lane);
    const int cb = 16 * r + (c0 ? 8 : 0) + (c1 ? 4 : 0) + (c2 ? 2 : 0);
    const float y0 = xv[0] + p3[0], y1 = xv[1] + p3[1];
    *(unsigned*)(X + (size_t)t * D_MODEL + 128 * sl + cb) = cvt_pk_bf16(y0, y1);
    const float ss = wave_sum(y0 * y0 + y1 * y1, lane);
    if (lane == 0) fx_add(ssq2 + t, ss);
}
__device__ __forceinline__ void row8_load(f32x4 (&v)[8], const float* src, int lane) {
    const f32x4* xr = (const f32x4*)src + lane;
#pragma unroll
    for (int j = 0; j < 8; ++j) v[j] = __builtin_nontemporal_load(xr + 64 * j);
}
__device__ __forceinline__ unsigned pack_i8x4(f32x4 v) {
    int i[4];
#pragma unroll
    for (int e = 0; e < 4; ++e) i[e] = (int)__builtin_rintf(__builtin_amdgcn_fmed3f(v[e], -127.f, 127.f));
    const unsigned lo = __builtin_amdgcn_perm((unsigned)i[1], (unsigned)i[0], 0x0c0c0400u), hi = __builtin_amdgcn_perm((unsigned)i[3], (unsigned)i[2], 0x0c0c0400u);
    return __builtin_amdgcn_perm(hi, lo, 0x05040100u); }
template <bool I8>
__device__ __forceinline__ void row_to_fp8(f32x4 (&v)[8], unsigned char* tab, int e, float* inv_scale, int lane, const f32x4* colmul) {
    float am = 0.f;
#pragma unroll
    for (int j = 0; j < 8; ++j) { if (colmul) v[j] = v[j] * colmul[j];
        am = fmaxf(am, fmaxf(fmaxf(fabsf(v[j][0]), fabsf(v[j][1])), fmaxf(fabsf(v[j][2]), fabsf(v[j][3])))); }
#pragma unroll
    for (int o = 1; o < 64; o <<= 1) am = fmaxf(am, shx(am, o, lane));
    am = fmaxf(am, 1e-30f); const float sc = (I8 ? 127.f : 256.f) / am;
#pragma unroll
    for (int j = 0; j < 8; ++j) { int w = 0; if constexpr (I8) w = (int)pack_i8x4(v[j] * sc); else { w = __builtin_amdgcn_cvt_pk_fp8_f32(v[j][0] * sc, v[j][1] * sc, w, false); w = __builtin_amdgcn_cvt_pk_fp8_f32(v[j][2] * sc, v[j][3] * sc, w, true); } const int dw = lane + 64 * j; unsigned o_ = (unsigned)(dw >> 5) * (unsigned)(NEXP * 128) + (unsigned)(dw & 31) * 4u; asm volatile("" : "+v"(o_)); *(unsigned*)(tab + (size_t)e * 128 + o_) = (unsigned)w; }
    if (lane == 0) *inv_scale = am * (I8 ? 1.f / 127.f : 1.f / 256.f);
}

__global__ void __launch_bounds__(512, 2) mk_fwd(Args args) {
    extern __shared__ __attribute__((aligned(16))) unsigned char lds[];
    Frame F;
    F.lds = (LAS unsigned char*)lds;
    F.wave = __builtin_amdgcn_readfirstlane((int)threadIdx.x >> 6); F.lane = lane_id(); F.tid = F.wave * 64 + F.lane;
    F.G = gridDim.x; { const int bx = blockIdx.x; F.vcu = (F.G % 8 == 0) ? (bx % 8) * (F.G / 8) + bx / 8 : bx; }
    unsigned char* ws = args.ws;
    gu32* ctl = (gu32*)(ws + WS_CTL);
    volatile LAS unsigned* MISC = (volatile LAS unsigned*)(F.lds + MISC_OFF);
    for (int u = F.tid; u < (LDS_BYTES - LDSCTL_OFF) / 4; u += 512) ((LAS unsigned*)(F.lds + LDSCTL_OFF))[u] = 0u;
    __syncthreads();
    XcdBarrier bar; bar.bar = (unsigned*)(ctl + CW_BAR); bar.x = 0; bar.st = nullptr;
    bar = xcd_barrier_post((unsigned*)(ctl + CW_BAR), MISC + 8, F.wave);
#define GRID_BAR() xcd_barrier(bar)
#define PHASE_BEGIN() do { F.lane = lane_id(); asm volatile("" : "+v"(F.lane)); F.tid = F.wave * 64 + F.lane; } while (0)
    const float* x = args.in[0]; const int* positions = (const int*)args.in[1]; const float* g_norm1 = args.in[2]; const float* w_in = args.in[3];
    const float* g_q_a = args.in[4]; const float* w_uq = args.in[5]; const float* g_kv_a = args.in[6]; const float* w_ukv = args.in[7];
    const float* sgu_ln_g = args.in[8]; const float* sgu_ln_b = args.in[9]; const float* w_spatial = args.in[10]; const float* b_spatial = args.in[11];
    const float* b_gate = args.in[12]; const float* w_out = args.in[13]; const float* g_norm2 = args.in[14]; const float* w_peer_q = args.in[15];
    const float* peer_keys = args.in[16]; const float* peer_u = args.in[17]; const float* peer_v = args.in[18]; const float* g_final = args.in[19];
    float* out = args.out;
    bf16* KEYS = (bf16*)(ws + WS_KEYS); bf16* WSP = (bf16*)(ws + WS_WSP); bf16* WUQ = (bf16*)(ws + WS_WUQ); bf16* WUKV = (bf16*)(ws + WS_WUKV);
    bf16* WOUT = (bf16*)(ws + WS_WOUT); bf16* WPQ = (bf16*)(ws + WS_WPQ); float* ROPE = (float*)(ws + WS_ROPE);
    unsigned char* XN8 = ws + WS_XN8; unsigned char* WIN8 = ws + WS_WIN8; unsigned char* CQKV = ws + WS_CQKV; bf16* U = (bf16*)(ws + WS_U); bf16* VG = (bf16*)(ws + WS_VG);
    unsigned char* Vb = ws + WS_V; unsigned char* Kb = ws + WS_K; unsigned char* KR = ws + WS_KR; unsigned char* Qb = ws + WS_Q; bf16* GA = (bf16*)(ws + WS_GA); bf16* X2 = (bf16*)(ws + WS_X2);
    bf16* X1B = (bf16*)(ws + WS_X1B); unsigned char* PU = ws + WS_PU; unsigned char* PV = ws + WS_PV; float* USC = (float*)(ws + WS_PSC); float* VSC = USC + NEXP; float* PART = (float*)(ws + WS_PART); bf16* QP = (bf16*)(ws + WS_QP);
    int* TOPI = (int*)(ws + WS_TOPI); float* TOPG = (float*)(ws + WS_TOPG); unsigned char* X1Q = ws + WS_X1Q; float* XS = (float*)(ws + WS_XS);
    u64* SQQ = (u64*)(ws + CTL_STATS); u64* SQKV = SQQ + MTOK; u64* SSUM = SQKV + MTOK; u64* SSQ = SSUM + MTOK; u64* SQX1 = SSQ + MTOK;
    const int gw = F.vcu * 8 + F.wave, NGW = F.G * 8;

    {
        LAS float* scr = (LAS float*)(F.lds + RING_OFF + F.wave * 16384);
        constexpr int I_IN8 = (D_MODEL / 64) * (IN8_ROWS / 32), I_UQ = (QL / 64) * (NQ_COLS / 32), I_UKV = (QL / 64) * (NKV_COLS / 32), I_O = (D_MODEL / 64) * (D_MODEL / 32);
        constexpr int NITEMS = I_IN8 + I_UQ + I_UKV + 2 * I_O;
        for (int it = gw; it < NITEMS; it += NGW) {
            int r = it;
            if (r < I_IN8) { p0_transpose_item<true>(w_in, D_MODEL, IN_COLS, (bf16*)WIN8, IN8_ROWS, 3, nullptr, scr, r, F.lane); continue; } r -= I_IN8;
            if (r < I_UQ) { p0_transpose_item<true>(w_uq, QL, NQ_COLS, WUQ, NQ_COLS, 2, g_q_a, scr, r, F.lane); continue; } r -= I_UQ;
            if (r < I_UKV) { p0_transpose_item<true>(w_ukv, QL, NKV_COLS, WUKV, NKV_COLS, 0, g_kv_a, scr, r, F.lane); continue; } r -= I_UKV;
            if (r < I_O) { p0_transpose_item(w_out, D_MODEL, D_MODEL, WOUT, D_MODEL, 0, nullptr, scr, r, F.lane); continue; } r -= I_O;
            p0_transpose_item(w_peer_q, D_MODEL, D_MODEL, WPQ, D_MODEL, 0, g_norm2, scr, r, F.lane);
        }
        {
#define XN_LOAD(v, m_) do { const f32x4* xr_ = (const f32x4*)(x + (size_t)(m_) * D_MODEL) + F.lane; _Pragma("unroll") for (int j = 0; j < 8; ++j) v[j] = __builtin_nontemporal_load(xr_ + 64 * j); } while (0)
#define XN_DO(v, m_) do { float s_ = 0.f; _Pragma("unroll") for (int j = 0; j < 8; ++j) s_ += (v[j][0] * v[j][0] + v[j][1] * v[j][1]) + (v[j][2] * v[j][2] + v[j][3] * v[j][3]); \
            const float r_ = __builtin_amdgcn_rsqf(wave_sum(s_, F.lane) * (1.f / D_MODEL) + EPS); \
            _Pragma("unroll") for (int j = 0; j < 8; ++j) { const f32x4 h_ = v[j] * r_ * gn[j]; \
                const f32x4 h8_ = __builtin_elementwise_min(__builtin_elementwise_max(h_ * XN8_SCALE, (f32x4){-448.f, -448.f, -448.f, -448.f}), (f32x4){448.f, 448.f, 448.f, 448.f}); \
                int p_ = 0; p_ = __builtin_amdgcn_cvt_pk_fp8_f32(h8_[0], h8_[1], p_, false); p_ = __builtin_amdgcn_cvt_pk_fp8_f32(h8_[2], h8_[3], p_, true); ((unsigned*)(XN8 + (size_t)(m_) * D_MODEL))[F.lane + 64 * j] = (unsigned)p_; } } while (0)
            f32x4 gn[8];
#pragma unroll
            for (int j = 0; j < 8; ++j) gn[j] = *((const f32x4*)g_norm1 + F.lane + 64 * j);
            f32x4 va[8], vb[8]; int m = gw; if (m < MTOK) XN_LOAD(va, m);
#pragma unroll 1
            for (; m < MTOK; m += 2 * NGW) {
                if (m + NGW < MTOK) XN_LOAD(vb, m + NGW);
                XN_DO(va, m);
                if (m + NGW < MTOK) { if (m + 2 * NGW < MTOK) XN_LOAD(va, m + 2 * NGW); XN_DO(vb, m + NGW); } }
#undef XN_LOAD
#undef XN_DO
        }
        for (int it = gw; it < MTOK / 2; it += NGW) { const int row = 2 * it + (F.lane >> 5), i = F.lane & 31;
            const float freq = exp2f(-(float)i * (13.287712379549449f / 32.f)); const float ang = (float)positions[row] * freq;
            const double ad = (double)ang; const double k = __builtin_rint(ad * 0.15915494309189535); const float red = (float)(ad - k * 6.283185307179586);
            ROPE[(size_t)row * 32 + i] = __cosf(red); ROPE[(size_t)MTOK * 32 + (size_t)row * 32 + i] = __sinf(red); }
        for (int it = gw; it < (PHEADS * 2 * NKEYS * KD) / 512; it += NGW) { const size_t e = (size_t)it * 512 + 8 * F.lane; const f32x4 a = *(const f32x4*)(peer_keys + e), b = *(const f32x4*)(peer_keys + e + 4);
            v4u w; w.x = cvt_pk_bf16(a[0], a[1]); w.y = cvt_pk_bf16(a[2], a[3]); w.z = cvt_pk_bf16(b[0], b[1]); w.w = cvt_pk_bf16(b[2], b[3]); *(v4u*)(KEYS + e) = w; }
        for (int it = gw; it < (8 * 128 * 128) / 512; it += NGW) { const size_t e = (size_t)it * 512 + 8 * F.lane; const int t = (int)((e >> 7) & 127), s0 = (int)(e & 127);
            const f32x4 a = *(const f32x4*)(w_spatial + e), b = *(const f32x4*)(w_spatial + e + 4); float v[8] = {a[0], a[1], a[2], a[3], b[0], b[1], b[2], b[3]};
#pragma unroll
            for (int j = 0; j < 8; ++j) if (s0 + j > t) v[j] = 0.f;
            v4u w; w.x = cvt_pk_bf16(v[0], v[1]); w.y = cvt_pk_bf16(v[2], v[3]); w.z = cvt_pk_bf16(v[4], v[5]); w.w = cvt_pk_bf16(v[6], v[7]); *(v4u*)(WSP + e) = w; }
        for (size_t it = (size_t)gw * 64 + F.lane; it < (size_t)5 * MTOK; it += (size_t)NGW * 64) SQQ[it] = 0ull;
        GRID_BAR();
    }
    {
        PHASE_BEGIN();
        pg8::EpiIn E{0, IN8_DESCALE, U, GA, VG, CQKV, KR, b_gate, ROPE, SQQ, SQKV, SSUM, SSQ};
        { pg8::Gemm g{(const bf16*)XN8, (const bf16*)WIN8, MTOK, IN8_ROWS, D_MODEL / 2, D_MODEL / 2}; pg8::StaticOrder S; S.init(MTOK, IN8_ROWS, F.G, (int)blockIdx.x);
          pg8::gemm_phase<pg8::EpiIn, pg8::StaticOrder, true, true, true>(F.lds + RING_OFF, g, S, E, F.wave); }
        GRID_BAR();
    }
    {
        PHASE_BEGIN();
        { pg8::Gemm g{(const bf16*)CQKV, WUQ, MTOK, NQ_COLS, QL / 2, 512}; pg8::StaticOrder S; S.init(MTOK, NQ_COLS, F.G, (int)blockIdx.x);
          pg8::EpiQ E{Qb, SQQ, ROPE}; pg8::gemm_phase<pg8::EpiQ, pg8::StaticOrder, true, true, true>(F.lds + RING_OFF, g, S, E, F.wave); }
        { pg8::Gemm g{(const bf16*)(CQKV + QL), WUKV, MTOK, NKV_COLS, QL / 2, 512}; pg8::StaticOrder S; S.init(MTOK, NKV_COLS, F.G, (int)blockIdx.x);
          pg8::EpiKV E{Kb, Vb, SQKV}; pg8::gemm_phase<pg8::EpiKV, pg8::StaticOrder, true, true, true, true>(F.lds + RING_OFF, g, S, E, F.wave); }
        PHASE_BEGIN();
        for (int un = F.vcu; un < (MTOK / 128) * 8; un += F.G) sgu_unit(F, un, VG, U, WSP, sgu_ln_g, sgu_ln_b, b_spatial, SSUM, SSQ);
        GRID_BAR();
    }
    {
        PHASE_BEGIN();
        if (F.G == 256) { const int s = F.vcu & 7, bh = F.vcu >> 3;
#pragma unroll 1
            for (int i = 0; i < 4; ++i) { const int qb = (i == 0) ? s : (i == 1) ? 15 - s : (i == 2) ? 16 + s : 31 - s; att::attn_unit(bh, qb, Qb, Kb, KR, Vb, GA, U, (char*)lds + RING_OFF, F.lds + RING_OFF, F.wave); }
        } else {
#pragma unroll 1
            for (int un = F.vcu; un < 1024; un += F.G) att::attn_unit(un >> 5, 31 - (un & 31), Qb, Kb, KR, Vb, GA, U, (char*)lds + RING_OFF, F.lds + RING_OFF, F.wave);
        }
        GRID_BAR();
    }
    {
        PHASE_BEGIN();
        for (int it = gw * 64 + F.lane; it < MTOK; it += NGW * 64) SQQ[it] = 0ull;
        { f32x4 va[8], vb[8];
#define CONV_ROWS(SRC, TAB, SC, I8_, CM) do { int e = gw; if (e < NEXP) row8_load(va, SRC + (size_t)e * D_MODEL, F.lane); \
          _Pragma("unroll 1") for (; e < NEXP; e += 2 * NGW) { \
              if (e + NGW < NEXP) row8_load(vb, SRC + (size_t)(e + NGW) * D_MODEL, F.lane); \
              row_to_fp8<I8_>(va, TAB, e, SC + e, F.lane, CM); \
              if (e + NGW < NEXP) { if (e + 2 * NGW < NEXP) row8_load(va, SRC + (size_t)(e + 2 * NGW) * D_MODEL, F.lane); row_to_fp8<I8_>(vb, TAB, e + NGW, SC + e + NGW, F.lane, CM); } } } while (0)
          f32x4 gn2[8];
#pragma unroll
          for (int j = 0; j < 8; ++j) gn2[j] = *((const f32x4*)g_norm2 + F.lane + 64 * j);
          CONV_ROWS(peer_u, PU, USC, true, gn2);
          CONV_ROWS(peer_v, PV, VSC, false, (const f32x4*)nullptr);
#undef CONV_ROWS
        }
        VM_WAIT(); __syncthreads();
        pg8::Gemm g{U, WOUT, MTOK, D_MODEL, D_MODEL, D_MODEL}; pg8::StaticOrder S; S.init(MTOK, D_MODEL, F.G, (int)blockIdx.x);
        pg8::EpiOut E{x, X1B, SQX1}; pg8::gemm_phase<pg8::EpiOut, pg8::StaticOrder, true, true>(F.lds + RING_OFF, g, S, E, F.wave);
        GRID_BAR();
    }
    {
        PHASE_BEGIN();
        pg8::Gemm g{X1B, WPQ, MTOK, D_MODEL, D_MODEL, D_MODEL}; pg8::StaticOrder S; S.init(MTOK, D_MODEL, F.G, (int)blockIdx.x);
        pg8::EpiPQ E{QP, SQX1}; pg8::gemm_phase<pg8::EpiPQ, pg8::StaticOrder, true, true>(F.lds + RING_OFF, g, S, E, F.wave);
        GRID_BAR();
    }
    {
        PHASE_BEGIN();
#pragma unroll 1
        for (int t = gw; t < MTOK; t += NGW) { const bf16* xp = X1B + (size_t)t * D_MODEL + 32 * F.lane; v4u xw[4];
#pragma unroll
            for (int j = 0; j < 4; ++j) xw[j] = *(const v4u*)(xp + 8 * j);
            float xf[32]; float am = 0.f;
#pragma unroll
            for (int j = 0; j < 4; ++j) { const unsigned w4[4] = {xw[j].x, xw[j].y, xw[j].z, xw[j].w};
#pragma unroll
                for (int q = 0; q < 4; ++q) { xf[8 * j + 2 * q] = bf_lo(w4[q]); xf[8 * j + 2 * q + 1] = bf_hi(w4[q]); am = fmaxf(am, fmaxf(fabsf(xf[8 * j + 2 * q]), fabsf(xf[8 * j + 2 * q + 1]))); } }
            am = fmaxf(am, shx(am, 1, F.lane)); am = fmaxf(am, shx(am, 2, F.lane)); am = fmaxf(am, 1e-30f);
            const float sc = 127.f / am; v4u q0, q1;
            q0.x = pack_i8x4((f32x4){xf[0], xf[1], xf[2], xf[3]} * sc); q0.y = pack_i8x4((f32x4){xf[4], xf[5], xf[6], xf[7]} * sc); q0.z = pack_i8x4((f32x4){xf[8], xf[9], xf[10], xf[11]} * sc); q0.w = pack_i8x4((f32x4){xf[12], xf[13], xf[14], xf[15]} * sc);
            q1.x = pack_i8x4((f32x4){xf[16], xf[17], xf[18], xf[19]} * sc); q1.y = pack_i8x4((f32x4){xf[20], xf[21], xf[22], xf[23]} * sc); q1.z = pack_i8x4((f32x4){xf[24], xf[25], xf[26], xf[27]} * sc); q1.w = pack_i8x4((f32x4){xf[28], xf[29], xf[30], xf[31]} * sc);
            unsigned char* qp = X1Q + (size_t)t * D_MODEL + 32 * F.lane; *(v4u*)qp = q0; *(v4u*)(qp + 16) = q1;
            if ((F.lane & 3) == 0) XS[(size_t)t * 16 + (F.lane >> 2)] = am * (1.f / 127.f); }
        { const int NH8 = (F.G % 8 == 0) ? 8 : 1, grp = (int)blockIdx.x % NH8, bi = (int)blockIdx.x / NH8, nbl = F.G / NH8;
#pragma unroll 1
          for (int h = grp; h < PHEADS; h += NH8) {
#pragma unroll
              for (int it = 0; it < 8; ++it) { const int id = it * 512 + F.tid, c = id & 15, n = (id >> 4) & 127, pp = id >> 11;
                  const v4u w = *(const v4u*)(KEYS + ((size_t)(h * 2 + pp) * NKEYS + n) * KD + 8 * c);
                  *(LAS v4u*)(F.lds + pp * 32768 + n * 256 + ((c ^ (n & 15)) << 4)) = w; }
              __syncthreads();
#pragma unroll 1
              for (int tg = bi * 8 + F.wave; tg < MTOK / 16; tg += nbl * 8) topk_unit(F, tg, h, QP, TOPI, TOPG);
              __syncthreads(); } }
        GRID_BAR();
    }
    {
        PHASE_BEGIN();
        const int NG = (F.G % 8 == 0) ? 8 : 1, grp = (int)blockIdx.x % NG, li = (int)blockIdx.x / NG, nl = F.G / NG;
        const int t0 = li * 8 + F.wave, ts = nl * 8, NTW = (MTOK - t0 + ts - 1) / ts;
#define LOAD_IDX(I, n) do { const int t_ = t0 + (n) * ts; I.i0 = __builtin_nontemporal_load(TOPI + (size_t)t_ * 128 + F.lane); I.i1 = __builtin_nontemporal_load(TOPI + (size_t)t_ * 128 + 64 + F.lane); } while (0)
#pragma unroll 1
        for (int sl = grp; sl < 16; sl += NG) {
            PeerIdx IA, IB; PeerRow RA, RB; v4u wA[16], wB[16];
            LOAD_IDX(IA, 0); pu_gather(t0, sl, F.lane, IA, wA, RA, X1Q, XS, PU); if (NTW > 1) LOAD_IDX(IB, 1);
#pragma unroll 1
            for (int n = 0; n < NTW; n += 2) {
                if (n + 2 < NTW) LOAD_IDX(IA, n + 2);
                if (n + 1 < NTW) pu_gather(t0 + (n + 1) * ts, sl, F.lane, IB, wB, RB, X1Q, XS, PU);
                pu_compute(t0 + n * ts, sl, F.lane, wA, RA, PART);
                if (n + 1 < NTW) {
                    if (n + 3 < NTW) LOAD_IDX(IB, n + 3);
                    if (n + 2 < NTW) pu_gather(t0 + (n + 2) * ts, sl, F.lane, IA, wA, RA, X1Q, XS, PU);
                    pu_compute(t0 + (n + 1) * ts, sl, F.lane, wB, RB, PART); }
            } }
#undef LOAD_IDX
        GRID_BAR();
#pragma unroll 1
        for (int t = gw; t < MTOK; t += NGW) peer_fin_token(t, F.lane, PART, TOPI, TOPG, USC, VSC, SQX1);
        GRID_BAR();
#define LOAD_IDXA(I, n) do { const int t_ = t0 + (n) * ts; I.i0 = __builtin_nontemporal_load(TOPI + (size_t)t_ * 128 + F.lane); I.i1 = __builtin_nontemporal_load(TOPI + (size_t)t_ * 128 + 64 + F.lane); \
            I.a0 = __builtin_nontemporal_load(TOPG + (size_t)t_ * 128 + F.lane); I.a1 = __builtin_nontemporal_load(TOPG + (size_t)t_ * 128 + 64 + F.lane); } while (0)
#pragma unroll 1
        for (int sl = grp; sl < 16; sl += NG) {
            PeerIdx IA, IB, IC; float xA[2], xB[2]; v4u wA[16], wB[16];
            LOAD_IDXA(IA, 0); pv_gather(t0, sl, F.lane, IA, wA, xA, X1B, PV); if (NTW > 1) LOAD_IDXA(IB, 1);
#pragma unroll 1
            for (int n = 0; n < NTW; n += 2) {
                if (n + 2 < NTW) LOAD_IDXA(IC, n + 2);
                if (n + 1 < NTW) pv_gather(t0 + (n + 1) * ts, sl, F.lane, IB, wB, xB, X1B, PV);
                pv_compute(t0 + n * ts, sl, F.lane, IA, wA, xA, X2, SQQ);
                IA = IC;
                if (n + 1 < NTW) {
                    if (n + 3 < NTW) LOAD_IDXA(IC, n + 3);
                    if (n + 2 < NTW) pv_gather(t0 + (n + 2) * ts, sl, F.lane, IA, wA, xA, X1B, PV);
                    pv_compute(t0 + (n + 1) * ts, sl, F.lane, IB, wB, xB, X2, SQQ);
                    IB = IC; }
            } }
#undef LOAD_IDXA
        GRID_BAR();
#pragma unroll 1
        for (int t = gw; t < MTOK; t += NGW) { const float rf = __builtin_amdgcn_rsqf(fx_get(SQQ + t) * (1.f / D_MODEL) + EPS);
            const v2u* xr = (const v2u*)(X2 + (size_t)t * D_MODEL) + F.lane; f32x4* orow = (f32x4*)(out + (size_t)t * D_MODEL) + F.lane;
#pragma unroll
            for (int j = 0; j < 8; ++j) { const v2u xw = __builtin_nontemporal_load(xr + 64 * j); const f32x4 v = {bf_lo(xw.x), bf_hi(xw.x), bf_lo(xw.y), bf_hi(xw.y)}, gg = *((const f32x4*)g_final + F.lane + 64 * j); f32x4 o4;
#pragma unroll
                for (int e = 0; e < 4; ++e) o4[e] = v[e] * rf * gg[e];
                __builtin_nontemporal_store(o4, orow + 64 * j); } }
    }
#undef GRID_BAR
}

extern "C" void kernel_launch(void* const* d_in, const int* in_sizes, int n_in, void* d_out, int out_size, void* d_ws, size_t ws_size, hipStream_t stream) {
    static int grid = 0;
    if (grid == 0) {
        if (n_in != 20 || in_sizes[0] != MTOK * D_MODEL || out_size != MTOK * D_MODEL || ws_size < WS_END) {
            fprintf(stderr, "kernel_launch: unexpected shapes (n_in %d, in0 %d, out %d, ws %zu); nothing launched\n", n_in, n_in > 0 ? in_sizes[0] : -1, out_size, ws_size); grid = -1; return; }
        int dev = 0, cus = 0;
        if (hipGetDevice(&dev) != hipSuccess || hipDeviceGetAttribute(&cus, hipDeviceAttributeMultiprocessorCount, dev) != hipSuccess) { fprintf(stderr, "kernel_launch: device query failed\n"); grid = -1; return; }
        if (hipFuncSetAttribute((const void*)mk_fwd, hipFuncAttributeMaxDynamicSharedMemorySize, LDS_BYTES) != hipSuccess) { fprintf(stderr, "kernel_launch: hipFuncSetAttribute failed\n"); grid = -1; return; }
        (void)hipGetLastError();
        grid = cus;
    }
    if (grid < 0) return;
    (void)hipMemsetAsync((char*)d_ws + WS_CTL, 0, CTL_ZERO_BYTES, stream);
    Args a{};
    for (int i = 0; i < 20; ++i) a.in[i] = (const float*)d_in[i];
    a.out = (float*)d_out; a.ws = (unsigned char*)d_ws;
    hipLaunchKernelGGL(mk_fwd, dim3(grid), dim3(512), LDS_BYTES, stream, a);
    const hipError_t le = hipPeekAtLastError();
    if (le != hipSuccess) fprintf(stderr, "kernel_launch: launch failed: %s\n", hipGetErrorName(le));
}
```

```cpp
#include <hip/hip_runtime.h>
#include <hip/hip_bf16.h>
#include <cstdio>
#include <cstdint>


constexpr int D_MODEL = 2048, NB = 2, SEQL = 8192, MTOK = NB * SEQL;
constexpr int NHEAD = 16, QL = 512, DN = 128, DR = 64, DVH = 128, DQK = 192;
constexpr int IN_COLS = 9280, IN16_ROWS = 2048, IN8_ROWS = 9472;
constexpr float Q8_SCALE = 64.f, K8_SCALE = 8.f, V8_SCALE = 8.f;
constexpr float XN8_SCALE = 8.f, WIN8_SCALE = 64.f, IN8_DESCALE = 1.f / 512.f;
constexpr int NQ_COLS = NHEAD * DQK, NKV_COLS = NHEAD * (DN + DVH);
constexpr int PHEADS = 8, NKEYS = 128, TOPK = 16, KD = 128, NEXP = 16384;
constexpr float EPS = 1e-6f;
constexpr float FXS = 16777216.f, FXI = 1.f / 16777216.f;
constexpr float C2Q = 0.07216878364870322f * 1.4426950408889634f;

constexpr size_t MiB = 1u << 20;
constexpr size_t WS_CTL = 0, CTL_ZERO_BYTES = 32 * 1024;
constexpr size_t WS_KEYS = 1 * MiB, WS_WSP = 1 * MiB + 512 * 1024;
constexpr size_t WS_WUQ = 2 * MiB, WS_WUKV = 5 * MiB, WS_WOUT = 9 * MiB, WS_WPQ = 17 * MiB;
constexpr size_t WS_ROPE = 27 * MiB;
constexpr size_t WS_WIN8 = 46 * MiB;
constexpr size_t WS_XN8 = 66 * MiB;
constexpr size_t WS_Q = 32 * MiB;
constexpr size_t WS_CQKV = 128 * MiB;
constexpr size_t WS_U = 160 * MiB;
constexpr size_t WS_VG = 224 * MiB;
constexpr size_t WS_GA = 288 * MiB;
constexpr size_t WS_V = 352 * MiB;
constexpr size_t WS_K = 416 * MiB;
constexpr size_t WS_KR = 504 * MiB;
constexpr size_t WS_X2 = 288 * MiB;
constexpr size_t WS_X1B = 96 * MiB;
constexpr size_t WS_PU = 32 * MiB, WS_PV = 64 * MiB;
constexpr size_t WS_X1Q = 160 * MiB, WS_XS = 192 * MiB;
constexpr size_t WS_PART = 352 * MiB;
constexpr size_t WS_PSC = 31 * MiB;
constexpr size_t WS_QP = 224 * MiB;
constexpr size_t WS_TOPI = 480 * MiB, WS_TOPG = 488 * MiB;
constexpr size_t WS_END = 512 * MiB;
constexpr int CW_BAR = 4096;
constexpr size_t CTL_STATS = 128 * 1024;
constexpr int RING_OFF = 0, RING_BYTES = 131072;
constexpr int LDSCTL_OFF = RING_BYTES, MISC_OFF = LDSCTL_OFF + 320;
constexpr int LDS_BYTES = 147456;

#define GAS __attribute__((address_space(1)))
#define LAS __attribute__((address_space(3)))
typedef unsigned short bf16;
typedef unsigned v4u __attribute__((ext_vector_type(4)));
typedef unsigned v2u __attribute__((ext_vector_type(2)));
typedef float f32x4 __attribute__((ext_vector_type(4)));
typedef float f32x16 __attribute__((ext_vector_type(16)));
typedef short bf16x8 __attribute__((ext_vector_type(8)));
typedef short s16x4 __attribute__((ext_vector_type(4)));
typedef int v8i __attribute__((ext_vector_type(8)));
typedef unsigned long long u64;
#define LDS_WAIT() asm volatile("s_waitcnt lgkmcnt(0)" ::: "memory")
#define VM_WAIT() asm volatile("s_waitcnt vmcnt(0)" ::: "memory")
#define SBAR() __builtin_amdgcn_sched_barrier(0)

typedef float f32x2_t __attribute__((ext_vector_type(2))); typedef __bf16 bf16x2_t __attribute__((ext_vector_type(2)));
__device__ __forceinline__ unsigned cvt_pk_bf16(float lo, float hi) { f32x2_t v = {lo, hi}; bf16x2_t b = __builtin_convertvector(v, bf16x2_t); return __builtin_bit_cast(unsigned, b); }
__device__ __forceinline__ unsigned pack_fp8x4(f32x4 v) {
    v = __builtin_elementwise_min(__builtin_elementwise_max(v, (f32x4){-448.f, -448.f, -448.f, -448.f}), (f32x4){448.f, 448.f, 448.f, 448.f});
    int p = 0; p = __builtin_amdgcn_cvt_pk_fp8_f32(v[0], v[1], p, false); p = __builtin_amdgcn_cvt_pk_fp8_f32(v[2], v[3], p, true); return (unsigned)p; }
__device__ __forceinline__ float bf_lo(unsigned w) { return __uint_as_float(w << 16); }
__device__ __forceinline__ float bf_hi(unsigned w) { return __uint_as_float(w & 0xffff0000u); }
__device__ __forceinline__ float gelu_t(float x) { const float t = x * (1.f + 0.044715f * x * x); const float e = __builtin_amdgcn_exp2f(-2.3022081986f * t); return x * __builtin_amdgcn_rcpf(1.f + e); }
__device__ __forceinline__ float sigmoid_f(float y) { return __builtin_amdgcn_rcpf(1.f + __builtin_amdgcn_exp2f(-1.4426950409f * y)); }
__device__ __forceinline__ void fx_add(u64* p, float v) { const long long q = __float2ll_rn(v * FXS); atomicAdd(p, (u64)q); }
__device__ __forceinline__ float fx_get(const u64* p) { return (float)((double)(long long)(*p) * (double)FXI); }
__device__ __forceinline__ int lane_id() { int l; asm volatile("v_mbcnt_lo_u32_b32 %0, -1, 0\n\tv_mbcnt_hi_u32_b32 %0, -1, %0" : "=v"(l)); return l; }

__device__ __forceinline__ float shx(float v, int o, int lane) { return __builtin_bit_cast(float, __builtin_amdgcn_ds_bpermute((lane ^ o) << 2, __builtin_bit_cast(int, v))); }
__device__ __forceinline__ float wave_sum(float v, int lane) {
#pragma unroll
    for (int o = 1; o < 64; o <<= 1) v += shx(v, o, lane);
    return v;
}

namespace pg8 {
#define PG8_LAS __attribute__((address_space(3)))
typedef unsigned short bf16_t;
constexpr int BM = 256, BK = 64, HALF = 128, HTB = HALF * BK * 2, STAGE_BYTES = 8 * HTB, NXCD = 8, WGM = 8;
__host__ __device__ __forceinline__ int lds_byte(int r, int c) { const int st = (r >> 4) * 2 + (c >> 5), rr = r & 15, cc = c & 31, ob = rr * 64 + cc * 2; return st * 1024 + (ob ^ (((ob >> 9) & 1) << 5)); }
__host__ __device__ __forceinline__ void stage_rc(int b, int& R, int& C) { const int st = b / 1024, sb = b % 1024, swz = sb ^ (((sb >> 9) & 1) << 5); R = (st >> 1) * 16 + swz / 64; C = (st & 1) * 32 + (swz % 64) / 2; }
__host__ __device__ __forceinline__ int perm32(int rho) { const int n = rho >> 4, i = rho & 15; return 8 * (i >> 2) + 4 * n + (i & 3); }
struct Unit { int pm, pn; };
struct Gemm { const bf16_t* A; const bf16_t* Bt; int M, N, K, lda; };
struct StaticOrder {
    int nM, nN, nwg, G, c;
    __host__ __device__ void init(int M, int N, int G_, int c_) { nM = M / BM; nN = N / BM; nwg = nM * nN; G = G_; c = c_; }
    __host__ __device__ bool next(int i, Unit& u) const {
        const long L = (long)i * G + c; if (L >= nwg) return false;
        int wgid = (int)L; { const int q = nwg / NXCD, r = nwg % NXCD, xcd = wgid % NXCD, off = wgid / NXCD; wgid = (xcd < r ? xcd * (q + 1) : r * (q + 1) + (xcd - r) * q) + off; }
        const int nig = WGM * nN, gid = wgid / nig, fm = gid * WGM, gsz = (nM - fm) < WGM ? (nM - fm) : WGM;
        u.pm = fm + ((wgid % nig) % gsz); u.pn = (wgid % nig) / gsz; return true;
    }
};
template <class Epi, class Sched, bool ALIGN_EPI = false, bool SP2 = false, bool F8 = false, bool SWAP1 = false>
__device__ __forceinline__ void gemm_phase(PG8_LAS unsigned char* lds, const Gemm g, const Sched& S, const Epi& E, const int wave) {
    int tid = wave * 64 + lane_id(); asm volatile("" : "+v"(tid));
    const int wid = __builtin_amdgcn_readfirstlane(tid >> 6), lane = tid & 63, wr = wid >> 2, wc = wid & 3, fr = lane & 15, fq = lane >> 4;
    const int K = g.K, nt = K / BK, lda = g.lda;
    unsigned voffA[2], voffB[2];
#pragma unroll
    for (int i = 0; i < 2; ++i) { int R, C; stage_rc(tid * 16 + i * 8192, R, C); const int Rb = Epi::PERM ? ((R & ~31) + perm32(R & 31)) : R;
        voffA[i] = (unsigned)(R * lda + C) * 2u; voffB[i] = (unsigned)(Rb * K + C) * 2u; }
    const size_t kstep = (size_t)(BK * 2);
    const size_t hstepA = (size_t)HALF * lda * 2, hstepB = (size_t)HALF * K * 2;
    const size_t tstepA = 2 * hstepA, tstepB = 2 * hstepB;
    const unsigned ldsw = (unsigned)wid * 1024u;
    const int aoff = lds_byte(wr * 64 + fr, fq * 8), boff = lds_byte(wc * 32 + fr, fq * 8);
#define PG8_SA(b, h) (((b) * 2 + (h)) * HTB)
#define PG8_SB(b, h) ((4 + (b) * 2 + (h)) * HTB)
#define PG8_STAGE(bufoff, gbase, voff) do { _Pragma("unroll") for (int _i = 0; _i < 2; ++_i) \
        { unsigned vo_ = (voff)[_i]; asm volatile("" : "+v"(vo_)); __builtin_amdgcn_global_load_lds((const unsigned*)((const char*)(gbase) + vo_), (PG8_LAS unsigned*)(lds + (bufoff) + ldsw + _i * 8192), 16, 0, 0); } } while (0)
#define PG8_LDA(dst, b, h) do { _Pragma("unroll") for (int m = 0; m < 4; ++m) _Pragma("unroll") for (int k = 0; k < 2; ++k) dst[m][k] = *(const PG8_LAS bf16x8*)(lds + PG8_SA(b, h) + aoff + m * 2048 + k * 1024); } while (0)
#define PG8_LDB(dst, b, h) do { _Pragma("unroll") for (int n = 0; n < 2; ++n) _Pragma("unroll") for (int k = 0; k < 2; ++k) dst[n][k] = *(const PG8_LAS bf16x8*)(lds + PG8_SB(b, h) + boff + n * 2048 + k * 1024); } while (0)
#define PG8_CAT(x) __builtin_bit_cast(v8i, __builtin_shufflevector((x)[0], (x)[1], 0, 1, 2, 3, 4, 5, 6, 7, 8, 9, 10, 11, 12, 13, 14, 15))
#define PG8_MMA(ai, bj, At, Bt) do { __builtin_amdgcn_s_setprio(1); _Pragma("unroll") for (int m = 0; m < 4; ++m) _Pragma("unroll") for (int n = 0; n < 2; ++n) { \
        if constexpr (F8 && SWAP1 && (bj) == 1) acc[ai][bj][m][n] = __builtin_amdgcn_mfma_scale_f32_16x16x128_f8f6f4(PG8_CAT(At[m]), PG8_CAT(Bt[n]), acc[ai][bj][m][n], 0, 0, 0, 0x7f7f7f7f, 0, 0x7f7f7f7f); \
        else if constexpr (F8) acc[ai][bj][m][n] = __builtin_amdgcn_mfma_scale_f32_16x16x128_f8f6f4(PG8_CAT(Bt[n]), PG8_CAT(At[m]), acc[ai][bj][m][n], 0, 0, 0, 0x7f7f7f7f, 0, 0x7f7f7f7f); \
        else { _Pragma("unroll") for (int k = 0; k < 2; ++k) acc[ai][bj][m][n] = __builtin_amdgcn_mfma_f32_16x16x32_bf16(Bt[n][k], At[m][k], acc[ai][bj][m][n], 0, 0, 0); } } __builtin_amdgcn_s_setprio(0); } while (0)
#define PG8_WAIT_V(n) asm volatile("s_waitcnt vmcnt(" #n ")" ::: "memory")
#define PG8_WAIT_L(n) asm volatile("s_waitcnt lgkmcnt(" #n ")" ::: "memory")
#define PG8_BAR __builtin_amdgcn_s_barrier()
#define PG8_SCHED __builtin_amdgcn_sched_barrier(0)
    Unit cur, nxt; int ui = 0;
    if (!S.next(0, cur)) return;
    f32x4 acc[2][2][4][2];
#pragma unroll
    for (int a = 0; a < 2; ++a)
#pragma unroll
        for (int b = 0; b < 2; ++b)
#pragma unroll
            for (int m = 0; m < 4; ++m)
#pragma unroll
                for (int n = 0; n < 2; ++n) acc[a][b][m][n] = (f32x4){0.f, 0.f, 0.f, 0.f};
    bf16x8 At[4][2], B0[2][2], B1[2][2];
    const char* cA = (const char*)g.A + (size_t)cur.pm * tstepA; const char* cB = (const char*)g.Bt + (size_t)cur.pn * tstepB;
    if constexpr (SP2) {
        PG8_STAGE(PG8_SB(0, 0), cB, voffB); PG8_STAGE(PG8_SB(0, 1), cB + hstepB, voffB); PG8_STAGE(PG8_SA(0, 0), cA, voffA); PG8_STAGE(PG8_SA(0, 1), cA + hstepA, voffA);
        if (wr == 1) PG8_BAR;
        PG8_WAIT_V(2); PG8_BAR;
        PG8_STAGE(PG8_SB(1, 0), cB + kstep, voffB); PG8_STAGE(PG8_SA(1, 0), cA + kstep, voffA); PG8_STAGE(PG8_SB(1, 1), cB + hstepB + kstep, voffB);
        PG8_WAIT_V(6); PG8_BAR;
    } else {
        PG8_STAGE(PG8_SB(0, 0), cB, voffB); PG8_STAGE(PG8_SA(0, 0), cA, voffA); PG8_STAGE(PG8_SB(0, 1), cB + hstepB, voffB); PG8_STAGE(PG8_SA(0, 1), cA + hstepA, voffA);
        if (wr == 1) PG8_BAR;
        PG8_WAIT_V(4); PG8_BAR;
        PG8_STAGE(PG8_SB(1, 0), cB + kstep, voffB); PG8_STAGE(PG8_SA(1, 0), cA + kstep, voffA); PG8_STAGE(PG8_SB(1, 1), cB + hstepB + kstep, voffB);
        PG8_WAIT_V(6); PG8_BAR;
    }
    for (;;) {
        const bool has_next = S.next(ui + 1, nxt);
        const char* nA = has_next ? (const char*)g.A + (size_t)nxt.pm * tstepA : cA; const char* nB = has_next ? (const char*)g.Bt + (size_t)nxt.pn * tstepB : cB;
#pragma unroll 1
        for (int t = 0; t < nt; t += 2) {
            const bool last = (t == nt - 2);
            const char* a1 = cA + (size_t)(t + 1) * kstep;
            const char* a2 = last ? nA : cA + (size_t)(t + 2) * kstep; const char* b2 = last ? nB : cB + (size_t)(t + 2) * kstep;
            const char* a3 = a2 + kstep; const char* b3 = b2 + kstep;
            if constexpr (SP2) {
            PG8_LDB(B0, 0, 0); PG8_LDB(B1, 0, 1); PG8_SCHED; PG8_LDA(At, 0, 0); PG8_STAGE(PG8_SA(1, 1), a1 + hstepA, voffA);
            PG8_WAIT_V(8); PG8_WAIT_L(0); PG8_BAR; PG8_MMA(0, 0, At, B0); PG8_MMA(0, 1, At, B1); PG8_BAR; PG8_SCHED;
            PG8_LDA(At, 0, 1); PG8_STAGE(PG8_SB(0, 0), b2, voffB); PG8_STAGE(PG8_SB(0, 1), b2 + hstepB, voffB); PG8_STAGE(PG8_SA(0, 0), a2, voffA);
            PG8_WAIT_V(8); PG8_WAIT_L(0); PG8_BAR; PG8_MMA(1, 0, At, B0); PG8_MMA(1, 1, At, B1); PG8_BAR; PG8_SCHED;
            PG8_LDB(B0, 1, 0); PG8_LDB(B1, 1, 1); PG8_SCHED; PG8_LDA(At, 1, 0); PG8_STAGE(PG8_SA(0, 1), a2 + hstepA, voffA);
            PG8_WAIT_V(8); PG8_WAIT_L(0); PG8_BAR; PG8_MMA(0, 0, At, B0); PG8_MMA(0, 1, At, B1); PG8_BAR; PG8_SCHED;
            PG8_LDA(At, 1, 1); PG8_STAGE(PG8_SB(1, 0), b3, voffB); PG8_STAGE(PG8_SB(1, 1), b3 + hstepB, voffB); PG8_STAGE(PG8_SA(1, 0), a3, voffA);
            PG8_WAIT_V(8); PG8_WAIT_L(0); PG8_BAR; PG8_MMA(1, 0, At, B0); PG8_MMA(1, 1, At, B1); PG8_BAR; PG8_SCHED;
            } else {
            PG8_LDB(B0, 0, 0); PG8_SCHED; PG8_LDA(At, 0, 0); PG8_STAGE(PG8_SA(1, 1), a1 + hstepA, voffA);
            PG8_WAIT_L(8); PG8_BAR; PG8_WAIT_L(0); PG8_MMA(0, 0, At, B0); PG8_BAR; PG8_SCHED;
            PG8_LDB(B1, 0, 1); PG8_STAGE(PG8_SB(0, 0), b2, voffB);
            PG8_BAR; PG8_WAIT_L(0); PG8_MMA(0, 1, At, B1); PG8_BAR;
            PG8_LDA(At, 0, 1); PG8_STAGE(PG8_SA(0, 0), a2, voffA);
            PG8_BAR; PG8_WAIT_L(0); PG8_MMA(1, 0, At, B0); PG8_BAR; PG8_SCHED;
            PG8_STAGE(PG8_SB(0, 1), b2 + hstepB, voffB);
            PG8_WAIT_V(6); PG8_BAR; PG8_MMA(1, 1, At, B1); PG8_BAR;
            PG8_LDB(B0, 1, 0); PG8_SCHED; PG8_LDA(At, 1, 0); PG8_STAGE(PG8_SA(0, 1), a2 + hstepA, voffA);
            PG8_WAIT_L(8); PG8_BAR; PG8_WAIT_L(0); PG8_MMA(0, 0, At, B0); PG8_BAR; PG8_SCHED;
            PG8_LDB(B1, 1, 1); PG8_STAGE(PG8_SB(1, 0), b3, voffB);
            PG8_BAR; PG8_WAIT_L(0); PG8_MMA(0, 1, At, B1); PG8_BAR;
            PG8_LDA(At, 1, 1); PG8_STAGE(PG8_SA(1, 0), a3, voffA);
            PG8_BAR; PG8_WAIT_L(0); PG8_MMA(1, 0, At, B0); PG8_BAR; PG8_SCHED;
            PG8_STAGE(PG8_SB(1, 1), b3 + hstepB, voffB);
            PG8_WAIT_V(6); PG8_BAR; PG8_MMA(1, 1, At, B1); PG8_BAR;
            }
        }
        if constexpr (ALIGN_EPI) { if (wr == 0) PG8_BAR; }
        { const int le = lane_id(); E(acc, cur, wr, wc, le & 15, le >> 4); }
        if (!has_next) break;
#pragma unroll
        for (int a = 0; a < 2; ++a)
#pragma unroll
            for (int b = 0; b < 2; ++b)
#pragma unroll
                for (int m = 0; m < 4; ++m)
#pragma unroll
                    for (int n = 0; n < 2; ++n) acc[a][b][m][n] = (f32x4){0.f, 0.f, 0.f, 0.f};
        cur = nxt; cA = nA; cB = nB; ++ui;
        if constexpr (ALIGN_EPI) { if (wr == 1) PG8_BAR; }
    }
    PG8_WAIT_V(0);
    if constexpr (!ALIGN_EPI) { if (wr == 0) PG8_BAR; }
    PG8_BAR;
#undef PG8_SA
#undef PG8_SB
#undef PG8_STAGE
#undef PG8_LDA
#undef PG8_LDB
#undef PG8_MMA
#undef PG8_CAT
#undef PG8_WAIT_V
#undef PG8_WAIT_L
#undef PG8_BAR
#undef PG8_SCHED
}

#define EPI_ROWS(ai, m) (u.pm * BM + wr * 64 + fr + (ai) * HALF + (m) * 16)
struct EpiIn {
    static constexpr bool PERM = true;
    int mode; float sc;
    bf16_t *U, *GA, *VG; unsigned char *CQKV, *KR; const float* bgate; const float* rope; u64 *sqq, *sqkv, *ssum, *ssq;
    __device__ __forceinline__ void operator()(const f32x4 (&acc)[2][2][4][2], const Unit& u, int wr, int wc, int fr, int fq) const {
        const int pn = u.pn, cw = wc * 32 + 8 * fq;
        if (mode == 1 || pn >= 29) {
            const int c0 = (mode == 1 ? pn : pn - 29) * 256 + cw;
#pragma unroll
            for (int ai = 0; ai < 2; ++ai)
#pragma unroll
                for (int m = 0; m < 4; ++m) { const int row = EPI_ROWS(ai, m); float s = 0.f, q = 0.f;
#pragma unroll
                    for (int bj = 0; bj < 2; ++bj) { f32x4 v0 = acc[ai][bj][m][0] * sc, v1 = acc[ai][bj][m][1] * sc;
#pragma unroll
                        for (int e = 0; e < 4; ++e) { v0[e] = gelu_t(v0[e]); v1[e] = gelu_t(v1[e]); }
                        s += (v0[0] + v0[1]) + (v0[2] + v0[3]) + (v1[0] + v1[1]) + (v1[2] + v1[3]);
                        q += (v0[0] * v0[0] + v0[1] * v0[1]) + (v0[2] * v0[2] + v0[3] * v0[3]) + (v1[0] * v1[0] + v1[1] * v1[1]) + (v1[2] * v1[2] + v1[3] * v1[3]);
                        v4u w; w.x = cvt_pk_bf16(v0[0], v0[1]); w.y = cvt_pk_bf16(v0[2], v0[3]); w.z = cvt_pk_bf16(v1[0], v1[1]); w.w = cvt_pk_bf16(v1[2], v1[3]);
                        __builtin_nontemporal_store(w, (v4u*)(VG + (size_t)row * 2048 + c0 + bj * HALF)); }
                    s += shx(s, 16, fq * 16 + fr); s += shx(s, 32, fq * 16 + fr); q += shx(q, 16, fq * 16 + fr); q += shx(q, 32, fq * 16 + fr);
                    if (fq == 0) { fx_add(ssum + row, s); fx_add(ssq + row, q); } }
        } else if (pn < 16) {
            const int c0 = pn * 128 + cw; const float* bg = bgate + 2048 + c0;
            const f32x4 b0 = *(const f32x4*)bg, b1 = *(const f32x4*)(bg + 4);
#pragma unroll
            for (int ai = 0; ai < 2; ++ai)
#pragma unroll
                for (int m = 0; m < 4; ++m) { const int row = EPI_ROWS(ai, m);
                    f32x4 v0 = acc[ai][0][m][0] * sc, v1 = acc[ai][0][m][1] * sc; const f32x4 g0 = acc[ai][1][m][0] * sc + b0, g1 = acc[ai][1][m][1] * sc + b1;
#pragma unroll
                    for (int e = 0; e < 4; ++e) { v0[e] = gelu_t(v0[e]) * sigmoid_f(g0[e]); v1[e] = gelu_t(v1[e]) * sigmoid_f(g1[e]); }
                    v4u w; w.x = cvt_pk_bf16(v0[0], v0[1]); w.y = cvt_pk_bf16(v0[2], v0[3]); w.z = cvt_pk_bf16(v1[0], v1[1]); w.w = cvt_pk_bf16(v1[2], v1[3]);
                    __builtin_nontemporal_store(w, (v4u*)(U + (size_t)row * 2048 + c0)); }
        } else if (pn < 24) {
            const int c0 = (pn - 16) * 256 + cw; const float* bg = bgate + c0;
            f32x4 bv[2][2];
#pragma unroll
            for (int bj = 0; bj < 2; ++bj) { bv[bj][0] = *(const f32x4*)(bg + bj * HALF); bv[bj][1] = *(const f32x4*)(bg + bj * HALF + 4); }
#pragma unroll
            for (int ai = 0; ai < 2; ++ai)
#pragma unroll
                for (int m = 0; m < 4; ++m) { const int row = EPI_ROWS(ai, m);
#pragma unroll
                    for (int bj = 0; bj < 2; ++bj) { f32x4 v0 = acc[ai][bj][m][0] * sc + bv[bj][0], v1 = acc[ai][bj][m][1] * sc + bv[bj][1];
#pragma unroll
                        for (int e = 0; e < 4; ++e) { v0[e] = sigmoid_f(v0[e]); v1[e] = sigmoid_f(v1[e]); }
                        v4u w; w.x = cvt_pk_bf16(v0[0], v0[1]); w.y = cvt_pk_bf16(v0[2], v0[3]); w.z = cvt_pk_bf16(v1[0], v1[1]); w.w = cvt_pk_bf16(v1[2], v1[3]);
                        __builtin_nontemporal_store(w, (v4u*)(GA + (size_t)row * 2048 + c0 + bj * HALF)); } }
        } else if (pn < 28) {
            const int pc = pn - 24; u64* sq = pc < 2 ? sqq : sqkv;
#pragma unroll
            for (int ai = 0; ai < 2; ++ai)
#pragma unroll
                for (int m = 0; m < 4; ++m) { const int row = EPI_ROWS(ai, m); float s = 0.f;
#pragma unroll
                    for (int bj = 0; bj < 2; ++bj) { const f32x4 v0 = acc[ai][bj][m][0] * sc, v1 = acc[ai][bj][m][1] * sc;
                        s += (v0[0] * v0[0] + v0[1] * v0[1]) + (v0[2] * v0[2] + v0[3] * v0[3]) + (v1[0] * v1[0] + v1[1] * v1[1]) + (v1[2] * v1[2] + v1[3] * v1[3]);
                        v2u w; w.x = pack_fp8x4(v0 * XN8_SCALE); w.y = pack_fp8x4(v1 * XN8_SCALE);
                        *(v2u*)(CQKV + (size_t)row * 1024 + pc * 256 + bj * HALF + cw) = w; }
                    s += shx(s, 16, fq * 16 + fr); s += shx(s, 32, fq * 16 + fr);
                    if (fq == 0) fx_add(sq + row, s); }
        } else {
            if (wc < 2) {
                const int i0 = cw >> 1;
#pragma unroll
                for (int ai = 0; ai < 2; ++ai)
#pragma unroll
                    for (int m = 0; m < 4; ++m) { const int row = EPI_ROWS(ai, m);
                        const f32x4 c4 = *(const f32x4*)(rope + (size_t)row * 32 + i0), s4 = *(const f32x4*)(rope + (size_t)MTOK * 32 + (size_t)row * 32 + i0);
                        const f32x4 v0 = acc[ai][0][m][0] * sc, v1 = acc[ai][0][m][1] * sc;
                        const f32x4 r0 = {v0[0] * c4[0] - v0[1] * s4[0], v0[0] * s4[0] + v0[1] * c4[0], v0[2] * c4[1] - v0[3] * s4[1], v0[2] * s4[1] + v0[3] * c4[1]};
                        const f32x4 r1 = {v1[0] * c4[2] - v1[1] * s4[2], v1[0] * s4[2] + v1[1] * c4[2], v1[2] * c4[3] - v1[3] * s4[3], v1[2] * s4[3] + v1[3] * c4[3]};
                        v2u w; w.x = pack_fp8x4(r0 * K8_SCALE); w.y = pack_fp8x4(r1 * K8_SCALE);
                        *(v2u*)(KR + (size_t)row * DR + cw) = w; }
            }
        }
    }
};
struct EpiQ {
    static constexpr bool PERM = true;
    unsigned char* Q; const u64* sqq; const float* rope;
    __device__ __forceinline__ void operator()(const f32x4 (&acc)[2][2][4][2], const Unit& u, int wr, int wc, int fr, int fq) const {
        const int cw = wc * 32 + 8 * fq;
#pragma unroll
        for (int ai = 0; ai < 2; ++ai)
#pragma unroll
            for (int m = 0; m < 4; ++m) { const int row = EPI_ROWS(ai, m); const int b = row >> 13, s = row & 8191;
                const float rq = __builtin_amdgcn_rsqf(fx_get(sqq + row) * (1.f / QL) + EPS) * (C2Q * IN8_DESCALE * Q8_SCALE);
#pragma unroll
                for (int bj = 0; bj < 2; ++bj) { const int colg = u.pn * 256 + bj * HALF + cw; const int head = colg / DQK, dd = colg - head * DQK;
                    f32x4 v0 = acc[ai][bj][m][0] * rq, v1 = acc[ai][bj][m][1] * rq;
                    if (dd >= DN) { const int i0 = (dd - DN) >> 1;
                        const f32x4 c4 = *(const f32x4*)(rope + (size_t)row * 32 + i0), s4 = *(const f32x4*)(rope + (size_t)MTOK * 32 + (size_t)row * 32 + i0);
                        const f32x4 r0 = {v0[0] * c4[0] - v0[1] * s4[0], v0[0] * s4[0] + v0[1] * c4[0], v0[2] * c4[1] - v0[3] * s4[1], v0[2] * s4[1] + v0[3] * c4[1]};
                        const f32x4 r1 = {v1[0] * c4[2] - v1[1] * s4[2], v1[0] * s4[2] + v1[1] * c4[2], v1[2] * c4[3] - v1[3] * s4[3], v1[2] * s4[3] + v1[3] * c4[3]};
                        v0 = r0; v1 = r1; }
                    v2u w; w.x = pack_fp8x4(v0); w.y = pack_fp8x4(v1);
                    *(v2u*)(Q + ((size_t)(b * NHEAD + head) * SEQL + s) * DQK + dd) = w; } }
    }
};
struct EpiKV {
    static constexpr bool PERM = true;
    unsigned char* Kb; unsigned char* Vt; const u64* sqkv;
    __device__ __forceinline__ void operator()(const f32x4 (&acc)[2][2][4][2], const Unit& u, int wr, int wc, int fr, int fq) const {
        const int cw = wc * 32 + 8 * fq, head = u.pn;
#pragma unroll
        for (int ai = 0; ai < 2; ++ai)
#pragma unroll
            for (int m = 0; m < 4; ++m) {
                { const int row = EPI_ROWS(ai, m); const int b = row >> 13, s = row & 8191;
                  const float rk = __builtin_amdgcn_rsqf(fx_get(sqkv + row) * (1.f / QL) + EPS) * (IN8_DESCALE * K8_SCALE); const size_t tr = (size_t)(b * NHEAD + head) * SEQL + s;
                  v2u w; w.x = pack_fp8x4(acc[ai][0][m][0] * rk); w.y = pack_fp8x4(acc[ai][0][m][1] * rk); *(v2u*)(Kb + tr * DN + cw) = w; }
                { const int row0 = u.pm * BM + wr * 64 + ai * HALF + m * 16 + 4 * fq; const int b = row0 >> 13, s0 = row0 & 8191;
                  f32x4 rk4;
#pragma unroll
                  for (int e = 0; e < 4; ++e) rk4[e] = __builtin_amdgcn_rsqf(fx_get(sqkv + row0 + e) * (1.f / QL) + EPS) * (IN8_DESCALE * V8_SCALE);
                  const int slot = (s0 & ~63) + 32 * (fq & 1) + 4 * (2 * m + (fq >> 1));
#pragma unroll
                  for (int n = 0; n < 2; ++n) { const int dv = wc * 32 + 8 * (fr >> 2) + 4 * n + (fr & 3);
                      *(unsigned*)(Vt + ((size_t)(b * NHEAD + head) * DVH + dv) * SEQL + slot) = pack_fp8x4(acc[ai][1][m][n] * rk4); } }
            }
    }
};
struct EpiOut {
    static constexpr bool PERM = false;
    const float* x; bf16_t* X1B; u64* sqx;
    __device__ __forceinline__ void operator()(const f32x4 (&acc)[2][2][4][2], const Unit& u, int wr, int wc, int fr, int fq) const {
        const int col0 = u.pn * BM + wc * 32 + 4 * fq;
#pragma unroll
        for (int ai = 0; ai < 2; ++ai)
#pragma unroll
            for (int m = 0; m < 4; ++m) { const int row = EPI_ROWS(ai, m); float s = 0.f;
#pragma unroll
                for (int bj = 0; bj < 2; ++bj)
#pragma unroll
                    for (int n = 0; n < 2; ++n) { const size_t off = (size_t)row * D_MODEL + col0 + bj * HALF + n * 16;
                        const f32x4 v = *(const f32x4*)(x + off) + acc[ai][bj][m][n];
                        s += (v[0] * v[0] + v[1] * v[1]) + (v[2] * v[2] + v[3] * v[3]);
                        v2u w; w.x = cvt_pk_bf16(v[0], v[1]); w.y = cvt_pk_bf16(v[2], v[3]); *(v2u*)(X1B + off) = w; }
                s += shx(s, 16, fq * 16 + fr); s += shx(s, 32, fq * 16 + fr);
                if (fq == 0) fx_add(sqx + row, s); }
    }
};
struct EpiPQ {
    static constexpr bool PERM = true;
    bf16_t* QP; const u64* sqx;
    __device__ __forceinline__ void operator()(const f32x4 (&acc)[2][2][4][2], const Unit& u, int wr, int wc, int fr, int fq) const {
        const int cw = u.pn * 256 + wc * 32 + 8 * fq;
#pragma unroll
        for (int ai = 0; ai < 2; ++ai)
#pragma unroll
            for (int m = 0; m < 4; ++m) { const int row = EPI_ROWS(ai, m);
                const float r2 = __builtin_amdgcn_rsqf(fx_get(sqx + row) * (1.f / D_MODEL) + EPS);
#pragma unroll
                for (int bj = 0; bj < 2; ++bj) { const f32x4 v0 = acc[ai][bj][m][0] * r2, v1 = acc[ai][bj][m][1] * r2;
                    v4u w; w.x = cvt_pk_bf16(v0[0], v0[1]); w.y = cvt_pk_bf16(v0[2], v0[3]); w.z = cvt_pk_bf16(v1[0], v1[1]); w.w = cvt_pk_bf16(v1[2], v1[3]);
                    __builtin_nontemporal_store(w, (v4u*)(QP + (size_t)row * D_MODEL + cw + bj * HALF)); } }
    }
};
#undef EPI_ROWS
}

typedef GAS unsigned gu32;
#define RLX_AGENT __ATOMIC_RELAXED, __HIP_MEMORY_SCOPE_AGENT
#define XB_TMO      128
#define XB_XCNT(j)  (256  + 64 * (j))
#define XB_XSUB(j)  (1280 + 64 * (j))
#define XB_XGEN(j)  (2304 + 64 * (j))
#define XB_TOP      3328
#define XB_TOPGEN   3392
#define XCD_BAR_WORDS 3456
#define XB_SPIN_CAP (1u << 18)
__device__ __forceinline__ unsigned xb_ld(unsigned* p)              { return __hip_atomic_load(p, __ATOMIC_RELAXED, __HIP_MEMORY_SCOPE_AGENT); }
__device__ __forceinline__ unsigned xb_add(unsigned* p, unsigned v) { return __hip_atomic_fetch_add(p, v, __ATOMIC_RELAXED, __HIP_MEMORY_SCOPE_AGENT); }
__device__ __forceinline__ unsigned xb_xcc_id() { return (unsigned)__builtin_amdgcn_s_getreg((3 << 11) | 20) & 0xFu; }
#define XB_SPIN(cond, bar) do { unsigned _sp = 0; while (cond) { __builtin_amdgcn_s_sleep(1); \
    if ((++_sp & 255u) == 0u) { if (xb_ld(&(bar)[XB_TMO])) break; if (_sp > XB_SPIN_CAP) { atomicAdd(&(bar)[XB_TMO], 1u); break; } } } } while (0)
struct XcdBarrier { unsigned* bar; unsigned x; volatile LAS unsigned* st; int wave; };
__device__ __forceinline__ XcdBarrier xcd_barrier_post(unsigned* bar, volatile LAS unsigned* st, int wave) {
    XcdBarrier b; b.bar = bar; b.x = xb_xcc_id(); b.st = st; b.wave = wave;
    if (wave == 0 && lane_id() == 0) (void)xb_add(&bar[XB_XCNT(b.x)], 1u);
    return b;
}
__device__ __forceinline__ void xcd_barrier_complete(unsigned* bar, unsigned x, unsigned& nloc, unsigned& nx) {
    const unsigned G = gridDim.x * gridDim.y * gridDim.z;
    unsigned sum, cnt, mine, sp = 0u;
    for (;;) {
        sum = 0u; cnt = 0u; mine = 0u;
#pragma unroll
        for (unsigned j = 0; j < 16; ++j) { const unsigned c = xb_ld(&bar[XB_XCNT(j)]); sum += c; cnt += (c > 0u) ? 1u : 0u; mine = (j == x) ? c : mine; }
        if (sum == G) break;
        __builtin_amdgcn_s_sleep(1);
        if ((++sp & 255u) == 0u) { if (xb_ld(&bar[XB_TMO])) break; if (sp > XB_SPIN_CAP) { atomicAdd(&bar[XB_TMO], 1u); break; } }
    }
    nloc = mine > 0u ? mine : 1u; nx = cnt > 0u ? cnt : 1u;
}
__device__ __forceinline__ void xcd_barrier(const XcdBarrier& b) {
    asm volatile("s_waitcnt vmcnt(0)" ::: "memory");
    __syncthreads();
    if (b.wave == 0 && lane_id() == 0) {
        unsigned* bar = b.bar;
        __builtin_amdgcn_s_waitcnt(0);
        unsigned nloc = b.st[0], nx = b.st[1];
        if (nloc == 0u) { xcd_barrier_complete(bar, b.x, nloc, nx); b.st[0] = nloc; b.st[1] = nx; }
        const unsigned old = xb_add(&bar[XB_XSUB(b.x)], 1u);
        const unsigned gen = old / nloc;
        if (old + 1u == (gen + 1u) * nloc) {
            __builtin_amdgcn_fence(__ATOMIC_RELEASE, "agent");
            asm volatile("s_waitcnt vmcnt(0)" ::: "memory");
            const unsigned og = xb_add(&bar[XB_TOP], 1u);
            const unsigned tg = og / nx;
            if (og + 1u == (tg + 1u) * nx) xb_add(&bar[XB_TOPGEN], 1u);
            else XB_SPIN(xb_ld(&bar[XB_TOPGEN]) == tg, bar);
            __builtin_amdgcn_fence(__ATOMIC_ACQUIRE, "agent");
            xb_add(&bar[XB_XGEN(b.x)], 1u);
            asm volatile("s_waitcnt vmcnt(0)" ::: "memory");
        } else {
            XB_SPIN(xb_ld(&bar[XB_XGEN(b.x)]) == gen, bar);
            __builtin_amdgcn_fence(__ATOMIC_ACQUIRE, "agent");
            asm volatile("s_waitcnt vmcnt(0)" ::: "memory");
        }
    }
    __syncthreads();
}

struct Args { const float* in[20]; float* out; unsigned char* ws; };
struct Frame {
    LAS unsigned char* lds; int tid, lane, wave, vcu, G;
};

__device__ __forceinline__ int colmap(int mode, int r) {
    if (mode == 0) return r;
    if (mode == 1) return 3136 + r;
    if (mode == 3) { if (r < 4096) { const int k = r >> 8, j = r & 255; return j < 128 ? 1088 + 128 * k + j : 7232 + 128 * k + (j - 128); } if (r < 6144) return 5184 + (r - 4096); if (r < 7168) return r - 6144;
        if (r < 7232) { const int j = r - 7168; return 1024 + (j >> 1) + 32 * (j & 1); } if (r < 7424) return -1; return 3136 + (r - 7424); }
    const int h = r / DQK, d = r - h * DQK; if (d < DN) return r; const int j = d - DN; return h * DQK + DN + (j >> 1) + 32 * (j & 1);
}
template <bool F8 = false>
__device__ __forceinline__ void p0_transpose_item(const float* W, int K, int N, bf16* WT, int ndst, int mode, const float* kscale, LAS float* scr, int item, int lane) {
    const int nblk = ndst / 32, kb = item / nblk, nb = item % nblk, k0 = 64 * kb, n0 = 32 * nb;
    const int src = colmap(mode, n0 + (lane & 31));
    const int s0 = colmap(mode, n0), s31 = colmap(mode, n0 + 31);
    if (s0 >= 0 && s31 == s0 + 31 && (s0 & 3) == 0) {
        const int kr = lane >> 3, n4 = lane & 7; f32x4 v[8];
#pragma unroll
        for (int i = 0; i < 8; ++i) v[i] = *(const f32x4*)(W + (size_t)(k0 + 8 * i + kr) * N + s0 + 4 * n4);
#pragma unroll
        for (int i = 0; i < 8; ++i) { const float ks = kscale ? kscale[k0 + 8 * i + kr] : 1.f; LAS float* d = scr + (8 * i + kr) * 33 + 4 * n4;
            d[0] = v[i][0] * ks; d[1] = v[i][1] * ks; d[2] = v[i][2] * ks; d[3] = v[i][3] * ks; }
    } else {
#pragma unroll 8
    for (int i = 0; i < 32; ++i) { const int kk = 2 * i + (lane >> 5); float v = 0.f;
        if (src >= 0) { v = W[(size_t)(k0 + kk) * N + src]; if (kscale) v *= kscale[k0 + kk]; }
        scr[kk * 33 + (lane & 31)] = v; }
    }
    LDS_WAIT(); asm volatile("" ::: "memory");
    const int c = lane & 7;
#pragma unroll
    for (int j = 0; j < 4; ++j) { const int n = (lane >> 3) + 8 * j; const LAS float* s = scr + (8 * c) * 33 + n;
        if constexpr (F8) { float t[8];
#pragma unroll
            for (int e = 0; e < 8; ++e) t[e] = fminf(fmaxf(s[e * 33] * WIN8_SCALE, -448.f), 448.f);
            int w0 = 0, w1 = 0; w0 = __builtin_amdgcn_cvt_pk_fp8_f32(t[0], t[1], w0, false); w0 = __builtin_amdgcn_cvt_pk_fp8_f32(t[2], t[3], w0, true); w1 = __builtin_amdgcn_cvt_pk_fp8_f32(t[4], t[5], w1, false); w1 = __builtin_amdgcn_cvt_pk_fp8_f32(t[6], t[7], w1, true);
            v2u o; o.x = (unsigned)w0; o.y = (unsigned)w1; *(v2u*)((unsigned char*)WT + (size_t)(n0 + n) * K + k0 + 8 * c) = o; continue; }
        v4u o; o.x = cvt_pk_bf16(s[0 * 33], s[1 * 33]); o.y = cvt_pk_bf16(s[2 * 33], s[3 * 33]); o.z = cvt_pk_bf16(s[4 * 33], s[5 * 33]); o.w = cvt_pk_bf16(s[6 * 33], s[7 * 33]);
        *(v4u*)(WT + (size_t)(n0 + n) * K + k0 + 8 * c) = o; }
    LDS_WAIT(); asm volatile("" ::: "memory");
}

__device__ __forceinline__ void sgu_unit(const Frame& F, int unit, const bf16* VG, bf16* U, const bf16* WSP, const float* lng, const float* lnb, const float* bsp, const u64* ssum, const u64* ssq) {
    const int chunk = unit >> 3, g = unit & 7, row0 = chunk * 128, c0 = g * 256;
    const int tid = F.tid, lane = F.lane, w = F.wave, fr = lane & 15, fq = lane >> 4;
    LAS unsigned* vt = (LAS unsigned*)F.lds;
    LAS float* st = (LAS float*)(F.lds + 256 * 272);
    if (tid < 128) { const float mean = fx_get(ssum + row0 + tid) * (1.f / D_MODEL), ex2 = fx_get(ssq + row0 + tid) * (1.f / D_MODEL);
        const float var = fmaxf(ex2 - mean * mean, 0.f); st[2 * tid] = mean; st[2 * tid + 1] = __builtin_amdgcn_rsqf(var + EPS); }
    __syncthreads();
#pragma unroll 1
    for (int q = 0; q < 4; ++q) {
        const int wi = w + 8 * q, c8 = lane & 7, rlo = lane >> 3, s2 = 8 * (wi & 7) + rlo, cg = 8 * (wi >> 3) + c8;
        const bf16* p = VG + (size_t)(row0 + 2 * s2) * D_MODEL + c0 + 8 * cg;
        const v4u a = *(const v4u*)p, b = *(const v4u*)(p + D_MODEL);
        const f32x4 g0 = *(const f32x4*)(lng + c0 + 8 * cg), g1 = *(const f32x4*)(lng + c0 + 8 * cg + 4), b0 = *(const f32x4*)(lnb + c0 + 8 * cg), b1 = *(const f32x4*)(lnb + c0 + 8 * cg + 4);
        const float m0 = st[4 * s2], r0 = st[4 * s2 + 1], m1 = st[4 * s2 + 2], r1 = st[4 * s2 + 3];
        const unsigned aw[4] = {a.x, a.y, a.z, a.w}, bw[4] = {b.x, b.y, b.z, b.w};
        const int pd = s2 ^ (c8 << 3);
#pragma unroll
        for (int j = 0; j < 8; ++j) { const float ga = j < 4 ? g0[j & 3] : g1[j & 3], be = j < 4 ? b0[j & 3] : b1[j & 3];
            const float x0 = (j & 1) ? bf_hi(aw[j >> 1]) : bf_lo(aw[j >> 1]), x1 = (j & 1) ? bf_hi(bw[j >> 1]) : bf_lo(bw[j >> 1]);
            vt[(8 * cg + j) * 68 + pd] = cvt_pk_bf16((x0 - m0) * r0 * ga + be, (x1 - m1) * r1 * ga + be); }
    }
    __syncthreads();
    f32x4 acc[2][8];
#pragma unroll
    for (int rt = 0; rt < 2; ++rt)
#pragma unroll
        for (int tt = 0; tt < 8; ++tt) acc[rt][tt] = (f32x4){0.f, 0.f, 0.f, 0.f};
    const bf16* wg = WSP + (size_t)g * 128 * 128;
#pragma unroll
    for (int kk = 0; kk < 4; ++kk) {
        bf16x8 af[2];
#pragma unroll
        for (int rt = 0; rt < 2; ++rt) { const int ch = 32 * w + 16 * rt + fr; const int d = 16 * kk + 4 * fq, pd = d ^ (((ch >> 3) & 7) << 3);
            af[rt] = *(const LAS bf16x8*)((const LAS unsigned char*)vt + ch * 272 + pd * 4); }
#pragma unroll
        for (int tt = 0; tt < 8; ++tt) { if (tt >= 2 * kk) {
            const bf16x8 bfr = *(const bf16x8*)(wg + (size_t)(16 * tt + fr) * 128 + 32 * kk + 8 * fq);
#pragma unroll
            for (int rt = 0; rt < 2; ++rt) acc[rt][tt] = __builtin_amdgcn_mfma_f32_16x16x32_bf16(af[rt], bfr, acc[rt][tt], 0, 0, 0); } }
    }
#pragma unroll
    for (int tt = 0; tt < 8; ++tt) { const int t = 16 * tt + fr; const float bs = bsp[g * 128 + t];
#pragma unroll
        for (int rt = 0; rt < 2; ++rt) { const size_t off = (size_t)(row0 + t) * D_MODEL + c0 + 32 * w + 16 * rt + 4 * fq;
            const v2u uu = *(const v2u*)(U + off);
            const f32x4 a = acc[rt][tt];
            v2u o; o.x = cvt_pk_bf16(bf_lo(uu.x) * (a[0] + bs), bf_hi(uu.x) * (a[1] + bs));
            o.y = cvt_pk_bf16(bf_lo(uu.y) * (a[2] + bs), bf_hi(uu.y) * (a[3] + bs));
            *(v2u*)(U + off) = o; } }
    __syncthreads();
}

namespace att {
constexpr int KT = 64 * 192, VT = 128 * 64;
constexpr int L_K = 0, L_V = 4 * KT, L_WS = 4 * KT + 4 * VT;
#define KSWZ(row, ch) ((row) * 192 + ((((ch) ^ (((row) >> 2) & 3))) << 4))
__device__ __forceinline__ int v_st(int k, int c) { const int kk = (k & ~0xC) | ((k & 4) << 1) | ((k & 8) >> 1); return ((kk >> 3) * 4 + (c >> 5)) * 512 + ((kk & 7) * 32 + (c & 31)) * 2; }
__device__ __forceinline__ int v_rd_base(int lane) { return ((lane & 3) << 3) | (((lane >> 2) & 3) << 6) | (((lane >> 4) & 1) << 5) | (((lane >> 5) & 1) << 8); }
constexpr int v_rd_off(int d0, int ks, int half) { return d0 * 512 + ks * 4096 + half * 2048; }
__device__ __forceinline__ int crow(int r, int hi) { return (r & 3) + 8 * (r >> 2) + 4 * hi; }
__device__ __forceinline__ void mask_tile(f32x16& p0, f32x16& p1, int dq) {
    const float NEG = -__builtin_inff();
#pragma unroll
    for (int r = 0; r < 16; ++r) { const int c = (r & 3) + 8 * (r >> 2); if (dq - c < 0) p0[r] = NEG; if (dq - c - 32 < 0) p1[r] = NEG; }
}
constexpr float THR = 8.f;
__device__ __forceinline__ void softmax_tile(f32x16& p0, f32x16& p1, float& m_reg, float& alpha, v8i& pk, bool first) {
    float pmax;
    { float a4[4];
#pragma unroll
      for (int c = 0; c < 4; ++c) { a4[c] = fmaxf(fmaxf(p0[4 * c], p0[4 * c + 1]), p0[4 * c + 2]); a4[c] = fmaxf(fmaxf(a4[c], p0[4 * c + 3]), p1[4 * c]);
          a4[c] = fmaxf(fmaxf(a4[c], p1[4 * c + 1]), p1[4 * c + 2]); a4[c] = fmaxf(a4[c], p1[4 * c + 3]); }
      pmax = fmaxf(fmaxf(a4[0], a4[1]), fmaxf(a4[2], a4[3])); }
    { auto rr = __builtin_amdgcn_permlane32_swap(__float_as_uint(pmax), __float_as_uint(pmax), false, false); pmax = fmaxf(__uint_as_float(rr[0]), __uint_as_float(rr[1])); }
    if (__builtin_expect(__all(pmax - m_reg <= THR) && !first, 1)) { alpha = 1.f; }
    else { float delta = first ? pmax - m_reg : fmaxf(pmax - m_reg, 0.f); if (!(delta > -1e30f)) delta = 0.f;
        alpha = first ? 1.f : __builtin_amdgcn_exp2f(-delta); m_reg += delta; }
#pragma unroll
    for (int r = 0; r < 16; ++r) { p0[r] = __builtin_amdgcn_exp2f(p0[r] - m_reg); p1[r] = __builtin_amdgcn_exp2f(p1[r] - m_reg); }
#pragma unroll
    for (int w = 0; w < 4; ++w) { int d0 = 0, d1 = 0; d0 = __builtin_amdgcn_cvt_pk_fp8_f32(p0[4 * w], p0[4 * w + 1], d0, false); d0 = __builtin_amdgcn_cvt_pk_fp8_f32(p0[4 * w + 2], p0[4 * w + 3], d0, true);
        d1 = __builtin_amdgcn_cvt_pk_fp8_f32(p1[4 * w], p1[4 * w + 1], d1, false); d1 = __builtin_amdgcn_cvt_pk_fp8_f32(p1[4 * w + 2], p1[4 * w + 3], d1, true); pk[w] = d0; pk[4 + w] = d1; }
}
template <int KB>
__device__ __forceinline__ void qkt(f32x16& p0, f32x16& p1, const char* K_lds, int r32, int hi, const v8i* qr) {
    p0 = f32x16{}; p1 = f32x16{};
    const char* k0 = K_lds + KB * KT + KSWZ(r32, 2 * hi); const char* k1 = K_lds + KB * KT + KSWZ(r32, 2 * hi + 1);
#pragma unroll
    for (int ks = 0; ks < 3; ++ks) {
        const v4u a0 = *reinterpret_cast<const v4u*>(k0 + ks * 64), a1 = *reinterpret_cast<const v4u*>(k1 + ks * 64);
        const v4u b0 = *reinterpret_cast<const v4u*>(k0 + ks * 64 + 32 * 192), b1 = *reinterpret_cast<const v4u*>(k1 + ks * 64 + 32 * 192);
        const v8i ka = {(int)a0.x, (int)a0.y, (int)a0.z, (int)a0.w, (int)a1.x, (int)a1.y, (int)a1.z, (int)a1.w};
        const v8i kb = {(int)b0.x, (int)b0.y, (int)b0.z, (int)b0.w, (int)b1.x, (int)b1.y, (int)b1.z, (int)b1.w};
        p0 = __builtin_amdgcn_mfma_scale_f32_32x32x64_f8f6f4(ka, qr[ks], p0, 0, 0, 0, 0x7c7c7c7c, 0, 0x79797979);
        p1 = __builtin_amdgcn_mfma_scale_f32_32x32x64_f8f6f4(kb, qr[ks], p1, 0, 0, 0, 0x7c7c7c7c, 0, 0x79797979); }
}
template <int VB>
__device__ __forceinline__ void pv_tile(f32x16* o, f32x16& lacc, const char* V_lds, int r32, int hi, v8i pk) {
    const int sw = (r32 >> 2) & 3;
    const char* v0 = V_lds + VB * VT + r32 * 64 + (((2 * hi) ^ sw) << 4); const char* v1 = V_lds + VB * VT + r32 * 64 + (((2 * hi + 1) ^ sw) << 4);
#pragma unroll
    for (int d0 = 0; d0 < 4; ++d0) { const v4u a = *reinterpret_cast<const v4u*>(v0 + d0 * 2048), b = *reinterpret_cast<const v4u*>(v1 + d0 * 2048);
        const v8i vb = {(int)a.x, (int)a.y, (int)a.z, (int)a.w, (int)b.x, (int)b.y, (int)b.z, (int)b.w};
        o[d0] = __builtin_amdgcn_mfma_scale_f32_32x32x64_f8f6f4(pk, vb, o[d0], 0, 0, 0, 0x7f7f7f7f, 0, 0x7c7c7c7c); if (d0 == 1) SBAR(); }
    { int c1 = 0x38383838; asm volatile("" : "+v"(c1)); const v8i ones = {c1, c1, c1, c1, c1, c1, c1, c1};
      lacc = __builtin_amdgcn_mfma_scale_f32_32x32x64_f8f6f4(pk, ones, lacc, 0, 0, 0, 0x7f7f7f7f, 0, 0x7f7f7f7f); }
}
__device__ __forceinline__ void attn_unit(int bh, int qb, const unsigned char* Q, const unsigned char* K, const unsigned char* KRp, const unsigned char* V, const bf16* GA, bf16* MG, char* lds, LAS unsigned char* lds3, const int wave0) {
    int tid = wave0 * 64 + lane_id(); asm volatile("" : "+v"(tid));
    const int wid = __builtin_amdgcn_readfirstlane(tid >> 6), lane = tid & 63, r32 = lane & 31, hi = lane >> 5;
    const int q0 = qb * 256, qlo = q0 + wid * 32, qm = qlo + r32 - 4 * hi;
    const unsigned char* Qw = Q + ((size_t)bh * SEQL + qlo + r32) * DQK;
    const unsigned char* Kh = K + (size_t)bh * SEQL * DN; const unsigned char* KRh = KRp + (size_t)(bh >> 4) * SEQL * DR; const unsigned char* Vh = V + (size_t)bh * SEQL * DVH;
    char* V_lds = lds + L_V; char* K_lds = lds + L_K;
    float* ws = (float*)(lds + L_WS) + wid * 64; float* li_l = ws, * al_l = ws + 32;
    v8i qr[3];
#pragma unroll
    for (int ks = 0; ks < 3; ++ks) { const v4u a = *reinterpret_cast<const v4u*>(Qw + ks * 64 + hi * 32), b = *reinterpret_cast<const v4u*>(Qw + ks * 64 + hi * 32 + 16);
        qr[ks] = (v8i){(int)a.x, (int)a.y, (int)a.z, (int)a.w, (int)b.x, (int)b.y, (int)b.z, (int)b.w}; }
    const int NT = 4 * (qb + 1);
    unsigned ksp[2], kst[2], vso;
#pragma unroll
    for (int i = 0; i < 2; ++i) { const int o = i * 8192 + tid * 16, row = (o / 192) & 63, pos = (o - (o / 192) * 192) >> 4, ch = pos ^ ((row >> 2) & 3);
        if (ch < 8) { ksp[i] = (unsigned)(Kh - Vh) + (unsigned)(row * DN + ch * 16); kst[i] = 64 * DN; } else { ksp[i] = (unsigned)(KRh - Vh) + (unsigned)(row * DR + (ch - 8) * 16); kst[i] = 64 * DR; } }
    { const int j = tid >> 2, c = (tid & 3) ^ ((j >> 2) & 3); vso = (unsigned)(j * SEQL + c * 16); }
    float m_reg = 0.f; f32x16 lacc = {}; f32x16 o[4] = {};
    const unsigned ldw = (unsigned)wid * 1024u;
#define SOFF(x) ({ unsigned o_ = (x); asm volatile("" : "+v"(o_)); (const unsigned*)((const char*)Vh + o_); })
#define SDMA(t, bf) do { \
        __builtin_amdgcn_global_load_lds(SOFF(ksp[0] + (unsigned)(t) * kst[0]), (LAS unsigned*)(lds3 + L_K + (bf) * KT + ldw), 16, 0, 0); \
        if (wid < 4) __builtin_amdgcn_global_load_lds(SOFF(ksp[1] + (unsigned)(t) * kst[1]), (LAS unsigned*)(lds3 + L_K + (bf) * KT + 8192 + ldw), 16, 0, 0); \
        __builtin_amdgcn_global_load_lds(SOFF(vso + (unsigned)(t) * 64u), (LAS unsigned*)(lds3 + L_V + (bf) * VT + ldw), 16, 0, 0); } while (0)
#define TILE(t, BF) do { f32x16 p0, p1; float alpha; v8i pk; \
        __builtin_amdgcn_s_setprio(1); qkt<BF>(p0, p1, K_lds, r32, hi, qr); __builtin_amdgcn_s_setprio(0); \
        { const int kb_ = (t) * 64; if (kb_ + 63 > qlo) mask_tile(p0, p1, qm - kb_); } \
        softmax_tile(p0, p1, m_reg, alpha, pk, (t) == 0); \
        if (__any(alpha < 1.f)) { if (hi == 0) al_l[r32] = alpha; asm volatile("s_waitcnt lgkmcnt(0)" ::: "memory"); \
            _Pragma("unroll") for (int r = 0; r < 16; ++r) { const float a_ = al_l[crow(r, hi)]; lacc[r] *= a_; _Pragma("unroll") for (int d_ = 0; d_ < 4; ++d_) o[d_][r] *= a_; } } \
        __builtin_amdgcn_s_setprio(1); pv_tile<BF>(o, lacc, V_lds, r32, hi, pk); __builtin_amdgcn_s_setprio(0); SBAR(); } while (0)
    SDMA(0, 0); SDMA(1, 1); VM_WAIT(); __syncthreads();
    for (int t = 0; t < NT; t += 4) {
        SDMA(t + 2, 2); SDMA(t + 3, 3); SBAR();
        TILE(t, 0); TILE(t + 1, 1);
        VM_WAIT(); __syncthreads();
        if (t + 4 < NT) { SDMA(t + 4, 0); SDMA(t + 5, 1); } SBAR();
        TILE(t + 2, 2); TILE(t + 3, 3);
        VM_WAIT(); __syncthreads(); }
#undef TILE
#undef SDMA
#undef SOFF
    float* stg = (float*)lds + wid * 4096;
    float rli[16];
#pragma unroll
    for (int r = 0; r < 16; ++r) rli[r] = __builtin_amdgcn_rcpf(lacc[r]);
    const int le = lane_id(), r32e = le & 31, hie = le >> 5;
#pragma unroll
    for (int r = 0; r < 16; ++r) { const int orow = crow(r, hie);
#pragma unroll
        for (int d0 = 0; d0 < 4; ++d0) stg[orow * 128 + d0 * 32 + r32e] = o[d0][r] * rli[r]; }
    asm volatile("s_waitcnt lgkmcnt(0)" ::: "memory");
    const int b = bh >> 4, h = bh & 15;
#pragma unroll 4
    for (int it = 0; it < 16; ++it) { const int row = 2 * it + hie, c4 = r32e * 4;
        const f32x4 ov = *(const f32x4*)(stg + row * 128 + c4);
        const size_t off = ((size_t)b * SEQL + qlo + row) * D_MODEL + h * DVH + c4;
        const v2u ga = *(const v2u*)(GA + off), ob = *(const v2u*)(MG + off);
        v2u w; w.x = cvt_pk_bf16(bf_lo(ga.x) * ov[0] + bf_lo(ob.x), bf_hi(ga.x) * ov[1] + bf_hi(ob.x)); w.y = cvt_pk_bf16(bf_lo(ga.y) * ov[2] + bf_lo(ob.y), bf_hi(ga.y) * ov[3] + bf_hi(ob.y));
        *(v2u*)(MG + off) = w; }
    __syncthreads();
}
#undef KSWZ
}

__device__ __forceinline__ void ce_desc(float& a, float& b) { const float hi = fmaxf(a, b), lo = fminf(a, b); a = hi; b = lo; }
template <int N> __device__ __forceinline__ void bitonic_sort_desc(float (&v)[N]) {
#pragma unroll
    for (int k = 2; k <= N; k <<= 1)
#pragma unroll
        for (int j = k >> 1; j > 0; j >>= 1)
#pragma unroll
            for (int i = 0; i < N; ++i) { const int l = i ^ j; if (l > i) { if ((i & k) == 0) ce_desc(v[i], v[l]); else ce_desc(v[l], v[i]); } }
}
template <int N> __device__ __forceinline__ void bitonic_merge_desc(float (&v)[N]) {
#pragma unroll
    for (int j = N >> 1; j > 0; j >>= 1)
#pragma unroll
        for (int i = 0; i < N; ++i) { const int l = i ^ j; if (l > i) ce_desc(v[i], v[l]); }
}
__device__ __forceinline__ void merge_top16(float (&a)[16], const float (&b)[16]) {
#pragma unroll
    for (int i = 0; i < 16; ++i) a[i] = fmaxf(a[i], b[15 - i]);
    bitonic_merge_desc<16>(a);
}
__device__ __forceinline__ void topk_unit(const Frame& F, int tg, int h, const bf16* QP, int* TOPI, float* TOPG) {
    const int lane = F.lane, fr = lane & 15, fq = lane >> 4;
    const int t0 = tg * 16;
    LAS float* sl = (LAS float*)(F.lds + 65536) + F.wave * 512;
    float s01[2][16];
#pragma unroll
    for (int p = 0; p < 2; ++p) {
        f32x4 acc[8];
#pragma unroll
        for (int mt = 0; mt < 8; ++mt) acc[mt] = (f32x4){0.f, 0.f, 0.f, 0.f};
        const bf16* qp = QP + (size_t)(t0 + fr) * D_MODEL + h * 256 + p * 128 + 8 * fq;
        const LAS unsigned char* kp = F.lds + p * 32768 + fr * 256;
#pragma unroll
        for (int kk = 0; kk < 4; ++kk) { const bf16x8 bq = *(const bf16x8*)(qp + 32 * kk);
#pragma unroll
            for (int mt = 0; mt < 8; ++mt) { const bf16x8 ak = *(const LAS bf16x8*)(kp + mt * 4096 + (((4 * kk + fq) ^ fr) << 4));
                acc[mt] = __builtin_amdgcn_mfma_f32_16x16x32_bf16(ak, bq, acc[mt], 0, 0, 0); } }
        float a[16], b[16];
#pragma unroll
        for (int mt = 0; mt < 8; ++mt)
#pragma unroll
            for (int e = 0; e < 4; ++e) { const unsigned n = (unsigned)(16 * mt + 4 * fq + e); const float pk = __uint_as_float((__float_as_uint(acc[mt][e]) & ~0x7Fu) | n);
                if (mt < 4) a[mt * 4 + e] = pk; else b[(mt - 4) * 4 + e] = pk; }
        bitonic_sort_desc<16>(a); bitonic_sort_desc<16>(b); merge_top16(a, b);
#pragma unroll
        for (int i = 0; i < 16; ++i) b[i] = shx(a[i], 16, F.lane);
        merge_top16(a, b);
#pragma unroll
        for (int i = 0; i < 16; ++i) b[i] = shx(a[i], 32, F.lane);
        merge_top16(a, b);
#pragma unroll
        for (int i = 0; i < 16; ++i) s01[p][i] = a[i];
    }
    if (fq == 0) {
#pragma unroll
        for (int p = 0; p < 2; ++p)
#pragma unroll
            for (int i = 0; i < 16; ++i) sl[fr * 32 + p * 16 + i] = s01[p][i];
    }
    float c[4][16];
#pragma unroll
    for (int gidx = 0; gidx < 4; ++gidx)
#pragma unroll
        for (int i = 0; i < 16; ++i) c[gidx][i] = -3.0e38f;
#define CAND(n, i, j) do { const float v_ = __uint_as_float(__float_as_uint(s01[0][i]) & ~0x7Fu) + __uint_as_float(__float_as_uint(s01[1][j]) & ~0x7Fu); \
        c[(n) >> 4][(n) & 15] = __uint_as_float((__float_as_uint(v_) & ~0xFFu) | (unsigned)((i) * 16 + (j))); } while (0)
    CAND(0, 0, 0); CAND(1, 0, 1); CAND(2, 0, 2); CAND(3, 0, 3); CAND(4, 0, 4); CAND(5, 0, 5); CAND(6, 0, 6); CAND(7, 0, 7);
    CAND(8, 0, 8); CAND(9, 0, 9); CAND(10, 0, 10); CAND(11, 0, 11); CAND(12, 0, 12); CAND(13, 0, 13); CAND(14, 0, 14); CAND(15, 0, 15);
    CAND(16, 1, 0); CAND(17, 1, 1); CAND(18, 1, 2); CAND(19, 1, 3); CAND(20, 1, 4); CAND(21, 1, 5); CAND(22, 1, 6); CAND(23, 1, 7);
    CAND(24, 2, 0); CAND(25, 2, 1); CAND(26, 2, 2); CAND(27, 2, 3); CAND(28, 2, 4);
    CAND(29, 3, 0); CAND(30, 3, 1); CAND(31, 3, 2); CAND(32, 3, 3);
    CAND(33, 4, 0); CAND(34, 4, 1); CAND(35, 4, 2);
    CAND(36, 5, 0); CAND(37, 5, 1); CAND(38, 6, 0); CAND(39, 6, 1); CAND(40, 7, 0); CAND(41, 7, 1);
    CAND(42, 8, 0); CAND(43, 9, 0); CAND(44, 10, 0); CAND(45, 11, 0); CAND(46, 12, 0); CAND(47, 13, 0); CAND(48, 14, 0); CAND(49, 15, 0);
#undef CAND
    bitonic_sort_desc<16>(c[0]); bitonic_sort_desc<16>(c[1]); bitonic_sort_desc<16>(c[2]); bitonic_sort_desc<16>(c[3]);
    merge_top16(c[0], c[1]); merge_top16(c[2], c[3]); merge_top16(c[0], c[2]);
    LDS_WAIT(); asm volatile("" ::: "memory");
    float sc[16]; int ix[16]; float mx = -3.0e38f;
#pragma unroll
    for (int w = 0; w < 16; ++w) { const unsigned id = __float_as_uint(c[0][w]) & 0xFFu; const unsigned u0 = __float_as_uint(sl[fr * 32 + (id >> 4)]), u1 = __float_as_uint(sl[fr * 32 + 16 + (id & 15)]);
        sc[w] = __uint_as_float(u0 & ~0x7Fu) + __uint_as_float(u1 & ~0x7Fu); ix[w] = (int)((u0 & 0x7Fu) * NKEYS + (u1 & 0x7Fu)); mx = fmaxf(mx, sc[w]); }
    float sum = 0.f;
#pragma unroll
    for (int w = 0; w < 16; ++w) { sc[w] = __builtin_amdgcn_exp2f((sc[w] - mx) * 1.4426950409f); sum += sc[w]; }
    const float rs = __builtin_amdgcn_rcpf(sum);
    if (fq == 0) { int* ti = TOPI + (size_t)(t0 + fr) * 128 + h * 16; float* tgp = TOPG + (size_t)(t0 + fr) * 128 + h * 16;
#pragma unroll
        for (int w = 0; w < 16; ++w) { ti[w] = ix[w]; tgp[w] = sc[w] * rs; } }
    LDS_WAIT(); asm volatile("" ::: "memory");
}

typedef float f32x2 __attribute__((ext_vector_type(2)));
struct PeerIdx { int i0, i1; float a0, a1; };
struct PeerRow { v4u x; float xs; };
__device__ __forceinline__ void pu_gather(int t, int sl, int lane, const PeerIdx& I, v4u (&wu)[16], PeerRow& R, const unsigned char* XQ, const float* XS, const unsigned char* PU8) {
    const int r = lane & 7, g = lane >> 3;
    const unsigned char* sb = PU8 + (size_t)sl * NEXP * 128;
#pragma unroll
    for (int k = 0; k < 16; ++k) { const int e = __shfl(k < 8 ? I.i0 : I.i1, (8 * k + g) & 63); unsigned o_ = (unsigned)(e * 128 + 16 * r); asm volatile("" : "+v"(o_)); wu[k] = *(const v4u*)(sb + o_); }
    R.x = __builtin_nontemporal_load((const v4u*)(XQ + (size_t)t * D_MODEL + 128 * sl + 16 * r)); R.xs = XS[(size_t)t * 16 + sl];
}
__device__ __forceinline__ void pu_compute(int t, int sl, int lane, const v4u (&wu)[16], const PeerRow& R, bf16* PART) {
    const int r = lane & 7, g = lane >> 3;
    float d[16];
#pragma unroll
    for (int k = 0; k < 16; ++k) { int a_ = __builtin_amdgcn_sdot4((int)wu[k].x, (int)R.x.x, 0, false); a_ = __builtin_amdgcn_sdot4((int)wu[k].y, (int)R.x.y, a_, false);
        a_ = __builtin_amdgcn_sdot4((int)wu[k].z, (int)R.x.z, a_, false); a_ = __builtin_amdgcn_sdot4((int)wu[k].w, (int)R.x.w, a_, false); d[k] = (float)a_; }
    const bool b0 = lane & 1, b1 = lane & 2, b2 = lane & 4;
    float res[2];
#pragma unroll
    for (int hf = 0; hf < 2; ++hf) { float e1[4], f1[2];
#pragma unroll
        for (int m = 0; m < 4; ++m) e1[m] = (b0 ? d[8 * hf + 2 * m + 1] : d[8 * hf + 2 * m]) + shx(b0 ? d[8 * hf + 2 * m] : d[8 * hf + 2 * m + 1], 1, lane);
#pragma unroll
        for (int n = 0; n < 2; ++n) f1[n] = (b1 ? e1[2 * n + 1] : e1[2 * n]) + shx(b1 ? e1[2 * n] : e1[2 * n + 1], 2, lane);
        res[hf] = (b2 ? f1[1] : f1[0]) + shx(b2 ? f1[0] : f1[1], 4, lane); }
    *(unsigned*)(PART + ((size_t)t * 16 + sl) * 128 + 16 * r + 2 * g) = cvt_pk_bf16(res[0] * R.xs, res[1] * R.xs);
}
__device__ __forceinline__ void peer_fin_token(int t, int lane, const bf16* PART, const int* TOPI, float* TOPG, const float* USC, const float* VSC, const u64* sqx) {
    const float r2 = __builtin_amdgcn_rsqf(fx_get(sqx + t) * (1.f / D_MODEL) + EPS);
    float s0 = 0.f, s1 = 0.f;
#pragma unroll
    for (int sl = 0; sl < 16; ++sl) { const unsigned w = __builtin_nontemporal_load((const unsigned*)(PART + ((size_t)t * 16 + sl) * 128 + 16 * (lane >> 3) + 2 * (lane & 7))); s0 += bf_lo(w); s1 += bf_hi(w); }
    const int e0 = TOPI[(size_t)t * 128 + lane], e1 = TOPI[(size_t)t * 128 + 64 + lane];
    float* gp = TOPG + (size_t)t * 128;
    gp[lane] = gelu_t(s0 * USC[e0] * r2) * gp[lane] * VSC[e0]; gp[64 + lane] = gelu_t(s1 * USC[e1] * r2) * gp[64 + lane] * VSC[e1];
}
__device__ __forceinline__ void pv_gather(int t, int sl, int lane, const PeerIdx& I, v4u (&wv)[16], float (&xv)[2], const bf16* X, const unsigned char* PV8) {
    const int r = lane & 7, g = lane >> 3;
    const unsigned char* sb = PV8 + (size_t)sl * NEXP * 128;
#pragma unroll
    for (int k = 0; k < 16; ++k) { const int e = __shfl(k < 8 ? I.i0 : I.i1, (8 * k + g) & 63); unsigned o_ = (unsigned)(e * 128 + 16 * r); asm volatile("" : "+v"(o_)); wv[k] = *(const v4u*)(sb + o_); }
    const int cb = 16 * r + ((lane & 8) ? 8 : 0) + ((lane & 16) ? 4 : 0) + ((lane & 32) ? 2 : 0);
    const unsigned xw = *(const unsigned*)(X + (size_t)t * D_MODEL + 128 * sl + cb); xv[0] = bf_lo(xw); xv[1] = bf_hi(xw);
}
__device__ __forceinline__ void pv_compute(int t, int sl, int lane, const PeerIdx& I, const v4u (&wv)[16], const float (&xv)[2], bf16* X, u64* ssq2) {
    const int r = lane & 7, g = lane >> 3;
    float oa[16];
    { f32x2 o2[8]; float ak[16];
#pragma unroll
      for (int e = 0; e < 8; ++e) o2[e] = (f32x2){0.f, 0.f};
#pragma unroll
      for (int k = 0; k < 16; ++k) ak[k] = __shfl(k < 8 ? I.a0 : I.a1, (8 * k + g) & 63);
#pragma unroll
      for (int k = 0; k < 16; ++k) { const f32x2 a2 = {ak[k], ak[k]};
#pragma unroll
          for (int q = 0; q < 4; ++q) { const int w_ = (int)(q == 0 ? wv[k].x : q == 1 ? wv[k].y : q == 2 ? wv[k].z : wv[k].w);
              o2[2 * q] += __builtin_amdgcn_cvt_pk_f32_fp8(w_, false) * a2; o2[2 * q + 1] += __builtin_amdgcn_cvt_pk_f32_fp8(w_, true) * a2; } }
#pragma unroll
      for (int e = 0; e < 8; ++e) { oa[2 * e] = o2[e][0]; oa[2 * e + 1] = o2[e][1]; } }
    const bool c0 = lane & 8, c1 = lane & 16, c2 = lane & 32;
    float p1[8], p2[4], p3[2];
#pragma unroll
    for (int m = 0; m < 8; ++m) p1[m] = (c0 ? oa[m + 8] : oa[m]) + shx(c0 ? oa[m] : oa[m + 8], 8, lane);
#pragma unroll
    for (int n = 0; n < 4; ++n) p2[n] = (c1 ? p1[n + 4] : p1[n]) + shx(c1 ? p1[n] : p1[n + 4], 16, lane);
#pragma unroll
    for (int q = 0; q < 2; ++q) p3[q] = (c2 ? p2[q + 2] : p2[q]) + shx(c2 ? p2[q] : p2[q + 2], 32, lane);
    const int cb = 16 * r + (c0 ? 8 : 0) + (c1 ? 4 : 0) + (c2 ? 2 : 0);
    const float y0 = xv[0] + p3[0], y1 = xv[1] + p3[1];
    *(unsigned*)(X + (size_t)t * D_MODEL + 128 * sl + cb) = cvt_pk_bf16(y0, y1);
    const float ss = wave_sum(y0 * y0 + y1 * y1, lane);
    if (lane == 0) fx_add(ssq2 + t, ss);
}
__device__ __forceinline__ void row8_load(f32x4 (&v)[8], const float* src, int lane) {
    const f32x4* xr = (const f32x4*)src + lane;
#pragma unroll
    for (int j = 0; j < 8; ++j) v[j] = __builtin_nontemporal_load(xr + 64 * j);
}
__device__ __forceinline__ unsigned pack_i8x4(f32x4 v) {
    int i[4];
#pragma unroll
    for (int e = 0; e < 4; ++e) i[e] = (int)__builtin_rintf(__builtin_amdgcn_fmed3f(v[e], -127.f, 127.f));
    const unsigned lo = __builtin_amdgcn_perm((unsigned)i[1], (unsigned)i[0], 0x0c0c0400u), hi = __builtin_amdgcn_perm((unsigned)i[3], (unsigned)i[2], 0x0c0c0400u);
    return __builtin_amdgcn_perm(hi, lo, 0x05040100u); }
template <bool I8>
__device__ __forceinline__ void row_to_fp8(f32x4 (&v)[8], unsigned char* tab, int e, float* inv_scale, int lane, const f32x4* colmul) {
    float am = 0.f;
#pragma unroll
    for (int j = 0; j < 8; ++j) { if (colmul) v[j] = v[j] * colmul[j];
        am = fmaxf(am, fmaxf(fmaxf(fabsf(v[j][0]), fabsf(v[j][1])), fmaxf(fabsf(v[j][2]), fabsf(v[j][3])))); }
#pragma unroll
    for (int o = 1; o < 64; o <<= 1) am = fmaxf(am, shx(am, o, lane));
    am = fmaxf(am, 1e-30f); const float sc = (I8 ? 127.f : 256.f) / am;
#pragma unroll
    for (int j = 0; j < 8; ++j) { int w = 0; if constexpr (I8) w = (int)pack_i8x4(v[j] * sc); else { w = __builtin_amdgcn_cvt_pk_fp8_f32(v[j][0] * sc, v[j][1] * sc, w, false); w = __builtin_amdgcn_cvt_pk_fp8_f32(v[j][2] * sc, v[j][3] * sc, w, true); } const int dw = lane + 64 * j; unsigned o_ = (unsigned)(dw >> 5) * (unsigned)(NEXP * 128) + (unsigned)(dw & 31) * 4u; asm volatile("" : "+v"(o_)); *(unsigned*)(tab + (size_t)e * 128 + o_) = (unsigned)w; }
    if (lane == 0) *inv_scale = am * (I8 ? 1.f / 127.f : 1.f / 256.f);
}

__global__ void __launch_bounds__(512, 2) mk_fwd(Args args) {
    extern __shared__ __attribute__((aligned(16))) unsigned char lds[];
    Frame F;
    F.lds = (LAS unsigned char*)lds;
    F.wave = __builtin_amdgcn_readfirstlane((int)threadIdx.x >> 6); F.lane = lane_id(); F.tid = F.wave * 64 + F.lane;
    F.G = gridDim.x; { const int bx = blockIdx.x; F.vcu = (F.G % 8 == 0) ? (bx % 8) * (F.G / 8) + bx / 8 : bx; }
    unsigned char* ws = args.ws;
    gu32* ctl = (gu32*)(ws + WS_CTL);
    volatile LAS unsigned* MISC = (volatile LAS unsigned*)(F.lds + MISC_OFF);
    for (int u = F.tid; u < (LDS_BYTES - LDSCTL_OFF) / 4; u += 512) ((LAS unsigned*)(F.lds + LDSCTL_OFF))[u] = 0u;
    __syncthreads();
    XcdBarrier bar; bar.bar = (unsigned*)(ctl + CW_BAR); bar.x = 0; bar.st = nullptr;
    bar = xcd_barrier_post((unsigned*)(ctl + CW_BAR), MISC + 8, F.wave);
#define GRID_BAR() xcd_barrier(bar)
#define PHASE_BEGIN() do { F.lane = lane_id(); asm volatile("" : "+v"(F.lane)); F.tid = F.wave * 64 + F.lane; } while (0)
    const float* x = args.in[0]; const int* positions = (const int*)args.in[1]; const float* g_norm1 = args.in[2]; const float* w_in = args.in[3];
    const float* g_q_a = args.in[4]; const float* w_uq = args.in[5]; const float* g_kv_a = args.in[6]; const float* w_ukv = args.in[7];
    const float* sgu_ln_g = args.in[8]; const float* sgu_ln_b = args.in[9]; const float* w_spatial = args.in[10]; const float* b_spatial = args.in[11];
    const float* b_gate = args.in[12]; const float* w_out = args.in[13]; const float* g_norm2 = args.in[14]; const float* w_peer_q = args.in[15];
    const float* peer_keys = args.in[16]; const float* peer_u = args.in[17]; const float* peer_v = args.in[18]; const float* g_final = args.in[19];
    float* out = args.out;
    bf16* KEYS = (bf16*)(ws + WS_KEYS); bf16* WSP = (bf16*)(ws + WS_WSP); bf16* WUQ = (bf16*)(ws + WS_WUQ); bf16* WUKV = (bf16*)(ws + WS_WUKV);
    bf16* WOUT = (bf16*)(ws + WS_WOUT); bf16* WPQ = (bf16*)(ws + WS_WPQ); float* ROPE = (float*)(ws + WS_ROPE);
    unsigned char* XN8 = ws + WS_XN8; unsigned char* WIN8 = ws + WS_WIN8; unsigned char* CQKV = ws + WS_CQKV; bf16* U = (bf16*)(ws + WS_U); bf16* VG = (bf16*)(ws + WS_VG);
    unsigned char* Vb = ws + WS_V; unsigned char* Kb = ws + WS_K; unsigned char* KR = ws + WS_KR; unsigned char* Qb = ws + WS_Q; bf16* GA = (bf16*)(ws + WS_GA); bf16* X2 = (bf16*)(ws + WS_X2);
    bf16* X1B = (bf16*)(ws + WS_X1B); unsigned char* PU = ws + WS_PU; unsigned char* PV = ws + WS_PV; float* USC = (float*)(ws + WS_PSC); float* VSC = USC + NEXP; bf16* PART = (bf16*)(ws + WS_PART); bf16* QP = (bf16*)(ws + WS_QP);
    int* TOPI = (int*)(ws + WS_TOPI); float* TOPG = (float*)(ws + WS_TOPG); unsigned char* X1Q = ws + WS_X1Q; float* XS = (float*)(ws + WS_XS);
    u64* SQQ = (u64*)(ws + CTL_STATS); u64* SQKV = SQQ + MTOK; u64* SSUM = SQKV + MTOK; u64* SSQ = SSUM + MTOK; u64* SQX1 = SSQ + MTOK;
    const int gw = F.vcu * 8 + F.wave, NGW = F.G * 8;

    {
        LAS float* scr = (LAS float*)(F.lds + RING_OFF + F.wave * 16384);
        constexpr int I_IN8 = (D_MODEL / 64) * (IN8_ROWS / 32), I_UQ = (QL / 64) * (NQ_COLS / 32), I_UKV = (QL / 64) * (NKV_COLS / 32), I_O = (D_MODEL / 64) * (D_MODEL / 32);
        constexpr int NITEMS = I_IN8 + I_UQ + I_UKV + 2 * I_O;
        for (int it = gw; it < NITEMS; it += NGW) {
            int r = it;
            if (r < I_IN8) { p0_transpose_item<true>(w_in, D_MODEL, IN_COLS, (bf16*)WIN8, IN8_ROWS, 3, nullptr, scr, r, F.lane); continue; } r -= I_IN8;
            if (r < I_UQ) { p0_transpose_item<true>(w_uq, QL, NQ_COLS, WUQ, NQ_COLS, 2, g_q_a, scr, r, F.lane); continue; } r -= I_UQ;
            if (r < I_UKV) { p0_transpose_item<true>(w_ukv, QL, NKV_COLS, WUKV, NKV_COLS, 0, g_kv_a, scr, r, F.lane); continue; } r -= I_UKV;
            if (r < I_O) { p0_transpose_item(w_out, D_MODEL, D_MODEL, WOUT, D_MODEL, 0, nullptr, scr, r, F.lane); continue; } r -= I_O;
            p0_transpose_item(w_peer_q, D_MODEL, D_MODEL, WPQ, D_MODEL, 0, g_norm2, scr, r, F.lane);
        }
        {
#define XN_LOAD(v, m_) do { const f32x4* xr_ = (const f32x4*)(x + (size_t)(m_) * D_MODEL) + F.lane; _Pragma("unroll") for (int j = 0; j < 8; ++j) v[j] = __builtin_nontemporal_load(xr_ + 64 * j); } while (0)
#define XN_DO(v, m_) do { float s_ = 0.f; _Pragma("unroll") for (int j = 0; j < 8; ++j) s_ += (v[j][0] * v[j][0] + v[j][1] * v[j][1]) + (v[j][2] * v[j][2] + v[j][3] * v[j][3]); \
            const float r_ = __builtin_amdgcn_rsqf(wave_sum(s_, F.lane) * (1.f / D_MODEL) + EPS); \
            _Pragma("unroll") for (int j = 0; j < 8; ++j) { const f32x4 h_ = v[j] * r_ * gn[j]; \
                const f32x4 h8_ = __builtin_elementwise_min(__builtin_elementwise_max(h_ * XN8_SCALE, (f32x4){-448.f, -448.f, -448.f, -448.f}), (f32x4){448.f, 448.f, 448.f, 448.f}); \
                int p_ = 0; p_ = __builtin_amdgcn_cvt_pk_fp8_f32(h8_[0], h8_[1], p_, false); p_ = __builtin_amdgcn_cvt_pk_fp8_f32(h8_[2], h8_[3], p_, true); ((unsigned*)(XN8 + (size_t)(m_) * D_MODEL))[F.lane + 64 * j] = (unsigned)p_; } } while (0)
            f32x4 gn[8];
#pragma unroll
            for (int j = 0; j < 8; ++j) gn[j] = *((const f32x4*)g_norm1 + F.lane + 64 * j);
            f32x4 va[8], vb[8]; int m = gw; if (m < MTOK) XN_LOAD(va, m);
#pragma unroll 1
            for (; m < MTOK; m += 2 * NGW) {
                if (m + NGW < MTOK) XN_LOAD(vb, m + NGW);
                XN_DO(va, m);
                if (m + NGW < MTOK) { if (m + 2 * NGW < MTOK) XN_LOAD(va, m + 2 * NGW); XN_DO(vb, m + NGW); } }
#undef XN_LOAD
#undef XN_DO
        }
        for (int it = gw; it < MTOK / 2; it += NGW) { const int row = 2 * it + (F.lane >> 5), i = F.lane & 31;
            const float freq = exp2f(-(float)i * (13.287712379549449f / 32.f)); const float ang = (float)positions[row] * freq;
            const double ad = (double)ang; const double k = __builtin_rint(ad * 0.15915494309189535); const float red = (float)(ad - k * 6.283185307179586);
            ROPE[(size_t)row * 32 + i] = __cosf(red); ROPE[(size_t)MTOK * 32 + (size_t)row * 32 + i] = __sinf(red); }
        for (int it = gw; it < (PHEADS * 2 * NKEYS * KD) / 512; it += NGW) { const size_t e = (size_t)it * 512 + 8 * F.lane; const f32x4 a = *(const f32x4*)(peer_keys + e), b = *(const f32x4*)(peer_keys + e + 4);
            v4u w; w.x = cvt_pk_bf16(a[0], a[1]); w.y = cvt_pk_bf16(a[2], a[3]); w.z = cvt_pk_bf16(b[0], b[1]); w.w = cvt_pk_bf16(b[2], b[3]); *(v4u*)(KEYS + e) = w; }
        for (int it = gw; it < (8 * 128 * 128) / 512; it += NGW) { const size_t e = (size_t)it * 512 + 8 * F.lane; const int t = (int)((e >> 7) & 127), s0 = (int)(e & 127);
            const f32x4 a = *(const f32x4*)(w_spatial + e), b = *(const f32x4*)(w_spatial + e + 4); float v[8] = {a[0], a[1], a[2], a[3], b[0], b[1], b[2], b[3]};
#pragma unroll
            for (int j = 0; j < 8; ++j) if (s0 + j > t) v[j] = 0.f;
            v4u w; w.x = cvt_pk_bf16(v[0], v[1]); w.y = cvt_pk_bf16(v[2], v[3]); w.z = cvt_pk_bf16(v[4], v[5]); w.w = cvt_pk_bf16(v[6], v[7]); *(v4u*)(WSP + e) = w; }
        for (size_t it = (size_t)gw * 64 + F.lane; it < (size_t)5 * MTOK; it += (size_t)NGW * 64) SQQ[it] = 0ull;
        GRID_BAR();
    }
    {
        PHASE_BEGIN();
        pg8::EpiIn E{0, IN8_DESCALE, U, GA, VG, CQKV, KR, b_gate, ROPE, SQQ, SQKV, SSUM, SSQ};
        { pg8::Gemm g{(const bf16*)XN8, (const bf16*)WIN8, MTOK, IN8_ROWS, D_MODEL / 2, D_MODEL / 2}; pg8::StaticOrder S; S.init(MTOK, IN8_ROWS, F.G, (int)blockIdx.x);
          pg8::gemm_phase<pg8::EpiIn, pg8::StaticOrder, true, true, true>(F.lds + RING_OFF, g, S, E, F.wave); }
        GRID_BAR();
    }
    {
        PHASE_BEGIN();
        { pg8::Gemm g{(const bf16*)CQKV, WUQ, MTOK, NQ_COLS, QL / 2, 512}; pg8::StaticOrder S; S.init(MTOK, NQ_COLS, F.G, (int)blockIdx.x);
          pg8::EpiQ E{Qb, SQQ, ROPE}; pg8::gemm_phase<pg8::EpiQ, pg8::StaticOrder, true, true, true>(F.lds + RING_OFF, g, S, E, F.wave); }
        { pg8::Gemm g{(const bf16*)(CQKV + QL), WUKV, MTOK, NKV_COLS, QL / 2, 512}; pg8::StaticOrder S; S.init(MTOK, NKV_COLS, F.G, (int)blockIdx.x);
          pg8::EpiKV E{Kb, Vb, SQKV}; pg8::gemm_phase<pg8::EpiKV, pg8::StaticOrder, true, true, true, true>(F.lds + RING_OFF, g, S, E, F.wave); }
        PHASE_BEGIN();
        for (int un = F.vcu; un < (MTOK / 128) * 8; un += F.G) sgu_unit(F, un, VG, U, WSP, sgu_ln_g, sgu_ln_b, b_spatial, SSUM, SSQ);
        GRID_BAR();
    }
    {
        PHASE_BEGIN();
        if (F.G == 256) { const int s = F.vcu & 7, bh = F.vcu >> 3;
#pragma unroll 1
            for (int i = 0; i < 4; ++i) { const int qb = (i == 0) ? s : (i == 1) ? 15 - s : (i == 2) ? 16 + s : 31 - s; att::attn_unit(bh, qb, Qb, Kb, KR, Vb, GA, U, (char*)lds + RING_OFF, F.lds + RING_OFF, F.wave); }
        } else {
#pragma unroll 1
            for (int un = F.vcu; un < 1024; un += F.G) att::attn_unit(un >> 5, 31 - (un & 31), Qb, Kb, KR, Vb, GA, U, (char*)lds + RING_OFF, F.lds + RING_OFF, F.wave);
        }
        GRID_BAR();
    }
    {
        PHASE_BEGIN();
        for (int it = gw * 64 + F.lane; it < MTOK; it += NGW * 64) SQQ[it] = 0ull;
        { f32x4 va[8], vb[8];
#define CONV_ROWS(SRC, TAB, SC, I8_, CM) do { int e = gw; if (e < NEXP) row8_load(va, SRC + (size_t)e * D_MODEL, F.lane); \
          _Pragma("unroll 1") for (; e < NEXP; e += 2 * NGW) { \
              if (e + NGW < NEXP) row8_load(vb, SRC + (size_t)(e + NGW) * D_MODEL, F.lane); \
              row_to_fp8<I8_>(va, TAB, e, SC + e, F.lane, CM); \
              if (e + NGW < NEXP) { if (e + 2 * NGW < NEXP) row8_load(va, SRC + (size_t)(e + 2 * NGW) * D_MODEL, F.lane); row_to_fp8<I8_>(vb, TAB, e + NGW, SC + e + NGW, F.lane, CM); } } } while (0)
          f32x4 gn2[8];
#pragma unroll
          for (int j = 0; j < 8; ++j) gn2[j] = *((const f32x4*)g_norm2 + F.lane + 64 * j);
          CONV_ROWS(peer_u, PU, USC, true, gn2);
          CONV_ROWS(peer_v, PV, VSC, false, (const f32x4*)nullptr);
#undef CONV_ROWS
        }
        VM_WAIT(); __syncthreads();
        pg8::Gemm g{U, WOUT, MTOK, D_MODEL, D_MODEL, D_MODEL}; pg8::StaticOrder S; S.init(MTOK, D_MODEL, F.G, (int)blockIdx.x);
        pg8::EpiOut E{x, X1B, SQX1}; pg8::gemm_phase<pg8::EpiOut, pg8::StaticOrder, true, true>(F.lds + RING_OFF, g, S, E, F.wave);
        GRID_BAR();
    }
    {
        PHASE_BEGIN();
        pg8::Gemm g{X1B, WPQ, MTOK, D_MODEL, D_MODEL, D_MODEL}; pg8::StaticOrder S; S.init(MTOK, D_MODEL, F.G, (int)blockIdx.x);
        pg8::EpiPQ E{QP, SQX1}; pg8::gemm_phase<pg8::EpiPQ, pg8::StaticOrder, true, true>(F.lds + RING_OFF, g, S, E, F.wave);
        GRID_BAR();
    }
    {
        PHASE_BEGIN();
#pragma unroll 1
        for (int t = gw; t < MTOK; t += NGW) { const bf16* xp = X1B + (size_t)t * D_MODEL + 32 * F.lane; v4u xw[4];
#pragma unroll
            for (int j = 0; j < 4; ++j) xw[j] = *(const v4u*)(xp + 8 * j);
            float xf[32]; float am = 0.f;
#pragma unroll
            for (int j = 0; j < 4; ++j) { const unsigned w4[4] = {xw[j].x, xw[j].y, xw[j].z, xw[j].w};
#pragma unroll
                for (int q = 0; q < 4; ++q) { xf[8 * j + 2 * q] = bf_lo(w4[q]); xf[8 * j + 2 * q + 1] = bf_hi(w4[q]); am = fmaxf(am, fmaxf(fabsf(xf[8 * j + 2 * q]), fabsf(xf[8 * j + 2 * q + 1]))); } }
            am = fmaxf(am, shx(am, 1, F.lane)); am = fmaxf(am, shx(am, 2, F.lane)); am = fmaxf(am, 1e-30f);
            const float sc = 127.f / am; v4u q0, q1;
            q0.x = pack_i8x4((f32x4){xf[0], xf[1], xf[2], xf[3]} * sc); q0.y = pack_i8x4((f32x4){xf[4], xf[5], xf[6], xf[7]} * sc); q0.z = pack_i8x4((f32x4){xf[8], xf[9], xf[10], xf[11]} * sc); q0.w = pack_i8x4((f32x4){xf[12], xf[13], xf[14], xf[15]} * sc);
            q1.x = pack_i8x4((f32x4){xf[16], xf[17], xf[18], xf[19]} * sc); q1.y = pack_i8x4((f32x4){xf[20], xf[21], xf[22], xf[23]} * sc); q1.z = pack_i8x4((f32x4){xf[24], xf[25], xf[26], xf[27]} * sc); q1.w = pack_i8x4((f32x4){xf[28], xf[29], xf[30], xf[31]} * sc);
            unsigned char* qp = X1Q + (size_t)t * D_MODEL + 32 * F.lane; *(v4u*)qp = q0; *(v4u*)(qp + 16) = q1;
            if ((F.lane & 3) == 0) XS[(size_t)t * 16 + (F.lane >> 2)] = am * (1.f / 127.f); }
        { const int NH8 = (F.G % 8 == 0) ? 8 : 1, grp = (int)blockIdx.x % NH8, bi = (int)blockIdx.x / NH8, nbl = F.G / NH8;
#pragma unroll 1
          for (int h = grp; h < PHEADS; h += NH8) {
#pragma unroll
              for (int it = 0; it < 8; ++it) { const int id = it * 512 + F.tid, c = id & 15, n = (id >> 4) & 127, pp = id >> 11;
                  const v4u w = *(const v4u*)(KEYS + ((size_t)(h * 2 + pp) * NKEYS + n) * KD + 8 * c);
                  *(LAS v4u*)(F.lds + pp * 32768 + n * 256 + ((c ^ (n & 15)) << 4)) = w; }
              __syncthreads();
#pragma unroll 1
              for (int tg = bi * 8 + F.wave; tg < MTOK / 16; tg += nbl * 8) topk_unit(F, tg, h, QP, TOPI, TOPG);
              __syncthreads(); } }
        GRID_BAR();
    }
    {
        PHASE_BEGIN();
        const int NG = (F.G % 8 == 0) ? 8 : 1, grp = (int)blockIdx.x % NG, li = (int)blockIdx.x / NG, nl = F.G / NG;
        const int t0 = li * 8 + F.wave, ts = nl * 8, NTW = (MTOK - t0 + ts - 1) / ts;
#define LOAD_IDX(I, n) do { const int t_ = t0 + (n) * ts; I.i0 = __builtin_nontemporal_load(TOPI + (size_t)t_ * 128 + F.lane); I.i1 = __builtin_nontemporal_load(TOPI + (size_t)t_ * 128 + 64 + F.lane); } while (0)
#pragma unroll 1
        for (int sl = grp; sl < 16; sl += NG) {
            PeerIdx IA, IB; PeerRow RA, RB; v4u wA[16], wB[16];
            LOAD_IDX(IA, 0); pu_gather(t0, sl, F.lane, IA, wA, RA, X1Q, XS, PU); if (NTW > 1) LOAD_IDX(IB, 1);
#pragma unroll 1
            for (int n = 0; n < NTW; n += 2) {
                if (n + 2 < NTW) LOAD_IDX(IA, n + 2);
                if (n + 1 < NTW) pu_gather(t0 + (n + 1) * ts, sl, F.lane, IB, wB, RB, X1Q, XS, PU);
                pu_compute(t0 + n * ts, sl, F.lane, wA, RA, PART);
                if (n + 1 < NTW) {
                    if (n + 3 < NTW) LOAD_IDX(IB, n + 3);
                    if (n + 2 < NTW) pu_gather(t0 + (n + 2) * ts, sl, F.lane, IA, wA, RA, X1Q, XS, PU);
                    pu_compute(t0 + (n + 1) * ts, sl, F.lane, wB, RB, PART); }
            } }
#undef LOAD_IDX
        GRID_BAR();
#pragma unroll 1
        for (int t = gw; t < MTOK; t += NGW) peer_fin_token(t, F.lane, PART, TOPI, TOPG, USC, VSC, SQX1);
        GRID_BAR();
#define LOAD_IDXA(I, n) do { const int t_ = t0 + (n) * ts; I.i0 = __builtin_nontemporal_load(TOPI + (size_t)t_ * 128 + F.lane); I.i1 = __builtin_nontemporal_load(TOPI + (size_t)t_ * 128 + 64 + F.lane); \
            I.a0 = __builtin_nontemporal_load(TOPG + (size_t)t_ * 128 + F.lane); I.a1 = __builtin_nontemporal_load(TOPG + (size_t)t_ * 128 + 64 + F.lane); } while (0)
#pragma unroll 1
        for (int sl = grp; sl < 16; sl += NG) {
            PeerIdx IA, IB, IC; float xA[2], xB[2]; v4u wA[16], wB[16];
            LOAD_IDXA(IA, 0); pv_gather(t0, sl, F.lane, IA, wA, xA, X1B, PV); if (NTW > 1) LOAD_IDXA(IB, 1);
#pragma unroll 1
            for (int n = 0; n < NTW; n += 2) {
                if (n + 2 < NTW) LOAD_IDXA(IC, n + 2);
                if (n + 1 < NTW) pv_gather(t0 + (n + 1) * ts, sl, F.lane, IB, wB, xB, X1B, PV);
                pv_compute(t0 + n * ts, sl, F.lane, IA, wA, xA, X2, SQQ);
                IA = IC;
                if (n + 1 < NTW) {
                    if (n + 3 < NTW) LOAD_IDXA(IC, n + 3);
                    if (n + 2 < NTW) pv_gather(t0 + (n + 2) * ts, sl, F.lane, IA, wA, xA, X1B, PV);
                    pv_compute(t0 + (n + 1) * ts, sl, F.lane, IB, wB, xB, X2, SQQ);
                    IB = IC; }
            } }
#undef LOAD_IDXA
        GRID_BAR();
#pragma unroll 1
        for (int t = gw; t < MTOK; t += NGW) { const float rf = __builtin_amdgcn_rsqf(fx_get(SQQ + t) * (1.f / D_MODEL) + EPS);
            const v2u* xr = (const v2u*)(X2 + (size_t)t * D_MODEL) + F.lane; f32x4* orow = (f32x4*)(out + (size_t)t * D_MODEL) + F.lane;
#pragma unroll
            for (int j = 0; j < 8; ++j) { const v2u xw = __builtin_nontemporal_load(xr + 64 * j); const f32x4 v = {bf_lo(xw.x), bf_hi(xw.x), bf_lo(xw.y), bf_hi(xw.y)}, gg = *((const f32x4*)g_final + F.lane + 64 * j); f32x4 o4;
#pragma unroll
                for (int e = 0; e < 4; ++e) o4[e] = v[e] * rf * gg[e];
                __builtin_nontemporal_store(o4, orow + 64 * j); } }
    }
#undef GRID_BAR
}

extern "C" void kernel_launch(void* const* d_in, const int* in_sizes, int n_in, void* d_out, int out_size, void* d_ws, size_t ws_size, hipStream_t stream) {
    static int grid = 0;
    if (grid == 0) {
        if (n_in != 20 || in_sizes[0] != MTOK * D_MODEL || out_size != MTOK * D_MODEL || ws_size < WS_END) {
            fprintf(stderr, "kernel_launch: unexpected shapes (n_in %d, in0 %d, out %d, ws %zu); nothing launched\n", n_in, n_in > 0 ? in_sizes[0] : -1, out_size, ws_size); grid = -1; return; }
        int dev = 0, cus = 0;
        if (hipGetDevice(&dev) != hipSuccess || hipDeviceGetAttribute(&cus, hipDeviceAttributeMultiprocessorCount, dev) != hipSuccess) { fprintf(stderr, "kernel_launch: device query failed\n"); grid = -1; return; }
        if (hipFuncSetAttribute((const void*)mk_fwd, hipFuncAttributeMaxDynamicSharedMemorySize, LDS_BYTES) != hipSuccess) { fprintf(stderr, "kernel_launch: hipFuncSetAttribute failed\n"); grid = -1; return; }
        (void)hipGetLastError();
        grid = cus;
    }
    if (grid < 0) return;
    (void)hipMemsetAsync((char*)d_ws + WS_CTL, 0, CTL_ZERO_BYTES, stream);
    Args a{};
    for (int i = 0; i < 20; ++i) a.in[i] = (const float*)d_in[i];
    a.out = (float*)d_out; a.ws = (unsigned char*)d_ws;
    hipLaunchKernelGGL(mk_fwd, dim3(grid), dim3(512), LDS_BYTES, stream, a);
    const hipError_t le = hipPeekAtLastError();
    if (le != hipSuccess) fprintf(stderr, "kernel_launch: launch failed: %s\n", hipGetErrorName(le));
}
```

```cpp
#include <hip/hip_runtime.h>
#include <hip/hip_bf16.h>
#include <cstdio>
#include <cstdint>


constexpr int D_MODEL = 2048, NB = 2, SEQL = 8192, MTOK = NB * SEQL;
constexpr int NHEAD = 16, QL = 512, DN = 128, DR = 64, DVH = 128, DQK = 192;
constexpr int IN_COLS = 9280, IN16_ROWS = 2048, IN8_ROWS = 9472;
constexpr float Q8_SCALE = 64.f, K8_SCALE = 8.f, V8_SCALE = 8.f;
constexpr float XN8_SCALE = 8.f, WIN8_SCALE = 64.f, IN8_DESCALE = 1.f / 512.f;
constexpr int NQ_COLS = NHEAD * DQK, NKV_COLS = NHEAD * (DN + DVH);
constexpr int PHEADS = 8, NKEYS = 128, TOPK = 16, KD = 128, NEXP = 16384;
constexpr float EPS = 1e-6f;
#define NTL(p) (*(p))
constexpr float FXS = 16777216.f, FXI = 1.f / 16777216.f;
constexpr float C2Q = 0.07216878364870322f * 1.4426950408889634f;

constexpr size_t MiB = 1u << 20;
constexpr size_t WS_CTL = 0, CTL_ZERO_BYTES = 32 * 1024;
constexpr size_t WS_KEYS = 1 * MiB, WS_WSP = 1 * MiB + 512 * 1024;
constexpr size_t WS_WUQ = 2 * MiB, WS_WUKV = 5 * MiB, WS_WOUT = 9 * MiB, WS_WPQ = 17 * MiB;
constexpr size_t WS_ROPE = 27 * MiB;
constexpr size_t WS_WIN8 = 46 * MiB;
constexpr size_t WS_XN8 = 66 * MiB;
constexpr size_t WS_Q = 32 * MiB;
constexpr size_t WS_CQKV = 128 * MiB;
constexpr size_t WS_U = 160 * MiB;
constexpr size_t WS_VG = 224 * MiB;
constexpr size_t WS_GA = 288 * MiB;
constexpr size_t WS_V = 352 * MiB;
constexpr size_t WS_K = 416 * MiB;
constexpr size_t WS_KR = 504 * MiB;
constexpr size_t WS_X2 = 288 * MiB;
constexpr size_t WS_X1B = 96 * MiB;
constexpr size_t WS_PU = 32 * MiB, WS_PV = 64 * MiB;
constexpr size_t WS_X1Q = 160 * MiB, WS_XS = 192 * MiB;
constexpr size_t WS_PART = 352 * MiB;
constexpr size_t WS_PSC = 31 * MiB;
constexpr size_t WS_QP = 224 * MiB;
constexpr size_t WS_TOPI = 480 * MiB, WS_TOPG = 488 * MiB;
constexpr size_t WS_END = 512 * MiB;
constexpr int CW_BAR = 4096;
constexpr size_t CTL_STATS = 128 * 1024;
constexpr int RING_OFF = 0, RING_BYTES = 131072;
constexpr int LDSCTL_OFF = RING_BYTES, MISC_OFF = LDSCTL_OFF + 320;
constexpr int LDS_BYTES = 147456;

#define GAS __attribute__((address_space(1)))
#define LAS __attribute__((address_space(3)))
typedef unsigned short bf16;
typedef unsigned v4u __attribute__((ext_vector_type(4)));
typedef unsigned v2u __attribute__((ext_vector_type(2)));
typedef float f32x4 __attribute__((ext_vector_type(4)));
typedef float f32x16 __attribute__((ext_vector_type(16)));
typedef short bf16x8 __attribute__((ext_vector_type(8)));
typedef short s16x4 __attribute__((ext_vector_type(4)));
typedef int v8i __attribute__((ext_vector_type(8)));
typedef unsigned long long u64;
#define LDS_WAIT() asm volatile("s_waitcnt lgkmcnt(0)" ::: "memory")
#define VM_WAIT() asm volatile("s_waitcnt vmcnt(0)" ::: "memory")
#define SBAR() __builtin_amdgcn_sched_barrier(0)

typedef float f32x2_t __attribute__((ext_vector_type(2))); typedef __bf16 bf16x2_t __attribute__((ext_vector_type(2)));
__device__ __forceinline__ unsigned cvt_pk_bf16(float lo, float hi) { f32x2_t v = {lo, hi}; bf16x2_t b = __builtin_convertvector(v, bf16x2_t); return __builtin_bit_cast(unsigned, b); }
__device__ __forceinline__ unsigned pack_fp8x4(f32x4 v) {
    v = __builtin_elementwise_min(__builtin_elementwise_max(v, (f32x4){-448.f, -448.f, -448.f, -448.f}), (f32x4){448.f, 448.f, 448.f, 448.f});
    int p = 0; p = __builtin_amdgcn_cvt_pk_fp8_f32(v[0], v[1], p, false); p = __builtin_amdgcn_cvt_pk_fp8_f32(v[2], v[3], p, true); return (unsigned)p; }
__device__ __forceinline__ float bf_lo(unsigned w) { return __uint_as_float(w << 16); }
__device__ __forceinline__ float bf_hi(unsigned w) { return __uint_as_float(w & 0xffff0000u); }
__device__ __forceinline__ float gelu_t(float x) { const float t = x * (1.f + 0.044715f * x * x); const float e = __builtin_amdgcn_exp2f(-2.3022081986f * t); return x * __builtin_amdgcn_rcpf(1.f + e); }
__device__ __forceinline__ float sigmoid_f(float y) { return __builtin_amdgcn_rcpf(1.f + __builtin_amdgcn_exp2f(-1.4426950409f * y)); }
__device__ __forceinline__ void fx_add(u64* p, float v) { const long long q = __float2ll_rn(v * FXS); atomicAdd(p, (u64)q); }
__device__ __forceinline__ float fx_get(const u64* p) { return (float)((double)(long long)(*p) * (double)FXI); }
__device__ __forceinline__ int lane_id() { int l; asm volatile("v_mbcnt_lo_u32_b32 %0, -1, 0\n\tv_mbcnt_hi_u32_b32 %0, -1, %0" : "=v"(l)); return l; }

__device__ __forceinline__ float shx(float v, int o, int lane) { return __builtin_bit_cast(float, __builtin_amdgcn_ds_bpermute((lane ^ o) << 2, __builtin_bit_cast(int, v))); }
__device__ __forceinline__ float wave_sum(float v, int lane) {
#pragma unroll
    for (int o = 1; o < 64; o <<= 1) v += shx(v, o, lane);
    return v;
}

namespace pg8 {
#define PG8_LAS __attribute__((address_space(3)))
typedef unsigned short bf16_t;
constexpr int BM = 256, BK = 64, HALF = 128, HTB = HALF * BK * 2, STAGE_BYTES = 8 * HTB, NXCD = 8, WGM = 8;
__host__ __device__ __forceinline__ int lds_byte(int r, int c) { const int st = (r >> 4) * 2 + (c >> 5), rr = r & 15, cc = c & 31, ob = rr * 64 + cc * 2; return st * 1024 + (ob ^ (((ob >> 9) & 1) << 5)); }
__host__ __device__ __forceinline__ void stage_rc(int b, int& R, int& C) { const int st = b / 1024, sb = b % 1024, swz = sb ^ (((sb >> 9) & 1) << 5); R = (st >> 1) * 16 + swz / 64; C = (st & 1) * 32 + (swz % 64) / 2; }
__host__ __device__ __forceinline__ int perm32(int rho) { const int n = rho >> 4, i = rho & 15; return 8 * (i >> 2) + 4 * n + (i & 3); }
struct Unit { int pm, pn; };
struct Gemm { const bf16_t* A; const bf16_t* Bt; int M, N, K, lda; };
struct StaticOrder {
    int nM, nN, nwg, G, c;
    __host__ __device__ void init(int M, int N, int G_, int c_) { nM = M / BM; nN = N / BM; nwg = nM * nN; G = G_; c = c_; }
    __host__ __device__ bool next(int i, Unit& u) const {
        const long L = (long)i * G + c; if (L >= nwg) return false;
        int wgid = (int)L; { const int q = nwg / NXCD, r = nwg % NXCD, xcd = wgid % NXCD, off = wgid / NXCD; wgid = (xcd < r ? xcd * (q + 1) : r * (q + 1) + (xcd - r) * q) + off; }
        const int nig = WGM * nN, gid = wgid / nig, fm = gid * WGM, gsz = (nM - fm) < WGM ? (nM - fm) : WGM;
        u.pm = fm + ((wgid % nig) % gsz); u.pn = (wgid % nig) / gsz; return true;
    }
};
template <class Epi, class Sched, bool ALIGN_EPI = false, bool SP2 = false, bool F8 = false, bool SWAP1 = false>
__device__ __forceinline__ void gemm_phase(PG8_LAS unsigned char* lds, const Gemm g, const Sched& S, const Epi& E, const int wave) {
    int tid = wave * 64 + lane_id(); asm volatile("" : "+v"(tid));
    const int wid = __builtin_amdgcn_readfirstlane(tid >> 6), lane = tid & 63, wr = wid >> 2, wc = wid & 3, fr = lane & 15, fq = lane >> 4;
    const int K = g.K, nt = K / BK, lda = g.lda;
    unsigned voffA[2], voffB[2];
#pragma unroll
    for (int i = 0; i < 2; ++i) { int R, C; stage_rc(tid * 16 + i * 8192, R, C); const int Rb = Epi::PERM ? ((R & ~31) + perm32(R & 31)) : R;
        voffA[i] = (unsigned)(R * lda + C) * 2u; voffB[i] = (unsigned)(Rb * K + C) * 2u; }
    const size_t kstep = (size_t)(BK * 2);
    const size_t hstepA = (size_t)HALF * lda * 2, hstepB = (size_t)HALF * K * 2;
    const size_t tstepA = 2 * hstepA, tstepB = 2 * hstepB;
    const unsigned ldsw = (unsigned)wid * 1024u;
    const int aoff = lds_byte(wr * 64 + fr, fq * 8), boff = lds_byte(wc * 32 + fr, fq * 8);
#define PG8_SA(b, h) (((b) * 2 + (h)) * HTB)
#define PG8_SB(b, h) ((4 + (b) * 2 + (h)) * HTB)
#define PG8_STAGE(bufoff, gbase, voff) do { _Pragma("unroll") for (int _i = 0; _i < 2; ++_i) \
        { unsigned vo_ = (voff)[_i]; asm volatile("" : "+v"(vo_)); __builtin_amdgcn_global_load_lds((const unsigned*)((const char*)(gbase) + vo_), (PG8_LAS unsigned*)(lds + (bufoff) + ldsw + _i * 8192), 16, 0, 0); } } while (0)
#define PG8_LDA(dst, b, h) do { _Pragma("unroll") for (int m = 0; m < 4; ++m) _Pragma("unroll") for (int k = 0; k < 2; ++k) dst[m][k] = *(const PG8_LAS bf16x8*)(lds + PG8_SA(b, h) + aoff + m * 2048 + k * 1024); } while (0)
#define PG8_LDB(dst, b, h) do { _Pragma("unroll") for (int n = 0; n < 2; ++n) _Pragma("unroll") for (int k = 0; k < 2; ++k) dst[n][k] = *(const PG8_LAS bf16x8*)(lds + PG8_SB(b, h) + boff + n * 2048 + k * 1024); } while (0)
#define PG8_CAT(x) __builtin_bit_cast(v8i, __builtin_shufflevector((x)[0], (x)[1], 0, 1, 2, 3, 4, 5, 6, 7, 8, 9, 10, 11, 12, 13, 14, 15))
#define PG8_MMA(ai, bj, At, Bt) do { __builtin_amdgcn_s_setprio(1); _Pragma("unroll") for (int m = 0; m < 4; ++m) _Pragma("unroll") for (int n = 0; n < 2; ++n) { \
        if constexpr (F8 && SWAP1 && (bj) == 1) acc[ai][bj][m][n] = __builtin_amdgcn_mfma_scale_f32_16x16x128_f8f6f4(PG8_CAT(At[m]), PG8_CAT(Bt[n]), acc[ai][bj][m][n], 0, 0, 0, 0x7f7f7f7f, 0, 0x7f7f7f7f); \
        else if constexpr (F8) acc[ai][bj][m][n] = __builtin_amdgcn_mfma_scale_f32_16x16x128_f8f6f4(PG8_CAT(Bt[n]), PG8_CAT(At[m]), acc[ai][bj][m][n], 0, 0, 0, 0x7f7f7f7f, 0, 0x7f7f7f7f); \
        else { _Pragma("unroll") for (int k = 0; k < 2; ++k) acc[ai][bj][m][n] = __builtin_amdgcn_mfma_f32_16x16x32_bf16(Bt[n][k], At[m][k], acc[ai][bj][m][n], 0, 0, 0); } } __builtin_amdgcn_s_setprio(0); } while (0)
#define PG8_WAIT_V(n) asm volatile("s_waitcnt vmcnt(" #n ")" ::: "memory")
#define PG8_WAIT_L(n) asm volatile("s_waitcnt lgkmcnt(" #n ")" ::: "memory")
#define PG8_BAR __builtin_amdgcn_s_barrier()
#define PG8_SCHED __builtin_amdgcn_sched_barrier(0)
    Unit cur, nxt; int ui = 0;
    if (!S.next(0, cur)) return;
    f32x4 acc[2][2][4][2];
#pragma unroll
    for (int a = 0; a < 2; ++a)
#pragma unroll
        for (int b = 0; b < 2; ++b)
#pragma unroll
            for (int m = 0; m < 4; ++m)
#pragma unroll
                for (int n = 0; n < 2; ++n) acc[a][b][m][n] = (f32x4){0.f, 0.f, 0.f, 0.f};
    bf16x8 At[4][2], B0[2][2], B1[2][2];
    const char* cA = (const char*)g.A + (size_t)cur.pm * tstepA; const char* cB = (const char*)g.Bt + (size_t)cur.pn * tstepB;
    if constexpr (SP2) {
        PG8_STAGE(PG8_SB(0, 0), cB, voffB); PG8_STAGE(PG8_SB(0, 1), cB + hstepB, voffB); PG8_STAGE(PG8_SA(0, 0), cA, voffA); PG8_STAGE(PG8_SA(0, 1), cA + hstepA, voffA);
        if (wr == 1) PG8_BAR;
        PG8_WAIT_V(2); PG8_BAR;
        PG8_STAGE(PG8_SB(1, 0), cB + kstep, voffB); PG8_STAGE(PG8_SA(1, 0), cA + kstep, voffA); PG8_STAGE(PG8_SB(1, 1), cB + hstepB + kstep, voffB);
        PG8_WAIT_V(6); PG8_BAR;
    } else {
        PG8_STAGE(PG8_SB(0, 0), cB, voffB); PG8_STAGE(PG8_SA(0, 0), cA, voffA); PG8_STAGE(PG8_SB(0, 1), cB + hstepB, voffB); PG8_STAGE(PG8_SA(0, 1), cA + hstepA, voffA);
        if (wr == 1) PG8_BAR;
        PG8_WAIT_V(4); PG8_BAR;
        PG8_STAGE(PG8_SB(1, 0), cB + kstep, voffB); PG8_STAGE(PG8_SA(1, 0), cA + kstep, voffA); PG8_STAGE(PG8_SB(1, 1), cB + hstepB + kstep, voffB);
        PG8_WAIT_V(6); PG8_BAR;
    }
    for (;;) {
        const bool has_next = S.next(ui + 1, nxt);
        const char* nA = has_next ? (const char*)g.A + (size_t)nxt.pm * tstepA : cA; const char* nB = has_next ? (const char*)g.Bt + (size_t)nxt.pn * tstepB : cB;
#pragma unroll 1
        for (int t = 0; t < nt; t += 2) {
            const bool last = (t == nt - 2);
            const char* a1 = cA + (size_t)(t + 1) * kstep;
            const char* a2 = last ? nA : cA + (size_t)(t + 2) * kstep; const char* b2 = last ? nB : cB + (size_t)(t + 2) * kstep;
            const char* a3 = a2 + kstep; const char* b3 = b2 + kstep;
            if constexpr (SP2) {
            PG8_LDB(B0, 0, 0); PG8_LDB(B1, 0, 1); PG8_SCHED; PG8_LDA(At, 0, 0); PG8_STAGE(PG8_SA(1, 1), a1 + hstepA, voffA);
            PG8_WAIT_V(8); PG8_WAIT_L(0); PG8_BAR; PG8_MMA(0, 0, At, B0); PG8_MMA(0, 1, At, B1); PG8_BAR; PG8_SCHED;
            PG8_LDA(At, 0, 1); PG8_STAGE(PG8_SB(0, 0), b2, voffB); PG8_STAGE(PG8_SB(0, 1), b2 + hstepB, voffB); PG8_STAGE(PG8_SA(0, 0), a2, voffA);
            PG8_WAIT_V(8); PG8_WAIT_L(0); PG8_BAR; PG8_MMA(1, 0, At, B0); PG8_MMA(1, 1, At, B1); PG8_BAR; PG8_SCHED;
            PG8_LDB(B0, 1, 0); PG8_LDB(B1, 1, 1); PG8_SCHED; PG8_LDA(At, 1, 0); PG8_STAGE(PG8_SA(0, 1), a2 + hstepA, voffA);
            PG8_WAIT_V(8); PG8_WAIT_L(0); PG8_BAR; PG8_MMA(0, 0, At, B0); PG8_MMA(0, 1, At, B1); PG8_BAR; PG8_SCHED;
            PG8_LDA(At, 1, 1); PG8_STAGE(PG8_SB(1, 0), b3, voffB); PG8_STAGE(PG8_SB(1, 1), b3 + hstepB, voffB); PG8_STAGE(PG8_SA(1, 0), a3, voffA);
            PG8_WAIT_V(8); PG8_WAIT_L(0); PG8_BAR; PG8_MMA(1, 0, At, B0); PG8_MMA(1, 1, At, B1); PG8_BAR; PG8_SCHED;
            } else {
            PG8_LDB(B0, 0, 0); PG8_SCHED; PG8_LDA(At, 0, 0); PG8_STAGE(PG8_SA(1, 1), a1 + hstepA, voffA);
            PG8_WAIT_L(8); PG8_BAR; PG8_WAIT_L(0); PG8_MMA(0, 0, At, B0); PG8_BAR; PG8_SCHED;
            PG8_LDB(B1, 0, 1); PG8_STAGE(PG8_SB(0, 0), b2, voffB);
            PG8_BAR; PG8_WAIT_L(0); PG8_MMA(0, 1, At, B1); PG8_BAR;
            PG8_LDA(At, 0, 1); PG8_STAGE(PG8_SA(0, 0), a2, voffA);
            PG8_BAR; PG8_WAIT_L(0); PG8_MMA(1, 0, At, B0); PG8_BAR; PG8_SCHED;
            PG8_STAGE(PG8_SB(0, 1), b2 + hstepB, voffB);
            PG8_WAIT_V(6); PG8_BAR; PG8_MMA(1, 1, At, B1); PG8_BAR;
            PG8_LDB(B0, 1, 0); PG8_SCHED; PG8_LDA(At, 1, 0); PG8_STAGE(PG8_SA(0, 1), a2 + hstepA, voffA);
            PG8_WAIT_L(8); PG8_BAR; PG8_WAIT_L(0); PG8_MMA(0, 0, At, B0); PG8_BAR; PG8_SCHED;
            PG8_LDB(B1, 1, 1); PG8_STAGE(PG8_SB(1, 0), b3, voffB);
            PG8_BAR; PG8_WAIT_L(0); PG8_MMA(0, 1, At, B1); PG8_BAR;
            PG8_LDA(At, 1, 1); PG8_STAGE(PG8_SA(1, 0), a3, voffA);
            PG8_BAR; PG8_WAIT_L(0); PG8_MMA(1, 0, At, B0); PG8_BAR; PG8_SCHED;
            PG8_STAGE(PG8_SB(1, 1), b3 + hstepB, voffB);
            PG8_WAIT_V(6); PG8_BAR; PG8_MMA(1, 1, At, B1); PG8_BAR;
            }
        }
        if constexpr (ALIGN_EPI) { if (wr == 0) PG8_BAR; }
        { const int le = lane_id(); E(acc, cur, wr, wc, le & 15, le >> 4); }
        if (!has_next) break;
#pragma unroll
        for (int a = 0; a < 2; ++a)
#pragma unroll
            for (int b = 0; b < 2; ++b)
#pragma unroll
                for (int m = 0; m < 4; ++m)
#pragma unroll
                    for (int n = 0; n < 2; ++n) acc[a][b][m][n] = (f32x4){0.f, 0.f, 0.f, 0.f};
        cur = nxt; cA = nA; cB = nB; ++ui;
        if constexpr (ALIGN_EPI) { if (wr == 1) PG8_BAR; }
    }
    PG8_WAIT_V(0);
    if constexpr (!ALIGN_EPI) { if (wr == 0) PG8_BAR; }
    PG8_BAR;
#undef PG8_SA
#undef PG8_SB
#undef PG8_STAGE
#undef PG8_LDA
#undef PG8_LDB
#undef PG8_MMA
#undef PG8_CAT
#undef PG8_WAIT_V
#undef PG8_WAIT_L
#undef PG8_BAR
#undef PG8_SCHED
}

#define EPI_ROWS(ai, m) (u.pm * BM + wr * 64 + fr + (ai) * HALF + (m) * 16)
struct EpiIn {
    static constexpr bool PERM = true;
    int mode; float sc;
    bf16_t *U, *GA, *VG; unsigned char *CQKV, *KR; const float* bgate; const float* rope; u64 *sqq, *sqkv, *ssum, *ssq;
    __device__ __forceinline__ void operator()(const f32x4 (&acc)[2][2][4][2], const Unit& u, int wr, int wc, int fr, int fq) const {
        const int pn = u.pn, cw = wc * 32 + 8 * fq;
        if (mode == 1 || pn >= 29) {
            const int c0 = (mode == 1 ? pn : pn - 29) * 256 + cw;
#pragma unroll
            for (int ai = 0; ai < 2; ++ai)
#pragma unroll
                for (int m = 0; m < 4; ++m) { const int row = EPI_ROWS(ai, m); float s = 0.f, q = 0.f;
#pragma unroll
                    for (int bj = 0; bj < 2; ++bj) { f32x4 v0 = acc[ai][bj][m][0] * sc, v1 = acc[ai][bj][m][1] * sc;
#pragma unroll
                        for (int e = 0; e < 4; ++e) { v0[e] = gelu_t(v0[e]); v1[e] = gelu_t(v1[e]); }
                        s += (v0[0] + v0[1]) + (v0[2] + v0[3]) + (v1[0] + v1[1]) + (v1[2] + v1[3]);
                        q += (v0[0] * v0[0] + v0[1] * v0[1]) + (v0[2] * v0[2] + v0[3] * v0[3]) + (v1[0] * v1[0] + v1[1] * v1[1]) + (v1[2] * v1[2] + v1[3] * v1[3]);
                        v4u w; w.x = cvt_pk_bf16(v0[0], v0[1]); w.y = cvt_pk_bf16(v0[2], v0[3]); w.z = cvt_pk_bf16(v1[0], v1[1]); w.w = cvt_pk_bf16(v1[2], v1[3]);
                        __builtin_nontemporal_store(w, (v4u*)(VG + (size_t)row * 2048 + c0 + bj * HALF)); }
                    s += shx(s, 16, fq * 16 + fr); s += shx(s, 32, fq * 16 + fr); q += shx(q, 16, fq * 16 + fr); q += shx(q, 32, fq * 16 + fr);
                    if (fq == 0) { fx_add(ssum + row, s); fx_add(ssq + row, q); } }
        } else if (pn < 16) {
            const int c0 = pn * 128 + cw; const float* bg = bgate + 2048 + c0;
            const f32x4 b0 = *(const f32x4*)bg, b1 = *(const f32x4*)(bg + 4);
#pragma unroll
            for (int ai = 0; ai < 2; ++ai)
#pragma unroll
                for (int m = 0; m < 4; ++m) { const int row = EPI_ROWS(ai, m);
                    f32x4 v0 = acc[ai][0][m][0] * sc, v1 = acc[ai][0][m][1] * sc; const f32x4 g0 = acc[ai][1][m][0] * sc + b0, g1 = acc[ai][1][m][1] * sc + b1;
#pragma unroll
                    for (int e = 0; e < 4; ++e) { v0[e] = gelu_t(v0[e]) * sigmoid_f(g0[e]); v1[e] = gelu_t(v1[e]) * sigmoid_f(g1[e]); }
                    v4u w; w.x = cvt_pk_bf16(v0[0], v0[1]); w.y = cvt_pk_bf16(v0[2], v0[3]); w.z = cvt_pk_bf16(v1[0], v1[1]); w.w = cvt_pk_bf16(v1[2], v1[3]);
                    __builtin_nontemporal_store(w, (v4u*)(U + (size_t)row * 2048 + c0)); }
        } else if (pn < 24) {
            const int c0 = (pn - 16) * 256 + cw; const float* bg = bgate + c0;
            f32x4 bv[2][2];
#pragma unroll
            for (int bj = 0; bj < 2; ++bj) { bv[bj][0] = *(const f32x4*)(bg + bj * HALF); bv[bj][1] = *(const f32x4*)(bg + bj * HALF + 4); }
#pragma unroll
            for (int ai = 0; ai < 2; ++ai)
#pragma unroll
                for (int m = 0; m < 4; ++m) { const int row = EPI_ROWS(ai, m);
#pragma unroll
                    for (int bj = 0; bj < 2; ++bj) { f32x4 v0 = acc[ai][bj][m][0] * sc + bv[bj][0], v1 = acc[ai][bj][m][1] * sc + bv[bj][1];
#pragma unroll
                        for (int e = 0; e < 4; ++e) { v0[e] = sigmoid_f(v0[e]); v1[e] = sigmoid_f(v1[e]); }
                        v4u w; w.x = cvt_pk_bf16(v0[0], v0[1]); w.y = cvt_pk_bf16(v0[2], v0[3]); w.z = cvt_pk_bf16(v1[0], v1[1]); w.w = cvt_pk_bf16(v1[2], v1[3]);
                        __builtin_nontemporal_store(w, (v4u*)(GA + (size_t)row * 2048 + c0 + bj * HALF)); } }
        } else if (pn < 28) {
            const int pc = pn - 24; u64* sq = pc < 2 ? sqq : sqkv;
#pragma unroll
            for (int ai = 0; ai < 2; ++ai)
#pragma unroll
                for (int m = 0; m < 4; ++m) { const int row = EPI_ROWS(ai, m); float s = 0.f;
#pragma unroll
                    for (int bj = 0; bj < 2; ++bj) { const f32x4 v0 = acc[ai][bj][m][0] * sc, v1 = acc[ai][bj][m][1] * sc;
                        s += (v0[0] * v0[0] + v0[1] * v0[1]) + (v0[2] * v0[2] + v0[3] * v0[3]) + (v1[0] * v1[0] + v1[1] * v1[1]) + (v1[2] * v1[2] + v1[3] * v1[3]);
                        v2u w; w.x = pack_fp8x4(v0 * XN8_SCALE); w.y = pack_fp8x4(v1 * XN8_SCALE);
                        *(v2u*)(CQKV + (size_t)row * 1024 + pc * 256 + bj * HALF + cw) = w; }
                    s += shx(s, 16, fq * 16 + fr); s += shx(s, 32, fq * 16 + fr);
                    if (fq == 0) fx_add(sq + row, s); }
        } else {
            if (wc < 2) {
                const int i0 = cw >> 1;
#pragma unroll
                for (int ai = 0; ai < 2; ++ai)
#pragma unroll
                    for (int m = 0; m < 4; ++m) { const int row = EPI_ROWS(ai, m);
                        const f32x4 c4 = *(const f32x4*)(rope + (size_t)row * 32 + i0), s4 = *(const f32x4*)(rope + (size_t)MTOK * 32 + (size_t)row * 32 + i0);
                        const f32x4 v0 = acc[ai][0][m][0] * sc, v1 = acc[ai][0][m][1] * sc;
                        const f32x4 r0 = {v0[0] * c4[0] - v0[1] * s4[0], v0[0] * s4[0] + v0[1] * c4[0], v0[2] * c4[1] - v0[3] * s4[1], v0[2] * s4[1] + v0[3] * c4[1]};
                        const f32x4 r1 = {v1[0] * c4[2] - v1[1] * s4[2], v1[0] * s4[2] + v1[1] * c4[2], v1[2] * c4[3] - v1[3] * s4[3], v1[2] * s4[3] + v1[3] * c4[3]};
                        v2u w; w.x = pack_fp8x4(r0 * K8_SCALE); w.y = pack_fp8x4(r1 * K8_SCALE);
                        *(v2u*)(KR + (size_t)row * DR + cw) = w; }
            }
        }
    }
};
struct EpiQ {
    static constexpr bool PERM = true;
    unsigned char* Q; const u64* sqq; const float* rope;
    __device__ __forceinline__ void operator()(const f32x4 (&acc)[2][2][4][2], const Unit& u, int wr, int wc, int fr, int fq) const {
        const int cw = wc * 32 + 8 * fq;
#pragma unroll
        for (int ai = 0; ai < 2; ++ai)
#pragma unroll
            for (int m = 0; m < 4; ++m) { const int row = EPI_ROWS(ai, m); const int b = row >> 13, s = row & 8191;
                const float rq = __builtin_amdgcn_rsqf(fx_get(sqq + row) * (1.f / QL) + EPS) * (C2Q * IN8_DESCALE * Q8_SCALE);
#pragma unroll
                for (int bj = 0; bj < 2; ++bj) { const int colg = u.pn * 256 + bj * HALF + cw; const int head = colg / DQK, dd = colg - head * DQK;
                    f32x4 v0 = acc[ai][bj][m][0] * rq, v1 = acc[ai][bj][m][1] * rq;
                    if (dd >= DN) { const int i0 = (dd - DN) >> 1;
                        const f32x4 c4 = *(const f32x4*)(rope + (size_t)row * 32 + i0), s4 = *(const f32x4*)(rope + (size_t)MTOK * 32 + (size_t)row * 32 + i0);
                        const f32x4 r0 = {v0[0] * c4[0] - v0[1] * s4[0], v0[0] * s4[0] + v0[1] * c4[0], v0[2] * c4[1] - v0[3] * s4[1], v0[2] * s4[1] + v0[3] * c4[1]};
                        const f32x4 r1 = {v1[0] * c4[2] - v1[1] * s4[2], v1[0] * s4[2] + v1[1] * c4[2], v1[2] * c4[3] - v1[3] * s4[3], v1[2] * s4[3] + v1[3] * c4[3]};
                        v0 = r0; v1 = r1; }
                    v2u w; w.x = pack_fp8x4(v0); w.y = pack_fp8x4(v1);
                    *(v2u*)(Q + ((size_t)(b * NHEAD + head) * SEQL + s) * DQK + dd) = w; } }
    }
};
struct EpiKV {
    static constexpr bool PERM = true;
    unsigned char* Kb; unsigned char* Vt; const u64* sqkv;
    __device__ __forceinline__ void operator()(const f32x4 (&acc)[2][2][4][2], const Unit& u, int wr, int wc, int fr, int fq) const {
        const int cw = wc * 32 + 8 * fq, head = u.pn;
#pragma unroll
        for (int ai = 0; ai < 2; ++ai)
#pragma unroll
            for (int m = 0; m < 4; ++m) {
                { const int row = EPI_ROWS(ai, m); const int b = row >> 13, s = row & 8191;
                  const float rk = __builtin_amdgcn_rsqf(fx_get(sqkv + row) * (1.f / QL) + EPS) * (IN8_DESCALE * K8_SCALE); const size_t tr = (size_t)(b * NHEAD + head) * SEQL + s;
                  v2u w; w.x = pack_fp8x4(acc[ai][0][m][0] * rk); w.y = pack_fp8x4(acc[ai][0][m][1] * rk); *(v2u*)(Kb + tr * DN + cw) = w; }
                { const int row0 = u.pm * BM + wr * 64 + ai * HALF + m * 16 + 4 * fq; const int b = row0 >> 13, s0 = row0 & 8191;
                  f32x4 rk4;
#pragma unroll
                  for (int e = 0; e < 4; ++e) rk4[e] = __builtin_amdgcn_rsqf(fx_get(sqkv + row0 + e) * (1.f / QL) + EPS) * (IN8_DESCALE * V8_SCALE);
                  const int slot = (s0 & ~63) + 32 * (fq & 1) + 4 * (2 * m + (fq >> 1));
#pragma unroll
                  for (int n = 0; n < 2; ++n) { const int dv = wc * 32 + 8 * (fr >> 2) + 4 * n + (fr & 3);
                      *(unsigned*)(Vt + ((size_t)(b * NHEAD + head) * DVH + dv) * SEQL + slot) = pack_fp8x4(acc[ai][1][m][n] * rk4); } }
            }
    }
};
struct EpiOut {
    static constexpr bool PERM = false;
    const float* x; bf16_t* X1B; u64* sqx;
    __device__ __forceinline__ void operator()(const f32x4 (&acc)[2][2][4][2], const Unit& u, int wr, int wc, int fr, int fq) const {
        const int col0 = u.pn * BM + wc * 32 + 4 * fq;
#pragma unroll
        for (int ai = 0; ai < 2; ++ai)
#pragma unroll
            for (int m = 0; m < 4; ++m) { const int row = EPI_ROWS(ai, m); float s = 0.f;
#pragma unroll
                for (int bj = 0; bj < 2; ++bj)
#pragma unroll
                    for (int n = 0; n < 2; ++n) { const size_t off = (size_t)row * D_MODEL + col0 + bj * HALF + n * 16;
                        const f32x4 v = *(const f32x4*)(x + off) + acc[ai][bj][m][n];
                        s += (v[0] * v[0] + v[1] * v[1]) + (v[2] * v[2] + v[3] * v[3]);
                        v2u w; w.x = cvt_pk_bf16(v[0], v[1]); w.y = cvt_pk_bf16(v[2], v[3]); *(v2u*)(X1B + off) = w; }
                s += shx(s, 16, fq * 16 + fr); s += shx(s, 32, fq * 16 + fr);
                if (fq == 0) fx_add(sqx + row, s); }
    }
};
struct EpiPQ {
    static constexpr bool PERM = true;
    bf16_t* QP; const u64* sqx;
    __device__ __forceinline__ void operator()(const f32x4 (&acc)[2][2][4][2], const Unit& u, int wr, int wc, int fr, int fq) const {
        const int cw = u.pn * 256 + wc * 32 + 8 * fq;
#pragma unroll
        for (int ai = 0; ai < 2; ++ai)
#pragma unroll
            for (int m = 0; m < 4; ++m) { const int row = EPI_ROWS(ai, m);
                const float r2 = __builtin_amdgcn_rsqf(fx_get(sqx + row) * (1.f / D_MODEL) + EPS);
#pragma unroll
                for (int bj = 0; bj < 2; ++bj) { const f32x4 v0 = acc[ai][bj][m][0] * r2, v1 = acc[ai][bj][m][1] * r2;
                    v4u w; w.x = cvt_pk_bf16(v0[0], v0[1]); w.y = cvt_pk_bf16(v0[2], v0[3]); w.z = cvt_pk_bf16(v1[0], v1[1]); w.w = cvt_pk_bf16(v1[2], v1[3]);
                    __builtin_nontemporal_store(w, (v4u*)(QP + (size_t)row * D_MODEL + cw + bj * HALF)); } }
    }
};
#undef EPI_ROWS
}

typedef GAS unsigned gu32;
#define RLX_AGENT __ATOMIC_RELAXED, __HIP_MEMORY_SCOPE_AGENT
#define XB_TMO      128
#define XB_XCNT(j)  (256  + 64 * (j))
#define XB_XSUB(j)  (1280 + 64 * (j))
#define XB_XGEN(j)  (2304 + 64 * (j))
#define XB_TOP      3328
#define XB_TOPGEN   3392
#define XCD_BAR_WORDS 3456
#define XB_SPIN_CAP (1u << 18)
__device__ __forceinline__ unsigned xb_ld(unsigned* p)              { return __hip_atomic_load(p, __ATOMIC_RELAXED, __HIP_MEMORY_SCOPE_AGENT); }
__device__ __forceinline__ unsigned xb_add(unsigned* p, unsigned v) { return __hip_atomic_fetch_add(p, v, __ATOMIC_RELAXED, __HIP_MEMORY_SCOPE_AGENT); }
__device__ __forceinline__ unsigned xb_xcc_id() { return (unsigned)__builtin_amdgcn_s_getreg((3 << 11) | 20) & 0xFu; }
#define XB_SPIN(cond, bar) do { unsigned _sp = 0; while (cond) { __builtin_amdgcn_s_sleep(1); \
    if ((++_sp & 255u) == 0u) { if (xb_ld(&(bar)[XB_TMO])) break; if (_sp > XB_SPIN_CAP) { atomicAdd(&(bar)[XB_TMO], 1u); break; } } } } while (0)
struct XcdBarrier { unsigned* bar; unsigned x; volatile LAS unsigned* st; int wave; };
__device__ __forceinline__ XcdBarrier xcd_barrier_post(unsigned* bar, volatile LAS unsigned* st, int wave) {
    XcdBarrier b; b.bar = bar; b.x = xb_xcc_id(); b.st = st; b.wave = wave;
    if (wave == 0 && lane_id() == 0) (void)xb_add(&bar[XB_XCNT(b.x)], 1u);
    return b;
}
__device__ __forceinline__ void xcd_barrier_complete(unsigned* bar, unsigned x, unsigned& nloc, unsigned& nx) {
    const unsigned G = gridDim.x * gridDim.y * gridDim.z;
    unsigned sum, cnt, mine, sp = 0u;
    for (;;) {
        sum = 0u; cnt = 0u; mine = 0u;
#pragma unroll
        for (unsigned j = 0; j < 16; ++j) { const unsigned c = xb_ld(&bar[XB_XCNT(j)]); sum += c; cnt += (c > 0u) ? 1u : 0u; mine = (j == x) ? c : mine; }
        if (sum == G) break;
        __builtin_amdgcn_s_sleep(1);
        if ((++sp & 255u) == 0u) { if (xb_ld(&bar[XB_TMO])) break; if (sp > XB_SPIN_CAP) { atomicAdd(&bar[XB_TMO], 1u); break; } }
    }
    nloc = mine > 0u ? mine : 1u; nx = cnt > 0u ? cnt : 1u;
}
__device__ __forceinline__ void xcd_barrier(const XcdBarrier& b) {
    asm volatile("s_waitcnt vmcnt(0)" ::: "memory");
    __syncthreads();
    if (b.wave == 0 && lane_id() == 0) {
        unsigned* bar = b.bar;
        __builtin_amdgcn_s_waitcnt(0);
        unsigned nloc = b.st[0], nx = b.st[1];
        if (nloc == 0u) { xcd_barrier_complete(bar, b.x, nloc, nx); b.st[0] = nloc; b.st[1] = nx; }
        const unsigned old = xb_add(&bar[XB_XSUB(b.x)], 1u);
        const unsigned gen = old / nloc;
        if (old + 1u == (gen + 1u) * nloc) {
            __builtin_amdgcn_fence(__ATOMIC_RELEASE, "agent");
            asm volatile("s_waitcnt vmcnt(0)" ::: "memory");
            const unsigned og = xb_add(&bar[XB_TOP], 1u);
            const unsigned tg = og / nx;
            if (og + 1u == (tg + 1u) * nx) xb_add(&bar[XB_TOPGEN], 1u);
            else XB_SPIN(xb_ld(&bar[XB_TOPGEN]) == tg, bar);
            __builtin_amdgcn_fence(__ATOMIC_ACQUIRE, "agent");
            xb_add(&bar[XB_XGEN(b.x)], 1u);
            asm volatile("s_waitcnt vmcnt(0)" ::: "memory");
        } else {
            XB_SPIN(xb_ld(&bar[XB_XGEN(b.x)]) == gen, bar);
            __builtin_amdgcn_fence(__ATOMIC_ACQUIRE, "agent");
            asm volatile("s_waitcnt vmcnt(0)" ::: "memory");
        }
    }
    __syncthreads();
}

struct Args { const float* in[20]; float* out; unsigned char* ws; };
struct Frame {
    LAS unsigned char* lds; int tid, lane, wave, vcu, G;
};

__device__ __forceinline__ int colmap(int mode, int r) {
    if (mode == 0) return r;
    if (mode == 1) return 3136 + r;
    if (mode == 3) { if (r < 4096) { const int k = r >> 8, j = r & 255; return j < 128 ? 1088 + 128 * k + j : 7232 + 128 * k + (j - 128); } if (r < 6144) return 5184 + (r - 4096); if (r < 7168) return r - 6144;
        if (r < 7232) { const int j = r - 7168; return 1024 + (j >> 1) + 32 * (j & 1); } if (r < 7424) return -1; return 3136 + (r - 7424); }
    const int h = r / DQK, d = r - h * DQK; if (d < DN) return r; const int j = d - DN; return h * DQK + DN + (j >> 1) + 32 * (j & 1);
}
template <bool F8 = false>
__device__ __forceinline__ void p0_transpose_item(const float* W, int K, int N, bf16* WT, int ndst, int mode, const float* kscale, LAS float* scr, int item, int lane) {
    const int nblk = ndst / 32, kb = item / nblk, nb = item % nblk, k0 = 64 * kb, n0 = 32 * nb;
    const int src = colmap(mode, n0 + (lane & 31));
    const int s0 = colmap(mode, n0), s31 = colmap(mode, n0 + 31);
    if (s0 >= 0 && s31 == s0 + 31 && (s0 & 3) == 0) {
        const int kr = lane >> 3, n4 = lane & 7; f32x4 v[8];
#pragma unroll
        for (int i = 0; i < 8; ++i) v[i] = *(const f32x4*)(W + (size_t)(k0 + 8 * i + kr) * N + s0 + 4 * n4);
#pragma unroll
        for (int i = 0; i < 8; ++i) { const float ks = kscale ? kscale[k0 + 8 * i + kr] : 1.f; LAS float* d = scr + (8 * i + kr) * 33 + 4 * n4;
            d[0] = v[i][0] * ks; d[1] = v[i][1] * ks; d[2] = v[i][2] * ks; d[3] = v[i][3] * ks; }
    } else {
#pragma unroll 8
    for (int i = 0; i < 32; ++i) { const int kk = 2 * i + (lane >> 5); float v = 0.f;
        if (src >= 0) { v = W[(size_t)(k0 + kk) * N + src]; if (kscale) v *= kscale[k0 + kk]; }
        scr[kk * 33 + (lane & 31)] = v; }
    }
    LDS_WAIT(); asm volatile("" ::: "memory");
    const int c = lane & 7;
#pragma unroll
    for (int j = 0; j < 4; ++j) { const int n = (lane >> 3) + 8 * j; const LAS float* s = scr + (8 * c) * 33 + n;
        if constexpr (F8) { float t[8];
#pragma unroll
            for (int e = 0; e < 8; ++e) t[e] = fminf(fmaxf(s[e * 33] * WIN8_SCALE, -448.f), 448.f);
            int w0 = 0, w1 = 0; w0 = __builtin_amdgcn_cvt_pk_fp8_f32(t[0], t[1], w0, false); w0 = __builtin_amdgcn_cvt_pk_fp8_f32(t[2], t[3], w0, true); w1 = __builtin_amdgcn_cvt_pk_fp8_f32(t[4], t[5], w1, false); w1 = __builtin_amdgcn_cvt_pk_fp8_f32(t[6], t[7], w1, true);
            v2u o; o.x = (unsigned)w0; o.y = (unsigned)w1; *(v2u*)((unsigned char*)WT + (size_t)(n0 + n) * K + k0 + 8 * c) = o; continue; }
        v4u o; o.x = cvt_pk_bf16(s[0 * 33], s[1 * 33]); o.y = cvt_pk_bf16(s[2 * 33], s[3 * 33]); o.z = cvt_pk_bf16(s[4 * 33], s[5 * 33]); o.w = cvt_pk_bf16(s[6 * 33], s[7 * 33]);
        *(v4u*)(WT + (size_t)(n0 + n) * K + k0 + 8 * c) = o; }
    LDS_WAIT(); asm volatile("" ::: "memory");
}

__device__ __forceinline__ void sgu_unit(const Frame& F, int unit, const bf16* VG, bf16* U, const bf16* WSP, const float* lng, const float* lnb, const float* bsp, const u64* ssum, const u64* ssq) {
    const int chunk = unit >> 3, g = unit & 7, row0 = chunk * 128, c0 = g * 256;
    const int tid = F.tid, lane = F.lane, w = F.wave, fr = lane & 15, fq = lane >> 4;
    LAS unsigned* vt = (LAS unsigned*)F.lds;
    LAS float* st = (LAS float*)(F.lds + 256 * 272);
    if (tid < 128) { const float mean = fx_get(ssum + row0 + tid) * (1.f / D_MODEL), ex2 = fx_get(ssq + row0 + tid) * (1.f / D_MODEL);
        const float var = fmaxf(ex2 - mean * mean, 0.f); st[2 * tid] = mean; st[2 * tid + 1] = __builtin_amdgcn_rsqf(var + EPS); }
    __syncthreads();
#pragma unroll 1
    for (int q = 0; q < 4; ++q) {
        const int wi = w + 8 * q, c8 = lane & 7, rlo = lane >> 3, s2 = 8 * (wi & 7) + rlo, cg = 8 * (wi >> 3) + c8;
        const bf16* p = VG + (size_t)(row0 + 2 * s2) * D_MODEL + c0 + 8 * cg;
        const v4u a = *(const v4u*)p, b = *(const v4u*)(p + D_MODEL);
        const f32x4 g0 = *(const f32x4*)(lng + c0 + 8 * cg), g1 = *(const f32x4*)(lng + c0 + 8 * cg + 4), b0 = *(const f32x4*)(lnb + c0 + 8 * cg), b1 = *(const f32x4*)(lnb + c0 + 8 * cg + 4);
        const float m0 = st[4 * s2], r0 = st[4 * s2 + 1], m1 = st[4 * s2 + 2], r1 = st[4 * s2 + 3];
        const unsigned aw[4] = {a.x, a.y, a.z, a.w}, bw[4] = {b.x, b.y, b.z, b.w};
        const int pd = s2 ^ (c8 << 3);
#pragma unroll
        for (int j = 0; j < 8; ++j) { const float ga = j < 4 ? g0[j & 3] : g1[j & 3], be = j < 4 ? b0[j & 3] : b1[j & 3];
            const float x0 = (j & 1) ? bf_hi(aw[j >> 1]) : bf_lo(aw[j >> 1]), x1 = (j & 1) ? bf_hi(bw[j >> 1]) : bf_lo(bw[j >> 1]);
            vt[(8 * cg + j) * 68 + pd] = cvt_pk_bf16((x0 - m0) * r0 * ga + be, (x1 - m1) * r1 * ga + be); }
    }
    __syncthreads();
    f32x4 acc[2][8];
#pragma unroll
    for (int rt = 0; rt < 2; ++rt)
#pragma unroll
        for (int tt = 0; tt < 8; ++tt) acc[rt][tt] = (f32x4){0.f, 0.f, 0.f, 0.f};
    const bf16* wg = WSP + (size_t)g * 128 * 128;
#pragma unroll
    for (int kk = 0; kk < 4; ++kk) {
        bf16x8 af[2];
#pragma unroll
        for (int rt = 0; rt < 2; ++rt) { const int ch = 32 * w + 16 * rt + fr; const int d = 16 * kk + 4 * fq, pd = d ^ (((ch >> 3) & 7) << 3);
            af[rt] = *(const LAS bf16x8*)((const LAS unsigned char*)vt + ch * 272 + pd * 4); }
#pragma unroll
        for (int tt = 0; tt < 8; ++tt) { if (tt >= 2 * kk) {
            const bf16x8 bfr = *(const bf16x8*)(wg + (size_t)(16 * tt + fr) * 128 + 32 * kk + 8 * fq);
#pragma unroll
            for (int rt = 0; rt < 2; ++rt) acc[rt][tt] = __builtin_amdgcn_mfma_f32_16x16x32_bf16(af[rt], bfr, acc[rt][tt], 0, 0, 0); } }
    }
#pragma unroll
    for (int tt = 0; tt < 8; ++tt) { const int t = 16 * tt + fr; const float bs = bsp[g * 128 + t];
#pragma unroll
        for (int rt = 0; rt < 2; ++rt) { const size_t off = (size_t)(row0 + t) * D_MODEL + c0 + 32 * w + 16 * rt + 4 * fq;
            const v2u uu = *(const v2u*)(U + off);
            const f32x4 a = acc[rt][tt];
            v2u o; o.x = cvt_pk_bf16(bf_lo(uu.x) * (a[0] + bs), bf_hi(uu.x) * (a[1] + bs));
            o.y = cvt_pk_bf16(bf_lo(uu.y) * (a[2] + bs), bf_hi(uu.y) * (a[3] + bs));
            *(v2u*)(U + off) = o; } }
    __syncthreads();
}

namespace att {
constexpr int KT = 64 * 192, VT = 128 * 64;
constexpr int L_K = 0, L_V = 4 * KT, L_WS = 4 * KT + 4 * VT;
#define KSWZ(row, ch) ((row) * 192 + ((((ch) ^ (((row) >> 2) & 3))) << 4))
__device__ __forceinline__ int v_st(int k, int c) { const int kk = (k & ~0xC) | ((k & 4) << 1) | ((k & 8) >> 1); return ((kk >> 3) * 4 + (c >> 5)) * 512 + ((kk & 7) * 32 + (c & 31)) * 2; }
__device__ __forceinline__ int v_rd_base(int lane) { return ((lane & 3) << 3) | (((lane >> 2) & 3) << 6) | (((lane >> 4) & 1) << 5) | (((lane >> 5) & 1) << 8); }
constexpr int v_rd_off(int d0, int ks, int half) { return d0 * 512 + ks * 4096 + half * 2048; }
__device__ __forceinline__ int crow(int r, int hi) { return (r & 3) + 8 * (r >> 2) + 4 * hi; }
__device__ __forceinline__ void mask_tile(f32x16& p0, f32x16& p1, int dq) {
    const float NEG = -__builtin_inff();
#pragma unroll
    for (int r = 0; r < 16; ++r) { const int c = (r & 3) + 8 * (r >> 2); if (dq - c < 0) p0[r] = NEG; if (dq - c - 32 < 0) p1[r] = NEG; }
}
constexpr float THR = 8.f;
__device__ __forceinline__ void softmax_tile(f32x16& p0, f32x16& p1, float& m_reg, float& alpha, v8i& pk, bool first) {
    float pmax;
    { float a4[4];
#pragma unroll
      for (int c = 0; c < 4; ++c) { a4[c] = fmaxf(fmaxf(p0[4 * c], p0[4 * c + 1]), p0[4 * c + 2]); a4[c] = fmaxf(fmaxf(a4[c], p0[4 * c + 3]), p1[4 * c]);
          a4[c] = fmaxf(fmaxf(a4[c], p1[4 * c + 1]), p1[4 * c + 2]); a4[c] = fmaxf(a4[c], p1[4 * c + 3]); }
      pmax = fmaxf(fmaxf(a4[0], a4[1]), fmaxf(a4[2], a4[3])); }
    { auto rr = __builtin_amdgcn_permlane32_swap(__float_as_uint(pmax), __float_as_uint(pmax), false, false); pmax = fmaxf(__uint_as_float(rr[0]), __uint_as_float(rr[1])); }
    if (__builtin_expect(__all(pmax - m_reg <= THR) && !first, 1)) { alpha = 1.f; }
    else { float delta = first ? pmax - m_reg : fmaxf(pmax - m_reg, 0.f); if (!(delta > -1e30f)) delta = 0.f;
        alpha = first ? 1.f : __builtin_amdgcn_exp2f(-delta); m_reg += delta; }
#pragma unroll
    for (int r = 0; r < 16; ++r) { p0[r] = __builtin_amdgcn_exp2f(p0[r] - m_reg); p1[r] = __builtin_amdgcn_exp2f(p1[r] - m_reg); }
#pragma unroll
    for (int w = 0; w < 4; ++w) { int d0 = 0, d1 = 0; d0 = __builtin_amdgcn_cvt_pk_fp8_f32(p0[4 * w], p0[4 * w + 1], d0, false); d0 = __builtin_amdgcn_cvt_pk_fp8_f32(p0[4 * w + 2], p0[4 * w + 3], d0, true);
        d1 = __builtin_amdgcn_cvt_pk_fp8_f32(p1[4 * w], p1[4 * w + 1], d1, false); d1 = __builtin_amdgcn_cvt_pk_fp8_f32(p1[4 * w + 2], p1[4 * w + 3], d1, true); pk[w] = d0; pk[4 + w] = d1; }
}
template <int KB>
__device__ __forceinline__ void qkt(f32x16& p0, f32x16& p1, const char* K_lds, int r32, int hi, const v8i* qr) {
    p0 = f32x16{}; p1 = f32x16{};
    const char* k0 = K_lds + KB * KT + KSWZ(r32, 2 * hi); const char* k1 = K_lds + KB * KT + KSWZ(r32, 2 * hi + 1);
#pragma unroll
    for (int ks = 0; ks < 3; ++ks) {
        const v4u a0 = *reinterpret_cast<const v4u*>(k0 + ks * 64), a1 = *reinterpret_cast<const v4u*>(k1 + ks * 64);
        const v4u b0 = *reinterpret_cast<const v4u*>(k0 + ks * 64 + 32 * 192), b1 = *reinterpret_cast<const v4u*>(k1 + ks * 64 + 32 * 192);
        const v8i ka = {(int)a0.x, (int)a0.y, (int)a0.z, (int)a0.w, (int)a1.x, (int)a1.y, (int)a1.z, (int)a1.w};
        const v8i kb = {(int)b0.x, (int)b0.y, (int)b0.z, (int)b0.w, (int)b1.x, (int)b1.y, (int)b1.z, (int)b1.w};
        p0 = __builtin_amdgcn_mfma_scale_f32_32x32x64_f8f6f4(ka, qr[ks], p0, 0, 0, 0, 0x7c7c7c7c, 0, 0x79797979);
        p1 = __builtin_amdgcn_mfma_scale_f32_32x32x64_f8f6f4(kb, qr[ks], p1, 0, 0, 0, 0x7c7c7c7c, 0, 0x79797979); }
}
template <int VB>
__device__ __forceinline__ void pv_tile(f32x16* o, f32x16& lacc, const char* V_lds, int r32, int hi, v8i pk) {
    const int sw = (r32 >> 2) & 3;
    const char* v0 = V_lds + VB * VT + r32 * 64 + (((2 * hi) ^ sw) << 4); const char* v1 = V_lds + VB * VT + r32 * 64 + (((2 * hi + 1) ^ sw) << 4);
#pragma unroll
    for (int d0 = 0; d0 < 4; ++d0) { const v4u a = *reinterpret_cast<const v4u*>(v0 + d0 * 2048), b = *reinterpret_cast<const v4u*>(v1 + d0 * 2048);
        const v8i vb = {(int)a.x, (int)a.y, (int)a.z, (int)a.w, (int)b.x, (int)b.y, (int)b.z, (int)b.w};
        o[d0] = __builtin_amdgcn_mfma_scale_f32_32x32x64_f8f6f4(pk, vb, o[d0], 0, 0, 0, 0x7f7f7f7f, 0, 0x7c7c7c7c); if (d0 == 1) SBAR(); }
    { int c1 = 0x38383838; asm volatile("" : "+v"(c1)); const v8i ones = {c1, c1, c1, c1, c1, c1, c1, c1};
      lacc = __builtin_amdgcn_mfma_scale_f32_32x32x64_f8f6f4(pk, ones, lacc, 0, 0, 0, 0x7f7f7f7f, 0, 0x7f7f7f7f); }
}
__device__ __forceinline__ void attn_unit(int bh, int qb, const unsigned char* Q, const unsigned char* K, const unsigned char* KRp, const unsigned char* V, const bf16* GA, bf16* MG, char* lds, LAS unsigned char* lds3, const int wave0) {
    int tid = wave0 * 64 + lane_id(); asm volatile("" : "+v"(tid));
    const int wid = __builtin_amdgcn_readfirstlane(tid >> 6), lane = tid & 63, r32 = lane & 31, hi = lane >> 5;
    const int q0 = qb * 256, qlo = q0 + wid * 32, qm = qlo + r32 - 4 * hi;
    const unsigned char* Qw = Q + ((size_t)bh * SEQL + qlo + r32) * DQK;
    const unsigned char* Kh = K + (size_t)bh * SEQL * DN; const unsigned char* KRh = KRp + (size_t)(bh >> 4) * SEQL * DR; const unsigned char* Vh = V + (size_t)bh * SEQL * DVH;
    char* V_lds = lds + L_V; char* K_lds = lds + L_K;
    float* ws = (float*)(lds + L_WS) + wid * 64; float* li_l = ws, * al_l = ws + 32;
    v8i qr[3];
#pragma unroll
    for (int ks = 0; ks < 3; ++ks) { const v4u a = *reinterpret_cast<const v4u*>(Qw + ks * 64 + hi * 32), b = *reinterpret_cast<const v4u*>(Qw + ks * 64 + hi * 32 + 16);
        qr[ks] = (v8i){(int)a.x, (int)a.y, (int)a.z, (int)a.w, (int)b.x, (int)b.y, (int)b.z, (int)b.w}; }
    const int NT = 4 * (qb + 1);
    unsigned ksp[2], kst[2], vso;
#pragma unroll
    for (int i = 0; i < 2; ++i) { const int o = i * 8192 + tid * 16, row = (o / 192) & 63, pos = (o - (o / 192) * 192) >> 4, ch = pos ^ ((row >> 2) & 3);
        if (ch < 8) { ksp[i] = (unsigned)(Kh - Vh) + (unsigned)(row * DN + ch * 16); kst[i] = 64 * DN; } else { ksp[i] = (unsigned)(KRh - Vh) + (unsigned)(row * DR + (ch - 8) * 16); kst[i] = 64 * DR; } }
    { const int j = tid >> 2, c = (tid & 3) ^ ((j >> 2) & 3); vso = (unsigned)(j * SEQL + c * 16); }
    float m_reg = 0.f; f32x16 lacc = {}; f32x16 o[4] = {};
    const unsigned ldw = (unsigned)wid * 1024u;
#define SOFF(x) ({ unsigned o_ = (x); asm volatile("" : "+v"(o_)); (const unsigned*)((const char*)Vh + o_); })
#define SDMA(t, bf) do { \
        __builtin_amdgcn_global_load_lds(SOFF(ksp[0] + (unsigned)(t) * kst[0]), (LAS unsigned*)(lds3 + L_K + (bf) * KT + ldw), 16, 0, 0); \
        if (wid < 4) __builtin_amdgcn_global_load_lds(SOFF(ksp[1] + (unsigned)(t) * kst[1]), (LAS unsigned*)(lds3 + L_K + (bf) * KT + 8192 + ldw), 16, 0, 0); \
        __builtin_amdgcn_global_load_lds(SOFF(vso + (unsigned)(t) * 64u), (LAS unsigned*)(lds3 + L_V + (bf) * VT + ldw), 16, 0, 0); } while (0)
#define TILE(t, BF) do { f32x16 p0, p1; float alpha; v8i pk; \
        __builtin_amdgcn_s_setprio(1); qkt<BF>(p0, p1, K_lds, r32, hi, qr); __builtin_amdgcn_s_setprio(0); \
        { const int kb_ = (t) * 64; if (kb_ + 63 > qlo) mask_tile(p0, p1, qm - kb_); } \
        softmax_tile(p0, p1, m_reg, alpha, pk, (t) == 0); \
        if (__any(alpha < 1.f)) { if (hi == 0) al_l[r32] = alpha; asm volatile("s_waitcnt lgkmcnt(0)" ::: "memory"); \
            _Pragma("unroll") for (int r = 0; r < 16; ++r) { const float a_ = al_l[crow(r, hi)]; lacc[r] *= a_; _Pragma("unroll") for (int d_ = 0; d_ < 4; ++d_) o[d_][r] *= a_; } } \
        __builtin_amdgcn_s_setprio(1); pv_tile<BF>(o, lacc, V_lds, r32, hi, pk); __builtin_amdgcn_s_setprio(0); SBAR(); } while (0)
    SDMA(0, 0); SDMA(1, 1); VM_WAIT(); __syncthreads();
    for (int t = 0; t < NT; t += 4) {
        SDMA(t + 2, 2); SDMA(t + 3, 3); SBAR();
        TILE(t, 0); TILE(t + 1, 1);
        VM_WAIT(); __syncthreads();
        if (t + 4 < NT) { SDMA(t + 4, 0); SDMA(t + 5, 1); } SBAR();
        TILE(t + 2, 2); TILE(t + 3, 3);
        VM_WAIT(); __syncthreads(); }
#undef TILE
#undef SDMA
#undef SOFF
    float* stg = (float*)lds + wid * 4096;
    float rli[16];
#pragma unroll
    for (int r = 0; r < 16; ++r) rli[r] = __builtin_amdgcn_rcpf(lacc[r]);
    const int le = lane_id(), r32e = le & 31, hie = le >> 5;
#pragma unroll
    for (int r = 0; r < 16; ++r) { const int orow = crow(r, hie);
#pragma unroll
        for (int d0 = 0; d0 < 4; ++d0) stg[orow * 128 + d0 * 32 + r32e] = o[d0][r] * rli[r]; }
    asm volatile("s_waitcnt lgkmcnt(0)" ::: "memory");
    const int b = bh >> 4, h = bh & 15;
#pragma unroll 4
    for (int it = 0; it < 16; ++it) { const int row = 2 * it + hie, c4 = r32e * 4;
        const f32x4 ov = *(const f32x4*)(stg + row * 128 + c4);
        const size_t off = ((size_t)b * SEQL + qlo + row) * D_MODEL + h * DVH + c4;
        const v2u ga = *(const v2u*)(GA + off), ob = *(const v2u*)(MG + off);
        v2u w; w.x = cvt_pk_bf16(bf_lo(ga.x) * ov[0] + bf_lo(ob.x), bf_hi(ga.x) * ov[1] + bf_hi(ob.x)); w.y = cvt_pk_bf16(bf_lo(ga.y) * ov[2] + bf_lo(ob.y), bf_hi(ga.y) * ov[3] + bf_hi(ob.y));
        *(v2u*)(MG + off) = w; }
    __syncthreads();
}
#undef KSWZ
}

__device__ __forceinline__ void ce_desc(float& a, float& b) { const float hi = fmaxf(a, b), lo = fminf(a, b); a = hi; b = lo; }
template <int N> __device__ __forceinline__ void bitonic_sort_desc(float (&v)[N]) {
#pragma unroll
    for (int k = 2; k <= N; k <<= 1)
#pragma unroll
        for (int j = k >> 1; j > 0; j >>= 1)
#pragma unroll
            for (int i = 0; i < N; ++i) { const int l = i ^ j; if (l > i) { if ((i & k) == 0) ce_desc(v[i], v[l]); else ce_desc(v[l], v[i]); } }
}
template <int N> __device__ __forceinline__ void bitonic_merge_desc(float (&v)[N]) {
#pragma unroll
    for (int j = N >> 1; j > 0; j >>= 1)
#pragma unroll
        for (int i = 0; i < N; ++i) { const int l = i ^ j; if (l > i) ce_desc(v[i], v[l]); }
}
__device__ __forceinline__ void merge_top16(float (&a)[16], const float (&b)[16]) {
#pragma unroll
    for (int i = 0; i < 16; ++i) a[i] = fmaxf(a[i], b[15 - i]);
    bitonic_merge_desc<16>(a);
}
__device__ __forceinline__ void topk_unit(const Frame& F, int tg, int h, const bf16* QP, int* TOPI, float* TOPG) {
    const int lane = F.lane, fr = lane & 15, fq = lane >> 4;
    const int t0 = tg * 16;
    LAS float* sl = (LAS float*)(F.lds + 65536) + F.wave * 512;
    float s01[2][16];
#pragma unroll
    for (int p = 0; p < 2; ++p) {
        f32x4 acc[8];
#pragma unroll
        for (int mt = 0; mt < 8; ++mt) acc[mt] = (f32x4){0.f, 0.f, 0.f, 0.f};
        const bf16* qp = QP + (size_t)(t0 + fr) * D_MODEL + h * 256 + p * 128 + 8 * fq;
        const LAS unsigned char* kp = F.lds + p * 32768 + fr * 256;
#pragma unroll
        for (int kk = 0; kk < 4; ++kk) { const bf16x8 bq = *(const bf16x8*)(qp + 32 * kk);
#pragma unroll
            for (int mt = 0; mt < 8; ++mt) { const bf16x8 ak = *(const LAS bf16x8*)(kp + mt * 4096 + (((4 * kk + fq) ^ fr) << 4));
                acc[mt] = __builtin_amdgcn_mfma_f32_16x16x32_bf16(ak, bq, acc[mt], 0, 0, 0); } }
        float a[16], b[16];
#pragma unroll
        for (int mt = 0; mt < 8; ++mt)
#pragma unroll
            for (int e = 0; e < 4; ++e) { const unsigned n = (unsigned)(16 * mt + 4 * fq + e); const float pk = __uint_as_float((__float_as_uint(acc[mt][e]) & ~0x7Fu) | n);
                if (mt < 4) a[mt * 4 + e] = pk; else b[(mt - 4) * 4 + e] = pk; }
        bitonic_sort_desc<16>(a); bitonic_sort_desc<16>(b); merge_top16(a, b);
#pragma unroll
        for (int i = 0; i < 16; ++i) b[i] = shx(a[i], 16, F.lane);
        merge_top16(a, b);
#pragma unroll
        for (int i = 0; i < 16; ++i) b[i] = shx(a[i], 32, F.lane);
        merge_top16(a, b);
#pragma unroll
        for (int i = 0; i < 16; ++i) s01[p][i] = a[i];
    }
    if (fq == 0) {
#pragma unroll
        for (int p = 0; p < 2; ++p)
#pragma unroll
            for (int i = 0; i < 16; ++i) sl[fr * 32 + p * 16 + i] = s01[p][i];
    }
    float c[4][16];
#pragma unroll
    for (int gidx = 0; gidx < 4; ++gidx)
#pragma unroll
        for (int i = 0; i < 16; ++i) c[gidx][i] = -3.0e38f;
#define CAND(n, i, j) do { const float v_ = __uint_as_float(__float_as_uint(s01[0][i]) & ~0x7Fu) + __uint_as_float(__float_as_uint(s01[1][j]) & ~0x7Fu); \
        c[(n) >> 4][(n) & 15] = __uint_as_float((__float_as_uint(v_) & ~0xFFu) | (unsigned)((i) * 16 + (j))); } while (0)
    CAND(0, 0, 0); CAND(1, 0, 1); CAND(2, 0, 2); CAND(3, 0, 3); CAND(4, 0, 4); CAND(5, 0, 5); CAND(6, 0, 6); CAND(7, 0, 7);
    CAND(8, 0, 8); CAND(9, 0, 9); CAND(10, 0, 10); CAND(11, 0, 11); CAND(12, 0, 12); CAND(13, 0, 13); CAND(14, 0, 14); CAND(15, 0, 15);
    CAND(16, 1, 0); CAND(17, 1, 1); CAND(18, 1, 2); CAND(19, 1, 3); CAND(20, 1, 4); CAND(21, 1, 5); CAND(22, 1, 6); CAND(23, 1, 7);
    CAND(24, 2, 0); CAND(25, 2, 1); CAND(26, 2, 2); CAND(27, 2, 3); CAND(28, 2, 4);
    CAND(29, 3, 0); CAND(30, 3, 1); CAND(31, 3, 2); CAND(32, 3, 3);
    CAND(33, 4, 0); CAND(34, 4, 1); CAND(35, 4, 2);
    CAND(36, 5, 0); CAND(37, 5, 1); CAND(38, 6, 0); CAND(39, 6, 1); CAND(40, 7, 0); CAND(41, 7, 1);
    CAND(42, 8, 0); CAND(43, 9, 0); CAND(44, 10, 0); CAND(45, 11, 0); CAND(46, 12, 0); CAND(47, 13, 0); CAND(48, 14, 0); CAND(49, 15, 0);
#undef CAND
    bitonic_sort_desc<16>(c[0]); bitonic_sort_desc<16>(c[1]); bitonic_sort_desc<16>(c[2]); bitonic_sort_desc<16>(c[3]);
    merge_top16(c[0], c[1]); merge_top16(c[2], c[3]); merge_top16(c[0], c[2]);
    LDS_WAIT(); asm volatile("" ::: "memory");
    float sc[16]; int ix[16]; float mx = -3.0e38f;
#pragma unroll
    for (int w = 0; w < 16; ++w) { const unsigned id = __float_as_uint(c[0][w]) & 0xFFu; const unsigned u0 = __float_as_uint(sl[fr * 32 + (id >> 4)]), u1 = __float_as_uint(sl[fr * 32 + 16 + (id & 15)]);
        sc[w] = __uint_as_float(u0 & ~0x7Fu) + __uint_as_float(u1 & ~0x7Fu); ix[w] = (int)((u0 & 0x7Fu) * NKEYS + (u1 & 0x7Fu)); mx = fmaxf(mx, sc[w]); }
    float sum = 0.f;
#pragma unroll
    for (int w = 0; w < 16; ++w) { sc[w] = __builtin_amdgcn_exp2f((sc[w] - mx) * 1.4426950409f); sum += sc[w]; }
    const float rs = __builtin_amdgcn_rcpf(sum);
    if (fq == 0) { int* ti = TOPI + (size_t)(t0 + fr) * 128 + h * 16; float* tgp = TOPG + (size_t)(t0 + fr) * 128 + h * 16;
#pragma unroll
        for (int w = 0; w < 16; ++w) { ti[w] = ix[w]; tgp[w] = sc[w] * rs; } }
    LDS_WAIT(); asm volatile("" ::: "memory");
}

typedef float f32x2 __attribute__((ext_vector_type(2)));
struct PeerIdx { int i0, i1; float a0, a1; };
struct PeerRow { v4u x; float xs; };
__device__ __forceinline__ void pu_gather(int t, int sl, int lane, const PeerIdx& I, v4u (&wu)[16], PeerRow& R, const unsigned char* XQ, const float* XS, const unsigned char* PU8) {
    const int r = lane & 7, g = lane >> 3;
    const unsigned char* sb = PU8 + (size_t)sl * NEXP * 128;
#pragma unroll
    for (int k = 0; k < 16; ++k) { const int e = __shfl(k < 8 ? I.i0 : I.i1, (8 * k + g) & 63); unsigned o_ = (unsigned)(e * 128 + 16 * r); asm volatile("" : "+v"(o_)); wu[k] = *(const v4u*)(sb + o_); }
    R.x = NTL((const v4u*)(XQ + (size_t)t * D_MODEL + 128 * sl + 16 * r)); R.xs = XS[(size_t)t * 16 + sl];
}
__device__ __forceinline__ void pu_compute(int t, int sl, int lane, const v4u (&wu)[16], const PeerRow& R, bf16* PART) {
    const int r = lane & 7, g = lane >> 3;
    float d[16];
#pragma unroll
    for (int k = 0; k < 16; ++k) { int a_ = __builtin_amdgcn_sdot4((int)wu[k].x, (int)R.x.x, 0, false); a_ = __builtin_amdgcn_sdot4((int)wu[k].y, (int)R.x.y, a_, false);
        a_ = __builtin_amdgcn_sdot4((int)wu[k].z, (int)R.x.z, a_, false); a_ = __builtin_amdgcn_sdot4((int)wu[k].w, (int)R.x.w, a_, false); d[k] = (float)a_; }
    const bool b0 = lane & 1, b1 = lane & 2, b2 = lane & 4;
    float res[2];
#pragma unroll
    for (int hf = 0; hf < 2; ++hf) { float e1[4], f1[2];
#pragma unroll
        for (int m = 0; m < 4; ++m) e1[m] = (b0 ? d[8 * hf + 2 * m + 1] : d[8 * hf + 2 * m]) + shx(b0 ? d[8 * hf + 2 * m] : d[8 * hf + 2 * m + 1], 1, lane);
#pragma unroll
        for (int n = 0; n < 2; ++n) f1[n] = (b1 ? e1[2 * n + 1] : e1[2 * n]) + shx(b1 ? e1[2 * n] : e1[2 * n + 1], 2, lane);
        res[hf] = (b2 ? f1[1] : f1[0]) + shx(b2 ? f1[0] : f1[1], 4, lane); }
    *(unsigned*)(PART + ((size_t)t * 16 + sl) * 128 + 16 * r + 2 * g) = cvt_pk_bf16(res[0] * R.xs, res[1] * R.xs);
}
__device__ __forceinline__ void peer_fin_token(int t, int lane, const bf16* PART, const int* TOPI, float* TOPG, const float* USC, const float* VSC, const u64* sqx) {
    const float r2 = __builtin_amdgcn_rsqf(fx_get(sqx + t) * (1.f / D_MODEL) + EPS);
    float s0 = 0.f, s1 = 0.f;
#pragma unroll
    for (int sl = 0; sl < 16; ++sl) { const unsigned w = NTL((const unsigned*)(PART + ((size_t)t * 16 + sl) * 128 + 16 * (lane >> 3) + 2 * (lane & 7))); s0 += bf_lo(w); s1 += bf_hi(w); }
    const int e0 = TOPI[(size_t)t * 128 + lane], e1 = TOPI[(size_t)t * 128 + 64 + lane];
    float* gp = TOPG + (size_t)t * 128;
    gp[lane] = gelu_t(s0 * USC[e0] * r2) * gp[lane] * VSC[e0]; gp[64 + lane] = gelu_t(s1 * USC[e1] * r2) * gp[64 + lane] * VSC[e1];
}
__device__ __forceinline__ void pv_gather(int t, int sl, int lane, const PeerIdx& I, v4u (&wv)[16], float (&xv)[2], const bf16* X, const unsigned char* PV8) {
    const int r = lane & 7, g = lane >> 3;
    const unsigned char* sb = PV8 + (size_t)sl * NEXP * 128;
#pragma unroll
    for (int k = 0; k < 16; ++k) { const int e = __shfl(k < 8 ? I.i0 : I.i1, (8 * k + g) & 63); unsigned o_ = (unsigned)(e * 128 + 16 * r); asm volatile("" : "+v"(o_)); wv[k] = *(const v4u*)(sb + o_); }
    const int cb = 16 * r + ((lane & 8) ? 8 : 0) + ((lane & 16) ? 4 : 0) + ((lane & 32) ? 2 : 0);
    const unsigned xw = *(const unsigned*)(X + (size_t)t * D_MODEL + 128 * sl + cb); xv[0] = bf_lo(xw); xv[1] = bf_hi(xw);
}
__device__ __forceinline__ void pv_compute(int t, int sl, int lane, const PeerIdx& I, const v4u (&wv)[16], const float (&xv)[2], bf16* X, u64* ssq2) {
    const int r = lane & 7, g = lane >> 3;
    float oa[16];
    { f32x2 o2[8]; float ak[16];
#pragma unroll
      for (int e = 0; e < 8; ++e) o2[e] = (f32x2){0.f, 0.f};
#pragma unroll
      for (int k = 0; k < 16; ++k) ak[k] = __shfl(k < 8 ? I.a0 : I.a1, (8 * k + g) & 63);
#pragma unroll
      for (int k = 0; k < 16; ++k) { const f32x2 a2 = {ak[k], ak[k]};
#pragma unroll
          for (int q = 0; q < 4; ++q) { const int w_ = (int)(q == 0 ? wv[k].x : q == 1 ? wv[k].y : q == 2 ? wv[k].z : wv[k].w);
              o2[2 * q] += __builtin_amdgcn_cvt_pk_f32_fp8(w_, false) * a2; o2[2 * q + 1] += __builtin_amdgcn_cvt_pk_f32_fp8(w_, true) * a2; } }
#pragma unroll
      for (int e = 0; e < 8; ++e) { oa[2 * e] = o2[e][0]; oa[2 * e + 1] = o2[e][1]; } }
    const bool c0 = lane & 8, c1 = lane & 16, c2 = lane & 32;
    float p1[8], p2[4], p3[2];
#pragma unroll
    for (int m = 0; m < 8; ++m) p1[m] = (c0 ? oa[m + 8] : oa[m]) + shx(c0 ? oa[m] : oa[m + 8], 8, lane);
#pragma unroll
    for (int n = 0; n < 4; ++n) p2[n] = (c1 ? p1[n + 4] : p1[n]) + shx(c1 ? p1[n] : p1[n + 4], 16, lane);
#pragma unroll
    for (int q = 0; q < 2; ++q) p3[q] = (c2 ? p2[q + 2] : p2[q]) + shx(c2 ? p2[q] : p2[q + 2], 32, lane);
    const int cb = 16 * r + (c0 ? 8 : 0) + (c1 ? 4 : 0) + (c2 ? 2 : 0);
    const float y0 = xv[0] + p3[0], y1 = xv[1] + p3[1];
    *(unsigned*)(X + (size_t)t * D_MODEL + 128 * sl + cb) = cvt_pk_bf16(y0, y1);
    const float ss = wave_sum(y0 * y0 + y1 * y1, lane);
    if (lane == 0) fx_add(ssq2 + t, ss);
}
__device__ __forceinline__ void row8_load(f32x4 (&v)[8], const float* src, int lane) {
    const f32x4* xr = (const f32x4*)src + lane;
#pragma unroll
    for (int j = 0; j < 8; ++j) v[j] = __builtin_nontemporal_load(xr + 64 * j);
}
__device__ __forceinline__ unsigned pack_i8x4(f32x4 v) {
    int i[4];
#pragma unroll
    for (int e = 0; e < 4; ++e) i[e] = (int)__builtin_rintf(__builtin_amdgcn_fmed3f(v[e], -127.f, 127.f));
    const unsigned lo = __builtin_amdgcn_perm((unsigned)i[1], (unsigned)i[0], 0x0c0c0400u), hi = __builtin_amdgcn_perm((unsigned)i[3], (unsigned)i[2], 0x0c0c0400u);
    return __builtin_amdgcn_perm(hi, lo, 0x05040100u); }
template <bool I8>
__device__ __forceinline__ void row_to_fp8(f32x4 (&v)[8], unsigned char* tab, int e, float* inv_scale, int lane, const f32x4* colmul) {
    float am = 0.f;
#pragma unroll
    for (int j = 0; j < 8; ++j) { if (colmul) v[j] = v[j] * colmul[j];
        am = fmaxf(am, fmaxf(fmaxf(fabsf(v[j][0]), fabsf(v[j][1])), fmaxf(fabsf(v[j][2]), fabsf(v[j][3])))); }
#pragma unroll
    for (int o = 1; o < 64; o <<= 1) am = fmaxf(am, shx(am, o, lane));
    am = fmaxf(am, 1e-30f); const float sc = (I8 ? 127.f : 256.f) / am;
#pragma unroll
    for (int j = 0; j < 8; ++j) { int w = 0; if constexpr (I8) w = (int)pack_i8x4(v[j] * sc); else { w = __builtin_amdgcn_cvt_pk_fp8_f32(v[j][0] * sc, v[j][1] * sc, w, false); w = __builtin_amdgcn_cvt_pk_fp8_f32(v[j][2] * sc, v[j][3] * sc, w, true); } const int dw = lane + 64 * j; unsigned o_ = (unsigned)(dw >> 5) * (unsigned)(NEXP * 128) + (unsigned)(dw & 31) * 4u; asm volatile("" : "+v"(o_)); *(unsigned*)(tab + (size_t)e * 128 + o_) = (unsigned)w; }
    if (lane == 0) *inv_scale = am * (I8 ? 1.f / 127.f : 1.f / 256.f);
}

__global__ void __launch_bounds__(512, 2) mk_fwd(Args args) {
    extern __shared__ __attribute__((aligned(16))) unsigned char lds[];
    Frame F;
    F.lds = (LAS unsigned char*)lds;
    F.wave = __builtin_amdgcn_readfirstlane((int)threadIdx.x >> 6); F.lane = lane_id(); F.tid = F.wave * 64 + F.lane;
    F.G = gridDim.x; { const int bx = blockIdx.x; F.vcu = (F.G % 8 == 0) ? (bx % 8) * (F.G / 8) + bx / 8 : bx; }
    unsigned char* ws = args.ws;
    gu32* ctl = (gu32*)(ws + WS_CTL);
    volatile LAS unsigned* MISC = (volatile LAS unsigned*)(F.lds + MISC_OFF);
    for (int u = F.tid; u < (LDS_BYTES - LDSCTL_OFF) / 4; u += 512) ((LAS unsigned*)(F.lds + LDSCTL_OFF))[u] = 0u;
    __syncthreads();
    XcdBarrier bar; bar.bar = (unsigned*)(ctl + CW_BAR); bar.x = 0; bar.st = nullptr;
    bar = xcd_barrier_post((unsigned*)(ctl + CW_BAR), MISC + 8, F.wave);
#define GRID_BAR() xcd_barrier(bar)
#define PHASE_BEGIN() do { F.lane = lane_id(); asm volatile("" : "+v"(F.lane)); F.tid = F.wave * 64 + F.lane; } while (0)
    const float* x = args.in[0]; const int* positions = (const int*)args.in[1]; const float* g_norm1 = args.in[2]; const float* w_in = args.in[3];
    const float* g_q_a = args.in[4]; const float* w_uq = args.in[5]; const float* g_kv_a = args.in[6]; const float* w_ukv = args.in[7];
    const float* sgu_ln_g = args.in[8]; const float* sgu_ln_b = args.in[9]; const float* w_spatial = args.in[10]; const float* b_spatial = args.in[11];
    const float* b_gate = args.in[12]; const float* w_out = args.in[13]; const float* g_norm2 = args.in[14]; const float* w_peer_q = args.in[15];
    const float* peer_keys = args.in[16]; const float* peer_u = args.in[17]; const float* peer_v = args.in[18]; const float* g_final = args.in[19];
    float* out = args.out;
    bf16* KEYS = (bf16*)(ws + WS_KEYS); bf16* WSP = (bf16*)(ws + WS_WSP); bf16* WUQ = (bf16*)(ws + WS_WUQ); bf16* WUKV = (bf16*)(ws + WS_WUKV);
    bf16* WOUT = (bf16*)(ws + WS_WOUT); bf16* WPQ = (bf16*)(ws + WS_WPQ); float* ROPE = (float*)(ws + WS_ROPE);
    unsigned char* XN8 = ws + WS_XN8; unsigned char* WIN8 = ws + WS_WIN8; unsigned char* CQKV = ws + WS_CQKV; bf16* U = (bf16*)(ws + WS_U); bf16* VG = (bf16*)(ws + WS_VG);
    unsigned char* Vb = ws + WS_V; unsigned char* Kb = ws + WS_K; unsigned char* KR = ws + WS_KR; unsigned char* Qb = ws + WS_Q; bf16* GA = (bf16*)(ws + WS_GA); bf16* X2 = (bf16*)(ws + WS_X2);
    bf16* X1B = (bf16*)(ws + WS_X1B); unsigned char* PU = ws + WS_PU; unsigned char* PV = ws + WS_PV; float* USC = (float*)(ws + WS_PSC); float* VSC = USC + NEXP; bf16* PART = (bf16*)(ws + WS_PART); bf16* QP = (bf16*)(ws + WS_QP);
    int* TOPI = (int*)(ws + WS_TOPI); float* TOPG = (float*)(ws + WS_TOPG); unsigned char* X1Q = ws + WS_X1Q; float* XS = (float*)(ws + WS_XS);
    u64* SQQ = (u64*)(ws + CTL_STATS); u64* SQKV = SQQ + MTOK; u64* SSUM = SQKV + MTOK; u64* SSQ = SSUM + MTOK; u64* SQX1 = SSQ + MTOK;
    const int gw = F.vcu * 8 + F.wave, NGW = F.G * 8;

    {
        LAS float* scr = (LAS float*)(F.lds + RING_OFF + F.wave * 16384);
        constexpr int I_IN8 = (D_MODEL / 64) * (IN8_ROWS / 32), I_UQ = (QL / 64) * (NQ_COLS / 32), I_UKV = (QL / 64) * (NKV_COLS / 32), I_O = (D_MODEL / 64) * (D_MODEL / 32);
        constexpr int NITEMS = I_IN8 + I_UQ + I_UKV + 2 * I_O;
        for (int it = gw; it < NITEMS; it += NGW) {
            int r = it;
            if (r < I_IN8) { p0_transpose_item<true>(w_in, D_MODEL, IN_COLS, (bf16*)WIN8, IN8_ROWS, 3, nullptr, scr, r, F.lane); continue; } r -= I_IN8;
            if (r < I_UQ) { p0_transpose_item<true>(w_uq, QL, NQ_COLS, WUQ, NQ_COLS, 2, g_q_a, scr, r, F.lane); continue; } r -= I_UQ;
            if (r < I_UKV) { p0_transpose_item<true>(w_ukv, QL, NKV_COLS, WUKV, NKV_COLS, 0, g_kv_a, scr, r, F.lane); continue; } r -= I_UKV;
            if (r < I_O) { p0_transpose_item(w_out, D_MODEL, D_MODEL, WOUT, D_MODEL, 0, nullptr, scr, r, F.lane); continue; } r -= I_O;
            p0_transpose_item(w_peer_q, D_MODEL, D_MODEL, WPQ, D_MODEL, 0, g_norm2, scr, r, F.lane);
        }
        {
#define XN_LOAD(v, m_) do { const f32x4* xr_ = (const f32x4*)(x + (size_t)(m_) * D_MODEL) + F.lane; _Pragma("unroll") for (int j = 0; j < 8; ++j) v[j] = __builtin_nontemporal_load(xr_ + 64 * j); } while (0)
#define XN_DO(v, m_) do { float s_ = 0.f; _Pragma("unroll") for (int j = 0; j < 8; ++j) s_ += (v[j][0] * v[j][0] + v[j][1] * v[j][1]) + (v[j][2] * v[j][2] + v[j][3] * v[j][3]); \
            const float r_ = __builtin_amdgcn_rsqf(wave_sum(s_, F.lane) * (1.f / D_MODEL) + EPS); \
            _Pragma("unroll") for (int j = 0; j < 8; ++j) { const f32x4 h_ = v[j] * r_ * gn[j]; \
                const f32x4 h8_ = __builtin_elementwise_min(__builtin_elementwise_max(h_ * XN8_SCALE, (f32x4){-448.f, -448.f, -448.f, -448.f}), (f32x4){448.f, 448.f, 448.f, 448.f}); \
                int p_ = 0; p_ = __builtin_amdgcn_cvt_pk_fp8_f32(h8_[0], h8_[1], p_, false); p_ = __builtin_amdgcn_cvt_pk_fp8_f32(h8_[2], h8_[3], p_, true); ((unsigned*)(XN8 + (size_t)(m_) * D_MODEL))[F.lane + 64 * j] = (unsigned)p_; } } while (0)
            f32x4 gn[8];
#pragma unroll
            for (int j = 0; j < 8; ++j) gn[j] = *((const f32x4*)g_norm1 + F.lane + 64 * j);
            f32x4 va[8], vb[8]; int m = gw; if (m < MTOK) XN_LOAD(va, m);
#pragma unroll 1
            for (; m < MTOK; m += 2 * NGW) {
                if (m + NGW < MTOK) XN_LOAD(vb, m + NGW);
                XN_DO(va, m);
                if (m + NGW < MTOK) { if (m + 2 * NGW < MTOK) XN_LOAD(va, m + 2 * NGW); XN_DO(vb, m + NGW); } }
#undef XN_LOAD
#undef XN_DO
        }
        for (int it = gw; it < MTOK / 2; it += NGW) { const int row = 2 * it + (F.lane >> 5), i = F.lane & 31;
            const float freq = exp2f(-(float)i * (13.287712379549449f / 32.f)); const float ang = (float)positions[row] * freq;
            const double ad = (double)ang; const double k = __builtin_rint(ad * 0.15915494309189535); const float red = (float)(ad - k * 6.283185307179586);
            ROPE[(size_t)row * 32 + i] = __cosf(red); ROPE[(size_t)MTOK * 32 + (size_t)row * 32 + i] = __sinf(red); }
        for (int it = gw; it < (PHEADS * 2 * NKEYS * KD) / 512; it += NGW) { const size_t e = (size_t)it * 512 + 8 * F.lane; const f32x4 a = *(const f32x4*)(peer_keys + e), b = *(const f32x4*)(peer_keys + e + 4);
            v4u w; w.x = cvt_pk_bf16(a[0], a[1]); w.y = cvt_pk_bf16(a[2], a[3]); w.z = cvt_pk_bf16(b[0], b[1]); w.w = cvt_pk_bf16(b[2], b[3]); *(v4u*)(KEYS + e) = w; }
        for (int it = gw; it < (8 * 128 * 128) / 512; it += NGW) { const size_t e = (size_t)it * 512 + 8 * F.lane; const int t = (int)((e >> 7) & 127), s0 = (int)(e & 127);
            const f32x4 a = *(const f32x4*)(w_spatial + e), b = *(const f32x4*)(w_spatial + e + 4); float v[8] = {a[0], a[1], a[2], a[3], b[0], b[1], b[2], b[3]};
#pragma unroll
            for (int j = 0; j < 8; ++j) if (s0 + j > t) v[j] = 0.f;
            v4u w; w.x = cvt_pk_bf16(v[0], v[1]); w.y = cvt_pk_bf16(v[2], v[3]); w.z = cvt_pk_bf16(v[4], v[5]); w.w = cvt_pk_bf16(v[6], v[7]); *(v4u*)(WSP + e) = w; }
        for (size_t it = (size_t)gw * 64 + F.lane; it < (size_t)5 * MTOK; it += (size_t)NGW * 64) SQQ[it] = 0ull;
        GRID_BAR();
    }
    {
        PHASE_BEGIN();
        pg8::EpiIn E{0, IN8_DESCALE, U, GA, VG, CQKV, KR, b_gate, ROPE, SQQ, SQKV, SSUM, SSQ};
        { pg8::Gemm g{(const bf16*)XN8, (const bf16*)WIN8, MTOK, IN8_ROWS, D_MODEL / 2, D_MODEL / 2}; pg8::StaticOrder S; S.init(MTOK, IN8_ROWS, F.G, (int)blockIdx.x);
          pg8::gemm_phase<pg8::EpiIn, pg8::StaticOrder, true, true, true>(F.lds + RING_OFF, g, S, E, F.wave); }
        GRID_BAR();
    }
    {
        PHASE_BEGIN();
        { pg8::Gemm g{(const bf16*)CQKV, WUQ, MTOK, NQ_COLS, QL / 2, 512}; pg8::StaticOrder S; S.init(MTOK, NQ_COLS, F.G, (int)blockIdx.x);
          pg8::EpiQ E{Qb, SQQ, ROPE}; pg8::gemm_phase<pg8::EpiQ, pg8::StaticOrder, true, true, true>(F.lds + RING_OFF, g, S, E, F.wave); }
        { pg8::Gemm g{(const bf16*)(CQKV + QL), WUKV, MTOK, NKV_COLS, QL / 2, 512}; pg8::StaticOrder S; S.init(MTOK, NKV_COLS, F.G, (int)blockIdx.x);
          pg8::EpiKV E{Kb, Vb, SQKV}; pg8::gemm_phase<pg8::EpiKV, pg8::StaticOrder, true, true, true, true>(F.lds + RING_OFF, g, S, E, F.wave); }
        PHASE_BEGIN();
        for (int un = F.vcu; un < (MTOK / 128) * 8; un += F.G) sgu_unit(F, un, VG, U, WSP, sgu_ln_g, sgu_ln_b, b_spatial, SSUM, SSQ);
        GRID_BAR();
    }
    {
        PHASE_BEGIN();
        if (F.G == 256) { const int s = F.vcu & 7, bh = F.vcu >> 3;
#pragma unroll 1
            for (int i = 0; i < 4; ++i) { const int qb = (i == 0) ? s : (i == 1) ? 15 - s : (i == 2) ? 16 + s : 31 - s; att::attn_unit(bh, qb, Qb, Kb, KR, Vb, GA, U, (char*)lds + RING_OFF, F.lds + RING_OFF, F.wave); }
        } else {
#pragma unroll 1
            for (int un = F.vcu; un < 1024; un += F.G) att::attn_unit(un >> 5, 31 - (un & 31), Qb, Kb, KR, Vb, GA, U, (char*)lds + RING_OFF, F.lds + RING_OFF, F.wave);
        }
        GRID_BAR();
    }
    {
        PHASE_BEGIN();
        for (int it = gw * 64 + F.lane; it < MTOK; it += NGW * 64) SQQ[it] = 0ull;
        { f32x4 va[8], vb[8];
#define CONV_ROWS(SRC, TAB, SC, I8_, CM) do { int e = gw; if (e < NEXP) row8_load(va, SRC + (size_t)e * D_MODEL, F.lane); \
          _Pragma("unroll 1") for (; e < NEXP; e += 2 * NGW) { \
              if (e + NGW < NEXP) row8_load(vb, SRC + (size_t)(e + NGW) * D_MODEL, F.lane); \
              row_to_fp8<I8_>(va, TAB, e, SC + e, F.lane, CM); \
              if (e + NGW < NEXP) { if (e + 2 * NGW < NEXP) row8_load(va, SRC + (size_t)(e + 2 * NGW) * D_MODEL, F.lane); row_to_fp8<I8_>(vb, TAB, e + NGW, SC + e + NGW, F.lane, CM); } } } while (0)
          f32x4 gn2[8];
#pragma unroll
          for (int j = 0; j < 8; ++j) gn2[j] = *((const f32x4*)g_norm2 + F.lane + 64 * j);
          CONV_ROWS(peer_u, PU, USC, true, gn2);
          CONV_ROWS(peer_v, PV, VSC, false, (const f32x4*)nullptr);
#undef CONV_ROWS
        }
        VM_WAIT(); __syncthreads();
        pg8::Gemm g{U, WOUT, MTOK, D_MODEL, D_MODEL, D_MODEL}; pg8::StaticOrder S; S.init(MTOK, D_MODEL, F.G, (int)blockIdx.x);
        pg8::EpiOut E{x, X1B, SQX1}; pg8::gemm_phase<pg8::EpiOut, pg8::StaticOrder, true, true>(F.lds + RING_OFF, g, S, E, F.wave);
        GRID_BAR();
    }
    {
        PHASE_BEGIN();
        pg8::Gemm g{X1B, WPQ, MTOK, D_MODEL, D_MODEL, D_MODEL}; pg8::StaticOrder S; S.init(MTOK, D_MODEL, F.G, (int)blockIdx.x);
        pg8::EpiPQ E{QP, SQX1}; pg8::gemm_phase<pg8::EpiPQ, pg8::StaticOrder, true, true>(F.lds + RING_OFF, g, S, E, F.wave);
        GRID_BAR();
    }
    {
        PHASE_BEGIN();
#pragma unroll 1
        for (int t = gw; t < MTOK; t += NGW) { const bf16* xp = X1B + (size_t)t * D_MODEL + 32 * F.lane; v4u xw[4];
#pragma unroll
            for (int j = 0; j < 4; ++j) xw[j] = *(const v4u*)(xp + 8 * j);
            float xf[32]; float am = 0.f;
#pragma unroll
            for (int j = 0; j < 4; ++j) { const unsigned w4[4] = {xw[j].x, xw[j].y, xw[j].z, xw[j].w};
#pragma unroll
                for (int q = 0; q < 4; ++q) { xf[8 * j + 2 * q] = bf_lo(w4[q]); xf[8 * j + 2 * q + 1] = bf_hi(w4[q]); am = fmaxf(am, fmaxf(fabsf(xf[8 * j + 2 * q]), fabsf(xf[8 * j + 2 * q + 1]))); } }
            am = fmaxf(am, shx(am, 1, F.lane)); am = fmaxf(am, shx(am, 2, F.lane)); am = fmaxf(am, 1e-30f);
            const float sc = 127.f / am; v4u q0, q1;
            q0.x = pack_i8x4((f32x4){xf[0], xf[1], xf[2], xf[3]} * sc); q0.y = pack_i8x4((f32x4){xf[4], xf[5], xf[6], xf[7]} * sc); q0.z = pack_i8x4((f32x4){xf[8], xf[9], xf[10], xf[11]} * sc); q0.w = pack_i8x4((f32x4){xf[12], xf[13], xf[14], xf[15]} * sc);
            q1.x = pack_i8x4((f32x4){xf[16], xf[17], xf[18], xf[19]} * sc); q1.y = pack_i8x4((f32x4){xf[20], xf[21], xf[22], xf[23]} * sc); q1.z = pack_i8x4((f32x4){xf[24], xf[25], xf[26], xf[27]} * sc); q1.w = pack_i8x4((f32x4){xf[28], xf[29], xf[30], xf[31]} * sc);
            unsigned char* qp = X1Q + (size_t)t * D_MODEL + 32 * F.lane; *(v4u*)qp = q0; *(v4u*)(qp + 16) = q1;
            if ((F.lane & 3) == 0) XS[(size_t)t * 16 + (F.lane >> 2)] = am * (1.f / 127.f); }
        { const int NH8 = (F.G % 8 == 0) ? 8 : 1, grp = (int)blockIdx.x % NH8, bi = (int)blockIdx.x / NH8, nbl = F.G / NH8;
#pragma unroll 1
          for (int h = grp; h < PHEADS; h += NH8) {
#pragma unroll
              for (int it = 0; it < 8; ++it) { const int id = it * 512 + F.tid, c = id & 15, n = (id >> 4) & 127, pp = id >> 11;
                  const v4u w = *(const v4u*)(KEYS + ((size_t)(h * 2 + pp) * NKEYS + n) * KD + 8 * c);
                  *(LAS v4u*)(F.lds + pp * 32768 + n * 256 + ((c ^ (n & 15)) << 4)) = w; }
              __syncthreads();
#pragma unroll 1
              for (int tg = bi * 8 + F.wave; tg < MTOK / 16; tg += nbl * 8) topk_unit(F, tg, h, QP, TOPI, TOPG);
              __syncthreads(); } }
        GRID_BAR();
    }
    {
        PHASE_BEGIN();
        const int NG = (F.G % 8 == 0) ? 8 : 1, grp = (int)blockIdx.x % NG, li = (int)blockIdx.x / NG, nl = F.G / NG;
        const int t0 = li * 8 + F.wave, ts = nl * 8, NTW = (MTOK - t0 + ts - 1) / ts;
#define LOAD_IDX(I, n) do { const int t_ = t0 + (n) * ts; I.i0 = NTL(TOPI + (size_t)t_ * 128 + F.lane); I.i1 = NTL(TOPI + (size_t)t_ * 128 + 64 + F.lane); } while (0)
#pragma unroll 1
        for (int sl = grp; sl < 16; sl += NG) {
            PeerIdx IA, IB; PeerRow RA, RB; v4u wA[16], wB[16];
            LOAD_IDX(IA, 0); pu_gather(t0, sl, F.lane, IA, wA, RA, X1Q, XS, PU); if (NTW > 1) LOAD_IDX(IB, 1);
#pragma unroll 1
            for (int n = 0; n < NTW; n += 2) {
                if (n + 2 < NTW) LOAD_IDX(IA, n + 2);
                if (n + 1 < NTW) pu_gather(t0 + (n + 1) * ts, sl, F.lane, IB, wB, RB, X1Q, XS, PU);
                pu_compute(t0 + n * ts, sl, F.lane, wA, RA, PART);
                if (n + 1 < NTW) {
                    if (n + 3 < NTW) LOAD_IDX(IB, n + 3);
                    if (n + 2 < NTW) pu_gather(t0 + (n + 2) * ts, sl, F.lane, IA, wA, RA, X1Q, XS, PU);
                    pu_compute(t0 + (n + 1) * ts, sl, F.lane, wB, RB, PART); }
            } }
#undef LOAD_IDX
        GRID_BAR();
#pragma unroll 1
        for (int t = gw; t < MTOK; t += NGW) peer_fin_token(t, F.lane, PART, TOPI, TOPG, USC, VSC, SQX1);
        GRID_BAR();
#define LOAD_IDXA(I, n) do { const int t_ = t0 + (n) * ts; I.i0 = NTL(TOPI + (size_t)t_ * 128 + F.lane); I.i1 = NTL(TOPI + (size_t)t_ * 128 + 64 + F.lane); \
            I.a0 = NTL(TOPG + (size_t)t_ * 128 + F.lane); I.a1 = NTL(TOPG + (size_t)t_ * 128 + 64 + F.lane); } while (0)
#pragma unroll 1
        for (int sl = grp; sl < 16; sl += NG) {
            PeerIdx IA, IB, IC; float xA[2], xB[2]; v4u wA[16], wB[16];
            LOAD_IDXA(IA, 0); pv_gather(t0, sl, F.lane, IA, wA, xA, X1B, PV); if (NTW > 1) LOAD_IDXA(IB, 1);
#pragma unroll 1
            for (int n = 0; n < NTW; n += 2) {
                if (n + 2 < NTW) LOAD_IDXA(IC, n + 2);
                if (n + 1 < NTW) pv_gather(t0 + (n + 1) * ts, sl, F.lane, IB, wB, xB, X1B, PV);
                pv_compute(t0 + n * ts, sl, F.lane, IA, wA, xA, X2, SQQ);
                IA = IC;
                if (n + 1 < NTW) {
                    if (n + 3 < NTW) LOAD_IDXA(IC, n + 3);
                    if (n + 2 < NTW) pv_gather(t0 + (n + 2) * ts, sl, F.lane, IA, wA, xA, X1B, PV);
                    pv_compute(t0 + (n + 1) * ts, sl, F.lane, IB, wB, xB, X2, SQQ);
                    IB = IC; }
            } }
#undef LOAD_IDXA
        GRID_BAR();
#pragma unroll 1
        for (int t = gw; t < MTOK; t += NGW) { const float rf = __builtin_amdgcn_rsqf(fx_get(SQQ + t) * (1.f / D_MODEL) + EPS);
            const v2u* xr = (const v2u*)(X2 + (size_t)t * D_MODEL) + F.lane; f32x4* orow = (f32x4*)(out + (size_t)t * D_MODEL) + F.lane;
#pragma unroll
            for (int j = 0; j < 8; ++j) { const v2u xw = NTL(xr + 64 * j); const f32x4 v = {bf_lo(xw.x), bf_hi(xw.x), bf_lo(xw.y), bf_hi(xw.y)}, gg = *((const f32x4*)g_final + F.lane + 64 * j); f32x4 o4;
#pragma unroll
                for (int e = 0; e < 4; ++e) o4[e] = v[e] * rf * gg[e];
                __builtin_nontemporal_store(o4, orow + 64 * j); } }
    }
#undef GRID_BAR
}

extern "C" void kernel_launch(void* const* d_in, const int* in_sizes, int n_in, void* d_out, int out_size, void* d_ws, size_t ws_size, hipStream_t stream) {
    static int grid = 0;
    if (grid == 0) {
        if (n_in != 20 || in_sizes[0] != MTOK * D_MODEL || out_size != MTOK * D_MODEL || ws_size < WS_END) {
            fprintf(stderr, "kernel_launch: unexpected shapes (n_in %d, in0 %d, out %d, ws %zu); nothing launched\n", n_in, n_in > 0 ? in_sizes[0] : -1, out_size, ws_size); grid = -1; return; }
        int dev = 0, cus = 0;
        if (hipGetDevice(&dev) != hipSuccess || hipDeviceGetAttribute(&cus, hipDeviceAttributeMultiprocessorCount, dev) != hipSuccess) { fprintf(stderr, "kernel_launch: device query failed\n"); grid = -1; return; }
        if (hipFuncSetAttribute((const void*)mk_fwd, hipFuncAttributeMaxDynamicSharedMemorySize, LDS_BYTES) != hipSuccess) { fprintf(stderr, "kernel_launch: hipFuncSetAttribute failed\n"); grid = -1; return; }
        (void)hipGetLastError();
        grid = cus;
    }
    if (grid < 0) return;
    (void)hipMemsetAsync((char*)d_ws + WS_CTL, 0, CTL_ZERO_BYTES, stream);
    Args a{};
    for (int i = 0; i < 20; ++i) a.in[i] = (const float*)d_in[i];
    a.out = (float*)d_out; a.ws = (unsigned char*)d_ws;
    hipLaunchKernelGGL(mk_fwd, dim3(grid), dim3(512), LDS_BYTES, stream, a);
    const hipError_t le = hipPeekAtLastError();
    if (le != hipSuccess) fprintf(stderr, "kernel_launch: launch failed: %s\n", hipGetErrorName(le));
}
```

```cpp
#include <hip/hip_runtime.h>
#include <hip/hip_bf16.h>
#include <cstdio>
#include <cstdint>


constexpr int D_MODEL = 2048, NB = 2, SEQL = 8192, MTOK = NB * SEQL;
constexpr int NHEAD = 16, QL = 512, DN = 128, DR = 64, DVH = 128, DQK = 192;
constexpr int IN_COLS = 9280, IN16_ROWS = 2048, IN8_ROWS = 9472;
constexpr float Q8_SCALE = 64.f, K8_SCALE = 8.f, V8_SCALE = 8.f;
constexpr float XN8_SCALE = 8.f, WIN8_SCALE = 64.f, IN8_DESCALE = 1.f / 512.f;
constexpr int NQ_COLS = NHEAD * DQK, NKV_COLS = NHEAD * (DN + DVH);
constexpr int PHEADS = 8, NKEYS = 128, TOPK = 16, KD = 128, NEXP = 16384;
constexpr float EPS = 1e-6f;
#define NTL(p) (*(p))
constexpr float FXS = 16777216.f, FXI = 1.f / 16777216.f;
constexpr float C2Q = 0.07216878364870322f * 1.4426950408889634f;

constexpr size_t MiB = 1u << 20;
constexpr size_t WS_CTL = 0, CTL_ZERO_BYTES = 32 * 1024;
constexpr size_t WS_KEYS = 1 * MiB, WS_WSP = 1 * MiB + 512 * 1024;
constexpr size_t WS_WUQ = 2 * MiB, WS_WUKV = 5 * MiB, WS_WOUT = 9 * MiB, WS_WPQ = 17 * MiB;
constexpr size_t WS_ROPE = 27 * MiB;
constexpr size_t WS_WIN8 = 46 * MiB;
constexpr size_t WS_XN8 = 66 * MiB;
constexpr size_t WS_Q = 32 * MiB;
constexpr size_t WS_CQKV = 128 * MiB;
constexpr size_t WS_U = 160 * MiB;
constexpr size_t WS_VG = 224 * MiB;
constexpr size_t WS_GA = 288 * MiB;
constexpr size_t WS_V = 352 * MiB;
constexpr size_t WS_K = 416 * MiB;
constexpr size_t WS_KR = 504 * MiB;
constexpr size_t WS_X2 = 288 * MiB;
constexpr size_t WS_X1B = 96 * MiB;
constexpr size_t WS_PU = 32 * MiB, WS_PV = 64 * MiB;
constexpr size_t WS_X1Q = 160 * MiB, WS_XS = 192 * MiB;
constexpr size_t WS_PART = 352 * MiB;
constexpr size_t WS_PSC = 31 * MiB;
constexpr size_t WS_QP = 224 * MiB;
constexpr size_t WS_TOPI = 480 * MiB, WS_TOPG = 488 * MiB;
constexpr size_t WS_END = 512 * MiB;
constexpr int CW_BAR = 4096;
constexpr size_t CTL_STATS = 128 * 1024;
constexpr int RING_OFF = 0, RING_BYTES = 131072;
constexpr int LDSCTL_OFF = RING_BYTES, MISC_OFF = LDSCTL_OFF + 320;
constexpr int LDS_BYTES = 147456;

#define GAS __attribute__((address_space(1)))
#define LAS __attribute__((address_space(3)))
typedef unsigned short bf16;
typedef unsigned v4u __attribute__((ext_vector_type(4)));
typedef unsigned v2u __attribute__((ext_vector_type(2)));
typedef float f32x4 __attribute__((ext_vector_type(4)));
typedef float f32x16 __attribute__((ext_vector_type(16)));
typedef short bf16x8 __attribute__((ext_vector_type(8)));
typedef short s16x4 __attribute__((ext_vector_type(4)));
typedef int v8i __attribute__((ext_vector_type(8)));
typedef unsigned long long u64;
#define LDS_WAIT() asm volatile("s_waitcnt lgkmcnt(0)" ::: "memory")
#define VM_WAIT() asm volatile("s_waitcnt vmcnt(0)" ::: "memory")
#define SBAR() __builtin_amdgcn_sched_barrier(0)

typedef float f32x2_t __attribute__((ext_vector_type(2))); typedef __bf16 bf16x2_t __attribute__((ext_vector_type(2)));
__device__ __forceinline__ unsigned cvt_pk_bf16(float lo, float hi) { f32x2_t v = {lo, hi}; bf16x2_t b = __builtin_convertvector(v, bf16x2_t); return __builtin_bit_cast(unsigned, b); }
__device__ __forceinline__ unsigned pack_fp8x4(f32x4 v) {
    v = __builtin_elementwise_min(__builtin_elementwise_max(v, (f32x4){-448.f, -448.f, -448.f, -448.f}), (f32x4){448.f, 448.f, 448.f, 448.f});
    int p = 0; p = __builtin_amdgcn_cvt_pk_fp8_f32(v[0], v[1], p, false); p = __builtin_amdgcn_cvt_pk_fp8_f32(v[2], v[3], p, true); return (unsigned)p; }
__device__ __forceinline__ float bf_lo(unsigned w) { return __uint_as_float(w << 16); }
__device__ __forceinline__ float bf_hi(unsigned w) { return __uint_as_float(w & 0xffff0000u); }
__device__ __forceinline__ float gelu_t(float x) { const float t = x * (1.f + 0.044715f * x * x); const float e = __builtin_amdgcn_exp2f(-2.3022081986f * t); return x * __builtin_amdgcn_rcpf(1.f + e); }
__device__ __forceinline__ float sigmoid_f(float y) { return __builtin_amdgcn_rcpf(1.f + __builtin_amdgcn_exp2f(-1.4426950409f * y)); }
__device__ __forceinline__ void fx_add(u64* p, float v) { const long long q = __float2ll_rn(v * FXS); atomicAdd(p, (u64)q); }
__device__ __forceinline__ float fx_get(const u64* p) { return (float)((double)(long long)(*p) * (double)FXI); }
__device__ __forceinline__ int lane_id() { int l; asm volatile("v_mbcnt_lo_u32_b32 %0, -1, 0\n\tv_mbcnt_hi_u32_b32 %0, -1, %0" : "=v"(l)); return l; }

__device__ __forceinline__ float shx(float v, int o, int lane) { return __builtin_bit_cast(float, __builtin_amdgcn_ds_bpermute((lane ^ o) << 2, __builtin_bit_cast(int, v))); }
__device__ __forceinline__ float wave_sum(float v, int lane) {
    (void)lane;
    v += __builtin_bit_cast(float, __builtin_amdgcn_update_dpp(0, __builtin_bit_cast(int, v), 0xB1, 0xF, 0xF, true));
    v += __builtin_bit_cast(float, __builtin_amdgcn_update_dpp(0, __builtin_bit_cast(int, v), 0x4E, 0xF, 0xF, true));
    v += __builtin_bit_cast(float, __builtin_amdgcn_update_dpp(0, __builtin_bit_cast(int, v), 0x141, 0xF, 0xF, true));
    v += __builtin_bit_cast(float, __builtin_amdgcn_update_dpp(0, __builtin_bit_cast(int, v), 0x140, 0xF, 0xF, true));
    const int vi = __builtin_bit_cast(int, v);
    return (__builtin_bit_cast(float, __builtin_amdgcn_readlane(vi, 0)) + __builtin_bit_cast(float, __builtin_amdgcn_readlane(vi, 16))) +
           (__builtin_bit_cast(float, __builtin_amdgcn_readlane(vi, 32)) + __builtin_bit_cast(float, __builtin_amdgcn_readlane(vi, 48)));
}

namespace pg8 {
#define PG8_LAS __attribute__((address_space(3)))
typedef unsigned short bf16_t;
constexpr int BM = 256, BK = 64, HALF = 128, HTB = HALF * BK * 2, STAGE_BYTES = 8 * HTB, NXCD = 8, WGM = 8;
__host__ __device__ __forceinline__ int lds_byte(int r, int c) { const int st = (r >> 4) * 2 + (c >> 5), rr = r & 15, cc = c & 31, ob = rr * 64 + cc * 2; return st * 1024 + (ob ^ (((ob >> 9) & 1) << 5)); }
__host__ __device__ __forceinline__ void stage_rc(int b, int& R, int& C) { const int st = b / 1024, sb = b % 1024, swz = sb ^ (((sb >> 9) & 1) << 5); R = (st >> 1) * 16 + swz / 64; C = (st & 1) * 32 + (swz % 64) / 2; }
__host__ __device__ __forceinline__ int perm32(int rho) { const int n = rho >> 4, i = rho & 15; return 8 * (i >> 2) + 4 * n + (i & 3); }
struct Unit { int pm, pn; };
struct Gemm { const bf16_t* A; const bf16_t* Bt; int M, N, K, lda; };
struct StaticOrder {
    int nM, nN, nwg, G, c;
    __host__ __device__ void init(int M, int N, int G_, int c_) { nM = M / BM; nN = N / BM; nwg = nM * nN; G = G_; c = c_; }
    __host__ __device__ bool next(int i, Unit& u) const {
        const long L = (long)i * G + c; if (L >= nwg) return false;
        int wgid = (int)L; { const int q = nwg / NXCD, r = nwg % NXCD, xcd = wgid % NXCD, off = wgid / NXCD; wgid = (xcd < r ? xcd * (q + 1) : r * (q + 1) + (xcd - r) * q) + off; }
        const int nig = WGM * nN, gid = wgid / nig, fm = gid * WGM, gsz = (nM - fm) < WGM ? (nM - fm) : WGM;
        u.pm = fm + ((wgid % nig) % gsz); u.pn = (wgid % nig) / gsz; return true;
    }
};
template <class Epi, class Sched, bool ALIGN_EPI = false, bool SP2 = false, bool F8 = false, bool SWAP1 = false>
__device__ __forceinline__ void gemm_phase(PG8_LAS unsigned char* lds, const Gemm g, const Sched& S, const Epi& E, const int wave) {
    int tid = wave * 64 + lane_id(); asm volatile("" : "+v"(tid));
    const int wid = __builtin_amdgcn_readfirstlane(tid >> 6), lane = tid & 63, wr = wid >> 2, wc = wid & 3, fr = lane & 15, fq = lane >> 4;
    const int K = g.K, nt = K / BK, lda = g.lda;
    unsigned voffA[2], voffB[2];
#pragma unroll
    for (int i = 0; i < 2; ++i) { int R, C; stage_rc(tid * 16 + i * 8192, R, C); const int Rb = Epi::PERM ? ((R & ~31) + perm32(R & 31)) : R;
        voffA[i] = (unsigned)(R * lda + C) * 2u; voffB[i] = (unsigned)(Rb * K + C) * 2u; }
    const size_t kstep = (size_t)(BK * 2);
    const size_t hstepA = (size_t)HALF * lda * 2, hstepB = (size_t)HALF * K * 2;
    const size_t tstepA = 2 * hstepA, tstepB = 2 * hstepB;
    const unsigned ldsw = (unsigned)wid * 1024u;
    const int aoff = lds_byte(wr * 64 + fr, fq * 8), boff = lds_byte(wc * 32 + fr, fq * 8);
#define PG8_SA(b, h) (((b) * 2 + (h)) * HTB)
#define PG8_SB(b, h) ((4 + (b) * 2 + (h)) * HTB)
#define PG8_STAGE(bufoff, gbase, voff) do { _Pragma("unroll") for (int _i = 0; _i < 2; ++_i) \
        { unsigned vo_ = (voff)[_i]; asm volatile("" : "+v"(vo_)); __builtin_amdgcn_global_load_lds((const unsigned*)((const char*)(gbase) + vo_), (PG8_LAS unsigned*)(lds + (bufoff) + ldsw + _i * 8192), 16, 0, 0); } } while (0)
#define PG8_LDA(dst, b, h) do { _Pragma("unroll") for (int m = 0; m < 4; ++m) _Pragma("unroll") for (int k = 0; k < 2; ++k) dst[m][k] = *(const PG8_LAS bf16x8*)(lds + PG8_SA(b, h) + aoff + m * 2048 + k * 1024); } while (0)
#define PG8_LDB(dst, b, h) do { _Pragma("unroll") for (int n = 0; n < 2; ++n) _Pragma("unroll") for (int k = 0; k < 2; ++k) dst[n][k] = *(const PG8_LAS bf16x8*)(lds + PG8_SB(b, h) + boff + n * 2048 + k * 1024); } while (0)
#define PG8_CAT(x) __builtin_bit_cast(v8i, __builtin_shufflevector((x)[0], (x)[1], 0, 1, 2, 3, 4, 5, 6, 7, 8, 9, 10, 11, 12, 13, 14, 15))
#define PG8_MMA(ai, bj, At, Bt) do { __builtin_amdgcn_s_setprio(1); _Pragma("unroll") for (int m = 0; m < 4; ++m) _Pragma("unroll") for (int n = 0; n < 2; ++n) { \
        if constexpr (F8 && SWAP1 && (bj) == 1) acc[ai][bj][m][n] = __builtin_amdgcn_mfma_scale_f32_16x16x128_f8f6f4(PG8_CAT(At[m]), PG8_CAT(Bt[n]), acc[ai][bj][m][n], 0, 0, 0, 0x7f7f7f7f, 0, 0x7f7f7f7f); \
        else if constexpr (F8) acc[ai][bj][m][n] = __builtin_amdgcn_mfma_scale_f32_16x16x128_f8f6f4(PG8_CAT(Bt[n]), PG8_CAT(At[m]), acc[ai][bj][m][n], 0, 0, 0, 0x7f7f7f7f, 0, 0x7f7f7f7f); \
        else { _Pragma("unroll") for (int k = 0; k < 2; ++k) acc[ai][bj][m][n] = __builtin_amdgcn_mfma_f32_16x16x32_bf16(Bt[n][k], At[m][k], acc[ai][bj][m][n], 0, 0, 0); } } __builtin_amdgcn_s_setprio(0); } while (0)
#define PG8_WAIT_V(n) asm volatile("s_waitcnt vmcnt(" #n ")" ::: "memory")
#define PG8_WAIT_L(n) asm volatile("s_waitcnt lgkmcnt(" #n ")" ::: "memory")
#define PG8_BAR __builtin_amdgcn_s_barrier()
#define PG8_SCHED __builtin_amdgcn_sched_barrier(0)
    Unit cur, nxt; int ui = 0;
    if (!S.next(0, cur)) return;
    f32x4 acc[2][2][4][2];
#pragma unroll
    for (int a = 0; a < 2; ++a)
#pragma unroll
        for (int b = 0; b < 2; ++b)
#pragma unroll
            for (int m = 0; m < 4; ++m)
#pragma unroll
                for (int n = 0; n < 2; ++n) acc[a][b][m][n] = (f32x4){0.f, 0.f, 0.f, 0.f};
    bf16x8 At[4][2], B0[2][2], B1[2][2];
    const char* cA = (const char*)g.A + (size_t)cur.pm * tstepA; const char* cB = (const char*)g.Bt + (size_t)cur.pn * tstepB;
    if constexpr (SP2) {
        PG8_STAGE(PG8_SB(0, 0), cB, voffB); PG8_STAGE(PG8_SB(0, 1), cB + hstepB, voffB); PG8_STAGE(PG8_SA(0, 0), cA, voffA); PG8_STAGE(PG8_SA(0, 1), cA + hstepA, voffA);
        if (wr == 1) PG8_BAR;
        PG8_WAIT_V(2); PG8_BAR;
        PG8_STAGE(PG8_SB(1, 0), cB + kstep, voffB); PG8_STAGE(PG8_SA(1, 0), cA + kstep, voffA); PG8_STAGE(PG8_SB(1, 1), cB + hstepB + kstep, voffB);
        PG8_WAIT_V(6); PG8_BAR;
    } else {
        PG8_STAGE(PG8_SB(0, 0), cB, voffB); PG8_STAGE(PG8_SA(0, 0), cA, voffA); PG8_STAGE(PG8_SB(0, 1), cB + hstepB, voffB); PG8_STAGE(PG8_SA(0, 1), cA + hstepA, voffA);
        if (wr == 1) PG8_BAR;
        PG8_WAIT_V(4); PG8_BAR;
        PG8_STAGE(PG8_SB(1, 0), cB + kstep, voffB); PG8_STAGE(PG8_SA(1, 0), cA + kstep, voffA); PG8_STAGE(PG8_SB(1, 1), cB + hstepB + kstep, voffB);
        PG8_WAIT_V(6); PG8_BAR;
    }
    for (;;) {
        const bool has_next = S.next(ui + 1, nxt);
        const char* nA = has_next ? (const char*)g.A + (size_t)nxt.pm * tstepA : cA; const char* nB = has_next ? (const char*)g.Bt + (size_t)nxt.pn * tstepB : cB;
#pragma unroll 1
        for (int t = 0; t < nt; t += 2) {
            const bool last = (t == nt - 2);
            const char* a1 = cA + (size_t)(t + 1) * kstep;
            const char* a2 = last ? nA : cA + (size_t)(t + 2) * kstep; const char* b2 = last ? nB : cB + (size_t)(t + 2) * kstep;
            const char* a3 = a2 + kstep; const char* b3 = b2 + kstep;
            if constexpr (SP2) {
            PG8_LDB(B0, 0, 0); PG8_LDB(B1, 0, 1); PG8_SCHED; PG8_LDA(At, 0, 0); PG8_STAGE(PG8_SA(1, 1), a1 + hstepA, voffA);
            PG8_WAIT_V(8); PG8_WAIT_L(0); PG8_BAR; PG8_MMA(0, 0, At, B0); PG8_MMA(0, 1, At, B1); PG8_BAR; PG8_SCHED;
            PG8_LDA(At, 0, 1); PG8_STAGE(PG8_SB(0, 0), b2, voffB); PG8_STAGE(PG8_SB(0, 1), b2 + hstepB, voffB); PG8_STAGE(PG8_SA(0, 0), a2, voffA);
            PG8_WAIT_V(8); PG8_WAIT_L(0); PG8_BAR; PG8_MMA(1, 0, At, B0); PG8_MMA(1, 1, At, B1); PG8_BAR; PG8_SCHED;
            PG8_LDB(B0, 1, 0); PG8_LDB(B1, 1, 1); PG8_SCHED; PG8_LDA(At, 1, 0); PG8_STAGE(PG8_SA(0, 1), a2 + hstepA, voffA);
            PG8_WAIT_V(8); PG8_WAIT_L(0); PG8_BAR; PG8_MMA(0, 0, At, B0); PG8_MMA(0, 1, At, B1); PG8_BAR; PG8_SCHED;
            PG8_LDA(At, 1, 1); PG8_STAGE(PG8_SB(1, 0), b3, voffB); PG8_STAGE(PG8_SB(1, 1), b3 + hstepB, voffB); PG8_STAGE(PG8_SA(1, 0), a3, voffA);
            PG8_WAIT_V(8); PG8_WAIT_L(0); PG8_BAR; PG8_MMA(1, 0, At, B0); PG8_MMA(1, 1, At, B1); PG8_BAR; PG8_SCHED;
            } else {
            PG8_LDB(B0, 0, 0); PG8_SCHED; PG8_LDA(At, 0, 0); PG8_STAGE(PG8_SA(1, 1), a1 + hstepA, voffA);
            PG8_WAIT_L(8); PG8_BAR; PG8_WAIT_L(0); PG8_MMA(0, 0, At, B0); PG8_BAR; PG8_SCHED;
            PG8_LDB(B1, 0, 1); PG8_STAGE(PG8_SB(0, 0), b2, voffB);
            PG8_BAR; PG8_WAIT_L(0); PG8_MMA(0, 1, At, B1); PG8_BAR;
            PG8_LDA(At, 0, 1); PG8_STAGE(PG8_SA(0, 0), a2, voffA);
            PG8_BAR; PG8_WAIT_L(0); PG8_MMA(1, 0, At, B0); PG8_BAR; PG8_SCHED;
            PG8_STAGE(PG8_SB(0, 1), b2 + hstepB, voffB);
            PG8_WAIT_V(6); PG8_BAR; PG8_MMA(1, 1, At, B1); PG8_BAR;
            PG8_LDB(B0, 1, 0); PG8_SCHED; PG8_LDA(At, 1, 0); PG8_STAGE(PG8_SA(0, 1), a2 + hstepA, voffA);
            PG8_WAIT_L(8); PG8_BAR; PG8_WAIT_L(0); PG8_MMA(0, 0, At, B0); PG8_BAR; PG8_SCHED;
            PG8_LDB(B1, 1, 1); PG8_STAGE(PG8_SB(1, 0), b3, voffB);
            PG8_BAR; PG8_WAIT_L(0); PG8_MMA(0, 1, At, B1); PG8_BAR;
            PG8_LDA(At, 1, 1); PG8_STAGE(PG8_SA(1, 0), a3, voffA);
            PG8_BAR; PG8_WAIT_L(0); PG8_MMA(1, 0, At, B0); PG8_BAR; PG8_SCHED;
            PG8_STAGE(PG8_SB(1, 1), b3 + hstepB, voffB);
            PG8_WAIT_V(6); PG8_BAR; PG8_MMA(1, 1, At, B1); PG8_BAR;
            }
        }
        if constexpr (ALIGN_EPI) { if (wr == 0) PG8_BAR; }
        { const int le = lane_id(); E(acc, cur, wr, wc, le & 15, le >> 4); }
        if (!has_next) break;
#pragma unroll
        for (int a = 0; a < 2; ++a)
#pragma unroll
            for (int b = 0; b < 2; ++b)
#pragma unroll
                for (int m = 0; m < 4; ++m)
#pragma unroll
                    for (int n = 0; n < 2; ++n) acc[a][b][m][n] = (f32x4){0.f, 0.f, 0.f, 0.f};
        cur = nxt; cA = nA; cB = nB; ++ui;
        if constexpr (ALIGN_EPI) { if (wr == 1) PG8_BAR; }
    }
    PG8_WAIT_V(0);
    if constexpr (!ALIGN_EPI) { if (wr == 0) PG8_BAR; }
    PG8_BAR;
#undef PG8_SA
#undef PG8_SB
#undef PG8_STAGE
#undef PG8_LDA
#undef PG8_LDB
#undef PG8_MMA
#undef PG8_CAT
#undef PG8_WAIT_V
#undef PG8_WAIT_L
#undef PG8_BAR
#undef PG8_SCHED
}

#define EPI_ROWS(ai, m) (u.pm * BM + wr * 64 + fr + (ai) * HALF + (m) * 16)
struct EpiIn {
    static constexpr bool PERM = true;
    int mode; float sc;
    bf16_t *U, *GA, *VG; unsigned char *CQKV, *KR; const float* bgate; const float* rope; u64 *sqq, *sqkv, *ssum, *ssq;
    __device__ __forceinline__ void operator()(const f32x4 (&acc)[2][2][4][2], const Unit& u, int wr, int wc, int fr, int fq) const {
        const int pn = u.pn, cw = wc * 32 + 8 * fq;
        if (mode == 1 || pn >= 29) {
            const int c0 = (mode == 1 ? pn : pn - 29) * 256 + cw;
#pragma unroll
            for (int ai = 0; ai < 2; ++ai)
#pragma unroll
                for (int m = 0; m < 4; ++m) { const int row = EPI_ROWS(ai, m); float s = 0.f, q = 0.f;
#pragma unroll
                    for (int bj = 0; bj < 2; ++bj) { f32x4 v0 = acc[ai][bj][m][0] * sc, v1 = acc[ai][bj][m][1] * sc;
#pragma unroll
                        for (int e = 0; e < 4; ++e) { v0[e] = gelu_t(v0[e]); v1[e] = gelu_t(v1[e]); }
                        s += (v0[0] + v0[1]) + (v0[2] + v0[3]) + (v1[0] + v1[1]) + (v1[2] + v1[3]);
                        q += (v0[0] * v0[0] + v0[1] * v0[1]) + (v0[2] * v0[2] + v0[3] * v0[3]) + (v1[0] * v1[0] + v1[1] * v1[1]) + (v1[2] * v1[2] + v1[3] * v1[3]);
                        v4u w; w.x = cvt_pk_bf16(v0[0], v0[1]); w.y = cvt_pk_bf16(v0[2], v0[3]); w.z = cvt_pk_bf16(v1[0], v1[1]); w.w = cvt_pk_bf16(v1[2], v1[3]);
                        __builtin_nontemporal_store(w, (v4u*)(VG + (size_t)row * 2048 + c0 + bj * HALF)); }
                    s += shx(s, 16, fq * 16 + fr); s += shx(s, 32, fq * 16 + fr); q += shx(q, 16, fq * 16 + fr); q += shx(q, 32, fq * 16 + fr);
                    if (fq == 0) { fx_add(ssum + row, s); fx_add(ssq + row, q); } }
        } else if (pn < 16) {
            const int c0 = pn * 128 + cw; const float* bg = bgate + 2048 + c0;
            const f32x4 b0 = *(const f32x4*)bg, b1 = *(const f32x4*)(bg + 4);
#pragma unroll
            for (int ai = 0; ai < 2; ++ai)
#pragma unroll
                for (int m = 0; m < 4; ++m) { const int row = EPI_ROWS(ai, m);
                    f32x4 v0 = acc[ai][0][m][0] * sc, v1 = acc[ai][0][m][1] * sc; const f32x4 g0 = acc[ai][1][m][0] * sc + b0, g1 = acc[ai][1][m][1] * sc + b1;
#pragma unroll
                    for (int e = 0; e < 4; ++e) { v0[e] = gelu_t(v0[e]) * sigmoid_f(g0[e]); v1[e] = gelu_t(v1[e]) * sigmoid_f(g1[e]); }
                    v4u w; w.x = cvt_pk_bf16(v0[0], v0[1]); w.y = cvt_pk_bf16(v0[2], v0[3]); w.z = cvt_pk_bf16(v1[0], v1[1]); w.w = cvt_pk_bf16(v1[2], v1[3]);
                    __builtin_nontemporal_store(w, (v4u*)(U + (size_t)row * 2048 + c0)); }
        } else if (pn < 24) {
            const int c0 = (pn - 16) * 256 + cw; const float* bg = bgate + c0;
            f32x4 bv[2][2];
#pragma unroll
            for (int bj = 0; bj < 2; ++bj) { bv[bj][0] = *(const f32x4*)(bg + bj * HALF); bv[bj][1] = *(const f32x4*)(bg + bj * HALF + 4); }
#pragma unroll
            for (int ai = 0; ai < 2; ++ai)
#pragma unroll
                for (int m = 0; m < 4; ++m) { const int row = EPI_ROWS(ai, m);
#pragma unroll
                    for (int bj = 0; bj < 2; ++bj) { f32x4 v0 = acc[ai][bj][m][0] * sc + bv[bj][0], v1 = acc[ai][bj][m][1] * sc + bv[bj][1];
#pragma unroll
                        for (int e = 0; e < 4; ++e) { v0[e] = sigmoid_f(v0[e]); v1[e] = sigmoid_f(v1[e]); }
                        v4u w; w.x = cvt_pk_bf16(v0[0], v0[1]); w.y = cvt_pk_bf16(v0[2], v0[3]); w.z = cvt_pk_bf16(v1[0], v1[1]); w.w = cvt_pk_bf16(v1[2], v1[3]);
                        __builtin_nontemporal_store(w, (v4u*)(GA + (size_t)row * 2048 + c0 + bj * HALF)); } }
        } else if (pn < 28) {
            const int pc = pn - 24; u64* sq = pc < 2 ? sqq : sqkv;
#pragma unroll
            for (int ai = 0; ai < 2; ++ai)
#pragma unroll
                for (int m = 0; m < 4; ++m) { const int row = EPI_ROWS(ai, m); float s = 0.f;
#pragma unroll
                    for (int bj = 0; bj < 2; ++bj) { const f32x4 v0 = acc[ai][bj][m][0] * sc, v1 = acc[ai][bj][m][1] * sc;
                        s += (v0[0] * v0[0] + v0[1] * v0[1]) + (v0[2] * v0[2] + v0[3] * v0[3]) + (v1[0] * v1[0] + v1[1] * v1[1]) + (v1[2] * v1[2] + v1[3] * v1[3]);
                        v2u w; w.x = pack_fp8x4(v0 * XN8_SCALE); w.y = pack_fp8x4(v1 * XN8_SCALE);
                        *(v2u*)(CQKV + (size_t)row * 1024 + pc * 256 + bj * HALF + cw) = w; }
                    s += shx(s, 16, fq * 16 + fr); s += shx(s, 32, fq * 16 + fr);
                    if (fq == 0) fx_add(sq + row, s); }
        } else {
            if (wc < 2) {
                const int i0 = cw >> 1;
#pragma unroll
                for (int ai = 0; ai < 2; ++ai)
#pragma unroll
                    for (int m = 0; m < 4; ++m) { const int row = EPI_ROWS(ai, m);
                        const f32x4 c4 = *(const f32x4*)(rope + (size_t)row * 32 + i0), s4 = *(const f32x4*)(rope + (size_t)MTOK * 32 + (size_t)row * 32 + i0);
                        const f32x4 v0 = acc[ai][0][m][0] * sc, v1 = acc[ai][0][m][1] * sc;
                        const f32x4 r0 = {v0[0] * c4[0] - v0[1] * s4[0], v0[0] * s4[0] + v0[1] * c4[0], v0[2] * c4[1] - v0[3] * s4[1], v0[2] * s4[1] + v0[3] * c4[1]};
                        const f32x4 r1 = {v1[0] * c4[2] - v1[1] * s4[2], v1[0] * s4[2] + v1[1] * c4[2], v1[2] * c4[3] - v1[3] * s4[3], v1[2] * s4[3] + v1[3] * c4[3]};
                        v2u w; w.x = pack_fp8x4(r0 * K8_SCALE); w.y = pack_fp8x4(r1 * K8_SCALE);
                        *(v2u*)(KR + (size_t)row * DR + cw) = w; }
            }
        }
    }
};
struct EpiQ {
    static constexpr bool PERM = true;
    unsigned char* Q; const u64* sqq; const float* rope;
    __device__ __forceinline__ void operator()(const f32x4 (&acc)[2][2][4][2], const Unit& u, int wr, int wc, int fr, int fq) const {
        const int cw = wc * 32 + 8 * fq;
#pragma unroll
        for (int ai = 0; ai < 2; ++ai)
#pragma unroll
            for (int m = 0; m < 4; ++m) { const int row = EPI_ROWS(ai, m); const int b = row >> 13, s = row & 8191;
                const float rq = __builtin_amdgcn_rsqf(fx_get(sqq + row) * (1.f / QL) + EPS) * (C2Q * IN8_DESCALE * Q8_SCALE);
#pragma unroll
                for (int bj = 0; bj < 2; ++bj) { const int colg = u.pn * 256 + bj * HALF + cw; const int head = colg / DQK, dd = colg - head * DQK;
                    f32x4 v0 = acc[ai][bj][m][0] * rq, v1 = acc[ai][bj][m][1] * rq;
                    if (dd >= DN) { const int i0 = (dd - DN) >> 1;
                        const f32x4 c4 = *(const f32x4*)(rope + (size_t)row * 32 + i0), s4 = *(const f32x4*)(rope + (size_t)MTOK * 32 + (size_t)row * 32 + i0);
                        const f32x4 r0 = {v0[0] * c4[0] - v0[1] * s4[0], v0[0] * s4[0] + v0[1] * c4[0], v0[2] * c4[1] - v0[3] * s4[1], v0[2] * s4[1] + v0[3] * c4[1]};
                        const f32x4 r1 = {v1[0] * c4[2] - v1[1] * s4[2], v1[0] * s4[2] + v1[1] * c4[2], v1[2] * c4[3] - v1[3] * s4[3], v1[2] * s4[3] + v1[3] * c4[3]};
                        v0 = r0; v1 = r1; }
                    v2u w; w.x = pack_fp8x4(v0); w.y = pack_fp8x4(v1);
                    *(v2u*)(Q + ((size_t)(b * NHEAD + head) * SEQL + s) * DQK + dd) = w; } }
    }
};
struct EpiKV {
    static constexpr bool PERM = true;
    unsigned char* Kb; unsigned char* Vt; const u64* sqkv;
    __device__ __forceinline__ void operator()(const f32x4 (&acc)[2][2][4][2], const Unit& u, int wr, int wc, int fr, int fq) const {
        const int cw = wc * 32 + 8 * fq, head = u.pn;
#pragma unroll
        for (int ai = 0; ai < 2; ++ai)
#pragma unroll
            for (int m = 0; m < 4; ++m) {
                { const int row = EPI_ROWS(ai, m); const int b = row >> 13, s = row & 8191;
                  const float rk = __builtin_amdgcn_rsqf(fx_get(sqkv + row) * (1.f / QL) + EPS) * (IN8_DESCALE * K8_SCALE); const size_t tr = (size_t)(b * NHEAD + head) * SEQL + s;
                  v2u w; w.x = pack_fp8x4(acc[ai][0][m][0] * rk); w.y = pack_fp8x4(acc[ai][0][m][1] * rk); *(v2u*)(Kb + tr * DN + cw) = w; }
                { const int row0 = u.pm * BM + wr * 64 + ai * HALF + m * 16 + 4 * fq; const int b = row0 >> 13, s0 = row0 & 8191;
                  f32x4 rk4;
#pragma unroll
                  for (int e = 0; e < 4; ++e) rk4[e] = __builtin_amdgcn_rsqf(fx_get(sqkv + row0 + e) * (1.f / QL) + EPS) * (IN8_DESCALE * V8_SCALE);
                  const int slot = (s0 & ~63) + 32 * (fq & 1) + 4 * (2 * m + (fq >> 1));
#pragma unroll
                  for (int n = 0; n < 2; ++n) { const int dv = wc * 32 + 8 * (fr >> 2) + 4 * n + (fr & 3);
                      *(unsigned*)(Vt + ((size_t)(b * NHEAD + head) * DVH + dv) * SEQL + slot) = pack_fp8x4(acc[ai][1][m][n] * rk4); } }
            }
    }
};
struct EpiOut {
    static constexpr bool PERM = false;
    const float* x; bf16_t* X1B; u64* sqx;
    __device__ __forceinline__ void operator()(const f32x4 (&acc)[2][2][4][2], const Unit& u, int wr, int wc, int fr, int fq) const {
        const int col0 = u.pn * BM + wc * 32 + 4 * fq;
#pragma unroll
        for (int ai = 0; ai < 2; ++ai)
#pragma unroll
            for (int m = 0; m < 4; ++m) { const int row = EPI_ROWS(ai, m); float s = 0.f;
#pragma unroll
                for (int bj = 0; bj < 2; ++bj)
#pragma unroll
                    for (int n = 0; n < 2; ++n) { const size_t off = (size_t)row * D_MODEL + col0 + bj * HALF + n * 16;
                        const f32x4 v = *(const f32x4*)(x + off) + acc[ai][bj][m][n];
                        s += (v[0] * v[0] + v[1] * v[1]) + (v[2] * v[2] + v[3] * v[3]);
                        v2u w; w.x = cvt_pk_bf16(v[0], v[1]); w.y = cvt_pk_bf16(v[2], v[3]); *(v2u*)(X1B + off) = w; }
                s += shx(s, 16, fq * 16 + fr); s += shx(s, 32, fq * 16 + fr);
                if (fq == 0) fx_add(sqx + row, s); }
    }
};
struct EpiPQ {
    static constexpr bool PERM = true;
    bf16_t* QP; const u64* sqx;
    __device__ __forceinline__ void operator()(const f32x4 (&acc)[2][2][4][2], const Unit& u, int wr, int wc, int fr, int fq) const {
        const int cw = u.pn * 256 + wc * 32 + 8 * fq;
#pragma unroll
        for (int ai = 0; ai < 2; ++ai)
#pragma unroll
            for (int m = 0; m < 4; ++m) { const int row = EPI_ROWS(ai, m);
                const float r2 = __builtin_amdgcn_rsqf(fx_get(sqx + row) * (1.f / D_MODEL) + EPS);
#pragma unroll
                for (int bj = 0; bj < 2; ++bj) { const f32x4 v0 = acc[ai][bj][m][0] * r2, v1 = acc[ai][bj][m][1] * r2;
                    v4u w; w.x = cvt_pk_bf16(v0[0], v0[1]); w.y = cvt_pk_bf16(v0[2], v0[3]); w.z = cvt_pk_bf16(v1[0], v1[1]); w.w = cvt_pk_bf16(v1[2], v1[3]);
                    __builtin_nontemporal_store(w, (v4u*)(QP + (size_t)row * D_MODEL + cw + bj * HALF)); } }
    }
};
#undef EPI_ROWS
}

typedef GAS unsigned gu32;
#define RLX_AGENT __ATOMIC_RELAXED, __HIP_MEMORY_SCOPE_AGENT
#define XB_TMO      128
#define XB_XCNT(j)  (256  + 64 * (j))
#define XB_XSUB(j)  (1280 + 64 * (j))
#define XB_XGEN(j)  (2304 + 64 * (j))
#define XB_TOP      3328
#define XB_TOPGEN   3392
#define XCD_BAR_WORDS 3456
#define XB_SPIN_CAP (1u << 18)
__device__ __forceinline__ unsigned xb_ld(unsigned* p)              { return __hip_atomic_load(p, __ATOMIC_RELAXED, __HIP_MEMORY_SCOPE_AGENT); }
__device__ __forceinline__ unsigned xb_add(unsigned* p, unsigned v) { return __hip_atomic_fetch_add(p, v, __ATOMIC_RELAXED, __HIP_MEMORY_SCOPE_AGENT); }
__device__ __forceinline__ unsigned xb_xcc_id() { return (unsigned)__builtin_amdgcn_s_getreg((3 << 11) | 20) & 0xFu; }
#define XB_SPIN(cond, bar) do { unsigned _sp = 0; while (cond) { __builtin_amdgcn_s_sleep(1); \
    if ((++_sp & 255u) == 0u) { if (xb_ld(&(bar)[XB_TMO])) break; if (_sp > XB_SPIN_CAP) { atomicAdd(&(bar)[XB_TMO], 1u); break; } } } } while (0)
struct XcdBarrier { unsigned* bar; unsigned x; volatile LAS unsigned* st; int wave; };
__device__ __forceinline__ XcdBarrier xcd_barrier_post(unsigned* bar, volatile LAS unsigned* st, int wave) {
    XcdBarrier b; b.bar = bar; b.x = xb_xcc_id(); b.st = st; b.wave = wave;
    if (wave == 0 && lane_id() == 0) (void)xb_add(&bar[XB_XCNT(b.x)], 1u);
    return b;
}
__device__ __forceinline__ void xcd_barrier_complete(unsigned* bar, unsigned x, unsigned& nloc, unsigned& nx) {
    const unsigned G = gridDim.x * gridDim.y * gridDim.z;
    unsigned sum, cnt, mine, sp = 0u;
    for (;;) {
        sum = 0u; cnt = 0u; mine = 0u;
#pragma unroll
        for (unsigned j = 0; j < 16; ++j) { const unsigned c = xb_ld(&bar[XB_XCNT(j)]); sum += c; cnt += (c > 0u) ? 1u : 0u; mine = (j == x) ? c : mine; }
        if (sum == G) break;
        __builtin_amdgcn_s_sleep(1);
        if ((++sp & 255u) == 0u) { if (xb_ld(&bar[XB_TMO])) break; if (sp > XB_SPIN_CAP) { atomicAdd(&bar[XB_TMO], 1u); break; } }
    }
    nloc = mine > 0u ? mine : 1u; nx = cnt > 0u ? cnt : 1u;
}
__device__ __forceinline__ void xcd_barrier(const XcdBarrier& b) {
    asm volatile("s_waitcnt vmcnt(0)" ::: "memory");
    __syncthreads();
    if (b.wave == 0 && lane_id() == 0) {
        unsigned* bar = b.bar;
        __builtin_amdgcn_s_waitcnt(0);
        unsigned nloc = b.st[0], nx = b.st[1];
        if (nloc == 0u) { xcd_barrier_complete(bar, b.x, nloc, nx); b.st[0] = nloc; b.st[1] = nx; }
        const unsigned old = xb_add(&bar[XB_XSUB(b.x)], 1u);
        const unsigned gen = old / nloc;
        if (old + 1u == (gen + 1u) * nloc) {
            __builtin_amdgcn_fence(__ATOMIC_RELEASE, "agent");
            asm volatile("s_waitcnt vmcnt(0)" ::: "memory");
            const unsigned og = xb_add(&bar[XB_TOP], 1u);
            const unsigned tg = og / nx;
            if (og + 1u == (tg + 1u) * nx) xb_add(&bar[XB_TOPGEN], 1u);
            else XB_SPIN(xb_ld(&bar[XB_TOPGEN]) == tg, bar);
            __builtin_amdgcn_fence(__ATOMIC_ACQUIRE, "agent");
            xb_add(&bar[XB_XGEN(b.x)], 1u);
            asm volatile("s_waitcnt vmcnt(0)" ::: "memory");
        } else {
            XB_SPIN(xb_ld(&bar[XB_XGEN(b.x)]) == gen, bar);
            __builtin_amdgcn_fence(__ATOMIC_ACQUIRE, "agent");
            asm volatile("s_waitcnt vmcnt(0)" ::: "memory");
        }
    }
    __syncthreads();
}

struct Args { const float* in[20]; float* out; unsigned char* ws; };
struct Frame {
    LAS unsigned char* lds; int tid, lane, wave, vcu, G;
};

__device__ __forceinline__ int colmap(int mode, int r) {
    if (mode == 0) return r;
    if (mode == 1) return 3136 + r;
    if (mode == 3) { if (r < 4096) { const int k = r >> 8, j = r & 255; return j < 128 ? 1088 + 128 * k + j : 7232 + 128 * k + (j - 128); } if (r < 6144) return 5184 + (r - 4096); if (r < 7168) return r - 6144;
        if (r < 7232) { const int j = r - 7168; return 1024 + (j >> 1) + 32 * (j & 1); } if (r < 7424) return -1; return 3136 + (r - 7424); }
    const int h = r / DQK, d = r - h * DQK; if (d < DN) return r; const int j = d - DN; return h * DQK + DN + (j >> 1) + 32 * (j & 1);
}
template <bool F8 = false>
__device__ __forceinline__ void p0_transpose_item(const float* W, int K, int N, bf16* WT, int ndst, int mode, const float* kscale, LAS float* scr, int item, int lane) {
    const int nblk = ndst / 32, kb = item / nblk, nb = item % nblk, k0 = 64 * kb, n0 = 32 * nb;
    const int src = colmap(mode, n0 + (lane & 31));
    const int s0 = colmap(mode, n0), s31 = colmap(mode, n0 + 31);
    if (s0 >= 0 && s31 == s0 + 31 && (s0 & 3) == 0) {
        const int kr = lane >> 3, n4 = lane & 7; f32x4 v[8];
#pragma unroll
        for (int i = 0; i < 8; ++i) v[i] = *(const f32x4*)(W + (size_t)(k0 + 8 * i + kr) * N + s0 + 4 * n4);
#pragma unroll
        for (int i = 0; i < 8; ++i) { const float ks = kscale ? kscale[k0 + 8 * i + kr] : 1.f; LAS float* d = scr + (8 * i + kr) * 33 + 4 * n4;
            d[0] = v[i][0] * ks; d[1] = v[i][1] * ks; d[2] = v[i][2] * ks; d[3] = v[i][3] * ks; }
    } else {
#pragma unroll 8
    for (int i = 0; i < 32; ++i) { const int kk = 2 * i + (lane >> 5); float v = 0.f;
        if (src >= 0) { v = W[(size_t)(k0 + kk) * N + src]; if (kscale) v *= kscale[k0 + kk]; }
        scr[kk * 33 + (lane & 31)] = v; }
    }
    LDS_WAIT(); asm volatile("" ::: "memory");
    const int c = lane & 7;
#pragma unroll
    for (int j = 0; j < 4; ++j) { const int n = (lane >> 3) + 8 * j; const LAS float* s = scr + (8 * c) * 33 + n;
        if constexpr (F8) { float t[8];
#pragma unroll
            for (int e = 0; e < 8; ++e) t[e] = fminf(fmaxf(s[e * 33] * WIN8_SCALE, -448.f), 448.f);
            int w0 = 0, w1 = 0; w0 = __builtin_amdgcn_cvt_pk_fp8_f32(t[0], t[1], w0, false); w0 = __builtin_amdgcn_cvt_pk_fp8_f32(t[2], t[3], w0, true); w1 = __builtin_amdgcn_cvt_pk_fp8_f32(t[4], t[5], w1, false); w1 = __builtin_amdgcn_cvt_pk_fp8_f32(t[6], t[7], w1, true);
            v2u o; o.x = (unsigned)w0; o.y = (unsigned)w1; *(v2u*)((unsigned char*)WT + (size_t)(n0 + n) * K + k0 + 8 * c) = o; continue; }
        v4u o; o.x = cvt_pk_bf16(s[0 * 33], s[1 * 33]); o.y = cvt_pk_bf16(s[2 * 33], s[3 * 33]); o.z = cvt_pk_bf16(s[4 * 33], s[5 * 33]); o.w = cvt_pk_bf16(s[6 * 33], s[7 * 33]);
        *(v4u*)(WT + (size_t)(n0 + n) * K + k0 + 8 * c) = o; }
    LDS_WAIT(); asm volatile("" ::: "memory");
}

__device__ __forceinline__ void sgu_unit(const Frame& F, int unit, const bf16* VG, bf16* U, const bf16* WSP, const float* lng, const float* lnb, const float* bsp, const u64* ssum, const u64* ssq) {
    const int chunk = unit >> 3, g = unit & 7, row0 = chunk * 128, c0 = g * 256;
    const int tid = F.tid, lane = F.lane, w = F.wave, fr = lane & 15, fq = lane >> 4;
    LAS unsigned* vt = (LAS unsigned*)F.lds;
    LAS float* st = (LAS float*)(F.lds + 256 * 272);
    if (tid < 128) { const float mean = fx_get(ssum + row0 + tid) * (1.f / D_MODEL), ex2 = fx_get(ssq + row0 + tid) * (1.f / D_MODEL);
        const float var = fmaxf(ex2 - mean * mean, 0.f); st[2 * tid] = mean; st[2 * tid + 1] = __builtin_amdgcn_rsqf(var + EPS); }
    __syncthreads();
#pragma unroll 1
    for (int q = 0; q < 4; ++q) {
        const int wi = w + 8 * q, c8 = lane & 7, rlo = lane >> 3, s2 = 8 * (wi & 7) + rlo, cg = 8 * (wi >> 3) + c8;
        const bf16* p = VG + (size_t)(row0 + 2 * s2) * D_MODEL + c0 + 8 * cg;
        const v4u a = *(const v4u*)p, b = *(const v4u*)(p + D_MODEL);
        const f32x4 g0 = *(const f32x4*)(lng + c0 + 8 * cg), g1 = *(const f32x4*)(lng + c0 + 8 * cg + 4), b0 = *(const f32x4*)(lnb + c0 + 8 * cg), b1 = *(const f32x4*)(lnb + c0 + 8 * cg + 4);
        const float m0 = st[4 * s2], r0 = st[4 * s2 + 1], m1 = st[4 * s2 + 2], r1 = st[4 * s2 + 3];
        const unsigned aw[4] = {a.x, a.y, a.z, a.w}, bw[4] = {b.x, b.y, b.z, b.w};
        const int pd = s2 ^ (c8 << 3);
#pragma unroll
        for (int j = 0; j < 8; ++j) { const float ga = j < 4 ? g0[j & 3] : g1[j & 3], be = j < 4 ? b0[j & 3] : b1[j & 3];
            const float x0 = (j & 1) ? bf_hi(aw[j >> 1]) : bf_lo(aw[j >> 1]), x1 = (j & 1) ? bf_hi(bw[j >> 1]) : bf_lo(bw[j >> 1]);
            vt[(8 * cg + j) * 68 + pd] = cvt_pk_bf16((x0 - m0) * r0 * ga + be, (x1 - m1) * r1 * ga + be); }
    }
    __syncthreads();
    f32x4 acc[2][8];
#pragma unroll
    for (int rt = 0; rt < 2; ++rt)
#pragma unroll
        for (int tt = 0; tt < 8; ++tt) acc[rt][tt] = (f32x4){0.f, 0.f, 0.f, 0.f};
    const bf16* wg = WSP + (size_t)g * 128 * 128;
#pragma unroll
    for (int kk = 0; kk < 4; ++kk) {
        bf16x8 af[2];
#pragma unroll
        for (int rt = 0; rt < 2; ++rt) { const int ch = 32 * w + 16 * rt + fr; const int d = 16 * kk + 4 * fq, pd = d ^ (((ch >> 3) & 7) << 3);
            af[rt] = *(const LAS bf16x8*)((const LAS unsigned char*)vt + ch * 272 + pd * 4); }
#pragma unroll
        for (int tt = 0; tt < 8; ++tt) { if (tt >= 2 * kk) {
            const bf16x8 bfr = *(const bf16x8*)(wg + (size_t)(16 * tt + fr) * 128 + 32 * kk + 8 * fq);
#pragma unroll
            for (int rt = 0; rt < 2; ++rt) acc[rt][tt] = __builtin_amdgcn_mfma_f32_16x16x32_bf16(af[rt], bfr, acc[rt][tt], 0, 0, 0); } }
    }
#pragma unroll
    for (int tt = 0; tt < 8; ++tt) { const int t = 16 * tt + fr; const float bs = bsp[g * 128 + t];
#pragma unroll
        for (int rt = 0; rt < 2; ++rt) { const size_t off = (size_t)(row0 + t) * D_MODEL + c0 + 32 * w + 16 * rt + 4 * fq;
            const v2u uu = *(const v2u*)(U + off);
            const f32x4 a = acc[rt][tt];
            v2u o; o.x = cvt_pk_bf16(bf_lo(uu.x) * (a[0] + bs), bf_hi(uu.x) * (a[1] + bs));
            o.y = cvt_pk_bf16(bf_lo(uu.y) * (a[2] + bs), bf_hi(uu.y) * (a[3] + bs));
            *(v2u*)(U + off) = o; } }
    __syncthreads();
}

namespace att {
constexpr int KT = 64 * 192, VT = 128 * 64;
constexpr int L_K = 0, L_V = 4 * KT, L_WS = 4 * KT + 4 * VT;
#define KSWZ(row, ch) ((row) * 192 + ((((ch) ^ (((row) >> 2) & 3))) << 4))
__device__ __forceinline__ int v_st(int k, int c) { const int kk = (k & ~0xC) | ((k & 4) << 1) | ((k & 8) >> 1); return ((kk >> 3) * 4 + (c >> 5)) * 512 + ((kk & 7) * 32 + (c & 31)) * 2; }
__device__ __forceinline__ int v_rd_base(int lane) { return ((lane & 3) << 3) | (((lane >> 2) & 3) << 6) | (((lane >> 4) & 1) << 5) | (((lane >> 5) & 1) << 8); }
constexpr int v_rd_off(int d0, int ks, int half) { return d0 * 512 + ks * 4096 + half * 2048; }
__device__ __forceinline__ int crow(int r, int hi) { return (r & 3) + 8 * (r >> 2) + 4 * hi; }
__device__ __forceinline__ void mask_tile(f32x16& p0, f32x16& p1, int dq) {
    const float NEG = -__builtin_inff();
#pragma unroll
    for (int r = 0; r < 16; ++r) { const int c = (r & 3) + 8 * (r >> 2); if (dq - c < 0) p0[r] = NEG; if (dq - c - 32 < 0) p1[r] = NEG; }
}
constexpr float THR = 8.f;
__device__ __forceinline__ void softmax_tile(f32x16& p0, f32x16& p1, float& m_reg, float& alpha, v8i& pk, bool first) {
    float pmax;
    { float a4[4];
#pragma unroll
      for (int c = 0; c < 4; ++c) { a4[c] = fmaxf(fmaxf(p0[4 * c], p0[4 * c + 1]), p0[4 * c + 2]); a4[c] = fmaxf(fmaxf(a4[c], p0[4 * c + 3]), p1[4 * c]);
          a4[c] = fmaxf(fmaxf(a4[c], p1[4 * c + 1]), p1[4 * c + 2]); a4[c] = fmaxf(a4[c], p1[4 * c + 3]); }
      pmax = fmaxf(fmaxf(a4[0], a4[1]), fmaxf(a4[2], a4[3])); }
    { auto rr = __builtin_amdgcn_permlane32_swap(__float_as_uint(pmax), __float_as_uint(pmax), false, false); pmax = fmaxf(__uint_as_float(rr[0]), __uint_as_float(rr[1])); }
    if (__builtin_expect(__all(pmax - m_reg <= THR) && !first, 1)) { alpha = 1.f; }
    else { float delta = first ? pmax - m_reg : fmaxf(pmax - m_reg, 0.f); if (!(delta > -1e30f)) delta = 0.f;
        alpha = first ? 1.f : __builtin_amdgcn_exp2f(-delta); m_reg += delta; }
#pragma unroll
    for (int r = 0; r < 16; ++r) { p0[r] = __builtin_amdgcn_exp2f(p0[r] - m_reg); p1[r] = __builtin_amdgcn_exp2f(p1[r] - m_reg); }
#pragma unroll
    for (int w = 0; w < 4; ++w) { int d0 = 0, d1 = 0; d0 = __builtin_amdgcn_cvt_pk_fp8_f32(p0[4 * w], p0[4 * w + 1], d0, false); d0 = __builtin_amdgcn_cvt_pk_fp8_f32(p0[4 * w + 2], p0[4 * w + 3], d0, true);
        d1 = __builtin_amdgcn_cvt_pk_fp8_f32(p1[4 * w], p1[4 * w + 1], d1, false); d1 = __builtin_amdgcn_cvt_pk_fp8_f32(p1[4 * w + 2], p1[4 * w + 3], d1, true); pk[w] = d0; pk[4 + w] = d1; }
}
template <int KB>
__device__ __forceinline__ void qkt(f32x16& p0, f32x16& p1, const char* K_lds, int r32, int hi, const v8i* qr) {
    p0 = f32x16{}; p1 = f32x16{};
    const char* k0 = K_lds + KB * KT + KSWZ(r32, 2 * hi); const char* k1 = K_lds + KB * KT + KSWZ(r32, 2 * hi + 1);
#pragma unroll
    for (int ks = 0; ks < 3; ++ks) {
        const v4u a0 = *reinterpret_cast<const v4u*>(k0 + ks * 64), a1 = *reinterpret_cast<const v4u*>(k1 + ks * 64);
        const v4u b0 = *reinterpret_cast<const v4u*>(k0 + ks * 64 + 32 * 192), b1 = *reinterpret_cast<const v4u*>(k1 + ks * 64 + 32 * 192);
        const v8i ka = {(int)a0.x, (int)a0.y, (int)a0.z, (int)a0.w, (int)a1.x, (int)a1.y, (int)a1.z, (int)a1.w};
        const v8i kb = {(int)b0.x, (int)b0.y, (int)b0.z, (int)b0.w, (int)b1.x, (int)b1.y, (int)b1.z, (int)b1.w};
        p0 = __builtin_amdgcn_mfma_scale_f32_32x32x64_f8f6f4(ka, qr[ks], p0, 0, 0, 0, 0x7c7c7c7c, 0, 0x79797979);
        p1 = __builtin_amdgcn_mfma_scale_f32_32x32x64_f8f6f4(kb, qr[ks], p1, 0, 0, 0, 0x7c7c7c7c, 0, 0x79797979); }
}
template <int VB>
__device__ __forceinline__ void pv_tile(f32x16* o, f32x16& lacc, const char* V_lds, int r32, int hi, v8i pk) {
    const int sw = (r32 >> 2) & 3;
    const char* v0 = V_lds + VB * VT + r32 * 64 + (((2 * hi) ^ sw) << 4); const char* v1 = V_lds + VB * VT + r32 * 64 + (((2 * hi + 1) ^ sw) << 4);
#pragma unroll
    for (int d0 = 0; d0 < 4; ++d0) { const v4u a = *reinterpret_cast<const v4u*>(v0 + d0 * 2048), b = *reinterpret_cast<const v4u*>(v1 + d0 * 2048);
        const v8i vb = {(int)a.x, (int)a.y, (int)a.z, (int)a.w, (int)b.x, (int)b.y, (int)b.z, (int)b.w};
        o[d0] = __builtin_amdgcn_mfma_scale_f32_32x32x64_f8f6f4(pk, vb, o[d0], 0, 0, 0, 0x7f7f7f7f, 0, 0x7c7c7c7c); if (d0 == 1) SBAR(); }
    { int c1 = 0x38383838; asm volatile("" : "+v"(c1)); const v8i ones = {c1, c1, c1, c1, c1, c1, c1, c1};
      lacc = __builtin_amdgcn_mfma_scale_f32_32x32x64_f8f6f4(pk, ones, lacc, 0, 0, 0, 0x7f7f7f7f, 0, 0x7f7f7f7f); }
}
__device__ __forceinline__ void attn_unit(int bh, int qb, const unsigned char* Q, const unsigned char* K, const unsigned char* KRp, const unsigned char* V, const bf16* GA, bf16* MG, char* lds, LAS unsigned char* lds3, const int wave0) {
    int tid = wave0 * 64 + lane_id(); asm volatile("" : "+v"(tid));
    const int wid = __builtin_amdgcn_readfirstlane(tid >> 6), lane = tid & 63, r32 = lane & 31, hi = lane >> 5;
    const int q0 = qb * 256, qlo = q0 + wid * 32, qm = qlo + r32 - 4 * hi;
    const unsigned char* Qw = Q + ((size_t)bh * SEQL + qlo + r32) * DQK;
    const unsigned char* Kh = K + (size_t)bh * SEQL * DN; const unsigned char* KRh = KRp + (size_t)(bh >> 4) * SEQL * DR; const unsigned char* Vh = V + (size_t)bh * SEQL * DVH;
    char* V_lds = lds + L_V; char* K_lds = lds + L_K;
    float* ws = (float*)(lds + L_WS) + wid * 64; float* li_l = ws, * al_l = ws + 32;
    v8i qr[3];
#pragma unroll
    for (int ks = 0; ks < 3; ++ks) { const v4u a = *reinterpret_cast<const v4u*>(Qw + ks * 64 + hi * 32), b = *reinterpret_cast<const v4u*>(Qw + ks * 64 + hi * 32 + 16);
        qr[ks] = (v8i){(int)a.x, (int)a.y, (int)a.z, (int)a.w, (int)b.x, (int)b.y, (int)b.z, (int)b.w}; }
    const int NT = 4 * (qb + 1);
    unsigned ksp[2], kst[2], vso;
#pragma unroll
    for (int i = 0; i < 2; ++i) { const int o = i * 8192 + tid * 16, row = (o / 192) & 63, pos = (o - (o / 192) * 192) >> 4, ch = pos ^ ((row >> 2) & 3);
        if (ch < 8) { ksp[i] = (unsigned)(Kh - Vh) + (unsigned)(row * DN + ch * 16); kst[i] = 64 * DN; } else { ksp[i] = (unsigned)(KRh - Vh) + (unsigned)(row * DR + (ch - 8) * 16); kst[i] = 64 * DR; } }
    { const int j = tid >> 2, c = (tid & 3) ^ ((j >> 2) & 3); vso = (unsigned)(j * SEQL + c * 16); }
    float m_reg = 0.f; f32x16 lacc = {}; f32x16 o[4] = {};
    const unsigned ldw = (unsigned)wid * 1024u;
#define SOFF(x) ({ unsigned o_ = (x); asm volatile("" : "+v"(o_)); (const unsigned*)((const char*)Vh + o_); })
#define SDMA(t, bf) do { \
        __builtin_amdgcn_global_load_lds(SOFF(ksp[0] + (unsigned)(t) * kst[0]), (LAS unsigned*)(lds3 + L_K + (bf) * KT + ldw), 16, 0, 0); \
        if (wid < 4) __builtin_amdgcn_global_load_lds(SOFF(ksp[1] + (unsigned)(t) * kst[1]), (LAS unsigned*)(lds3 + L_K + (bf) * KT + 8192 + ldw), 16, 0, 0); \
        __builtin_amdgcn_global_load_lds(SOFF(vso + (unsigned)(t) * 64u), (LAS unsigned*)(lds3 + L_V + (bf) * VT + ldw), 16, 0, 0); } while (0)
#define TILE(t, BF) do { f32x16 p0, p1; float alpha; v8i pk; \
        __builtin_amdgcn_s_setprio(1); qkt<BF>(p0, p1, K_lds, r32, hi, qr); __builtin_amdgcn_s_setprio(0); \
        { const int kb_ = (t) * 64; if (kb_ + 63 > qlo) mask_tile(p0, p1, qm - kb_); } \
        softmax_tile(p0, p1, m_reg, alpha, pk, (t) == 0); \
        if (__any(alpha < 1.f)) { if (hi == 0) al_l[r32] = alpha; asm volatile("s_waitcnt lgkmcnt(0)" ::: "memory"); \
            _Pragma("unroll") for (int r = 0; r < 16; ++r) { const float a_ = al_l[crow(r, hi)]; lacc[r] *= a_; _Pragma("unroll") for (int d_ = 0; d_ < 4; ++d_) o[d_][r] *= a_; } } \
        __builtin_amdgcn_s_setprio(1); pv_tile<BF>(o, lacc, V_lds, r32, hi, pk); __builtin_amdgcn_s_setprio(0); SBAR(); } while (0)
    SDMA(0, 0); SDMA(1, 1); VM_WAIT(); __syncthreads();
    for (int t = 0; t < NT; t += 4) {
        SDMA(t + 2, 2); SDMA(t + 3, 3); SBAR();
        TILE(t, 0); TILE(t + 1, 1);
        VM_WAIT(); __syncthreads();
        if (t + 4 < NT) { SDMA(t + 4, 0); SDMA(t + 5, 1); } SBAR();
        TILE(t + 2, 2); TILE(t + 3, 3);
        VM_WAIT(); __syncthreads(); }
#undef TILE
#undef SDMA
#undef SOFF
    float* stg = (float*)lds + wid * 4096;
    float rli[16];
#pragma unroll
    for (int r = 0; r < 16; ++r) rli[r] = __builtin_amdgcn_rcpf(lacc[r]);
    const int le = lane_id(), r32e = le & 31, hie = le >> 5;
#pragma unroll
    for (int r = 0; r < 16; ++r) { const int orow = crow(r, hie);
#pragma unroll
        for (int d0 = 0; d0 < 4; ++d0) stg[orow * 128 + d0 * 32 + r32e] = o[d0][r] * rli[r]; }
    asm volatile("s_waitcnt lgkmcnt(0)" ::: "memory");
    const int b = bh >> 4, h = bh & 15;
#pragma unroll 4
    for (int it = 0; it < 16; ++it) { const int row = 2 * it + hie, c4 = r32e * 4;
        const f32x4 ov = *(const f32x4*)(stg + row * 128 + c4);
        const size_t off = ((size_t)b * SEQL + qlo + row) * D_MODEL + h * DVH + c4;
        const v2u ga = *(const v2u*)(GA + off), ob = *(const v2u*)(MG + off);
        v2u w; w.x = cvt_pk_bf16(bf_lo(ga.x) * ov[0] + bf_lo(ob.x), bf_hi(ga.x) * ov[1] + bf_hi(ob.x)); w.y = cvt_pk_bf16(bf_lo(ga.y) * ov[2] + bf_lo(ob.y), bf_hi(ga.y) * ov[3] + bf_hi(ob.y));
        *(v2u*)(MG + off) = w; }
    __syncthreads();
}
#undef KSWZ
}

__device__ __forceinline__ void ce_desc(float& a, float& b) { const float hi = fmaxf(a, b), lo = fminf(a, b); a = hi; b = lo; }
template <int N> __device__ __forceinline__ void bitonic_sort_desc(float (&v)[N]) {
#pragma unroll
    for (int k = 2; k <= N; k <<= 1)
#pragma unroll
        for (int j = k >> 1; j > 0; j >>= 1)
#pragma unroll
            for (int i = 0; i < N; ++i) { const int l = i ^ j; if (l > i) { if ((i & k) == 0) ce_desc(v[i], v[l]); else ce_desc(v[l], v[i]); } }
}
template <int N> __device__ __forceinline__ void bitonic_merge_desc(float (&v)[N]) {
#pragma unroll
    for (int j = N >> 1; j > 0; j >>= 1)
#pragma unroll
        for (int i = 0; i < N; ++i) { const int l = i ^ j; if (l > i) ce_desc(v[i], v[l]); }
}
__device__ __forceinline__ void merge_top16(float (&a)[16], const float (&b)[16]) {
#pragma unroll
    for (int i = 0; i < 16; ++i) a[i] = fmaxf(a[i], b[15 - i]);
    bitonic_merge_desc<16>(a);
}
__device__ __forceinline__ void topk_unit(const Frame& F, int tg, int h, const bf16* QP, int* TOPI, float* TOPG) {
    const int lane = F.lane, fr = lane & 15, fq = lane >> 4;
    const int t0 = tg * 16;
    LAS float* sl = (LAS float*)(F.lds + 65536) + F.wave * 512;
    float s01[2][16];
#pragma unroll
    for (int p = 0; p < 2; ++p) {
        f32x4 acc[8];
#pragma unroll
        for (int mt = 0; mt < 8; ++mt) acc[mt] = (f32x4){0.f, 0.f, 0.f, 0.f};
        const bf16* qp = QP + (size_t)(t0 + fr) * D_MODEL + h * 256 + p * 128 + 8 * fq;
        const LAS unsigned char* kp = F.lds + p * 32768 + fr * 256;
#pragma unroll
        for (int kk = 0; kk < 4; ++kk) { const bf16x8 bq = *(const bf16x8*)(qp + 32 * kk);
#pragma unroll
            for (int mt = 0; mt < 8; ++mt) { const bf16x8 ak = *(const LAS bf16x8*)(kp + mt * 4096 + (((4 * kk + fq) ^ fr) << 4));
                acc[mt] = __builtin_amdgcn_mfma_f32_16x16x32_bf16(ak, bq, acc[mt], 0, 0, 0); } }
        float a[16], b[16];
#pragma unroll
        for (int mt = 0; mt < 8; ++mt)
#pragma unroll
            for (int e = 0; e < 4; ++e) { const unsigned n = (unsigned)(16 * mt + 4 * fq + e); const float pk = __uint_as_float((__float_as_uint(acc[mt][e]) & ~0x7Fu) | n);
                if (mt < 4) a[mt * 4 + e] = pk; else b[(mt - 4) * 4 + e] = pk; }
        bitonic_sort_desc<16>(a); bitonic_sort_desc<16>(b); merge_top16(a, b);
#pragma unroll
        for (int i = 0; i < 16; ++i) b[i] = shx(a[i], 16, F.lane);
        merge_top16(a, b);
#pragma unroll
        for (int i = 0; i < 16; ++i) b[i] = shx(a[i], 32, F.lane);
        merge_top16(a, b);
#pragma unroll
        for (int i = 0; i < 16; ++i) s01[p][i] = a[i];
    }
    if (fq == 0) {
#pragma unroll
        for (int p = 0; p < 2; ++p)
#pragma unroll
            for (int i = 0; i < 16; ++i) sl[fr * 32 + p * 16 + i] = s01[p][i];
    }
    float c[4][16];
#pragma unroll
    for (int gidx = 0; gidx < 4; ++gidx)
#pragma unroll
        for (int i = 0; i < 16; ++i) c[gidx][i] = -3.0e38f;
#define CAND(n, i, j) do { const float v_ = __uint_as_float(__float_as_uint(s01[0][i]) & ~0x7Fu) + __uint_as_float(__float_as_uint(s01[1][j]) & ~0x7Fu); \
        c[(n) >> 4][(n) & 15] = __uint_as_float((__float_as_uint(v_) & ~0xFFu) | (unsigned)((i) * 16 + (j))); } while (0)
    CAND(0, 0, 0); CAND(1, 0, 1); CAND(2, 0, 2); CAND(3, 0, 3); CAND(4, 0, 4); CAND(5, 0, 5); CAND(6, 0, 6); CAND(7, 0, 7);
    CAND(8, 0, 8); CAND(9, 0, 9); CAND(10, 0, 10); CAND(11, 0, 11); CAND(12, 0, 12); CAND(13, 0, 13); CAND(14, 0, 14); CAND(15, 0, 15);
    CAND(16, 1, 0); CAND(17, 1, 1); CAND(18, 1, 2); CAND(19, 1, 3); CAND(20, 1, 4); CAND(21, 1, 5); CAND(22, 1, 6); CAND(23, 1, 7);
    CAND(24, 2, 0); CAND(25, 2, 1); CAND(26, 2, 2); CAND(27, 2, 3); CAND(28, 2, 4);
    CAND(29, 3, 0); CAND(30, 3, 1); CAND(31, 3, 2); CAND(32, 3, 3);
    CAND(33, 4, 0); CAND(34, 4, 1); CAND(35, 4, 2);
    CAND(36, 5, 0); CAND(37, 5, 1); CAND(38, 6, 0); CAND(39, 6, 1); CAND(40, 7, 0); CAND(41, 7, 1);
    CAND(42, 8, 0); CAND(43, 9, 0); CAND(44, 10, 0); CAND(45, 11, 0); CAND(46, 12, 0); CAND(47, 13, 0); CAND(48, 14, 0); CAND(49, 15, 0);
#undef CAND
    bitonic_sort_desc<16>(c[0]); bitonic_sort_desc<16>(c[1]); bitonic_sort_desc<16>(c[2]); bitonic_sort_desc<16>(c[3]);
    merge_top16(c[0], c[1]); merge_top16(c[2], c[3]); merge_top16(c[0], c[2]);
    LDS_WAIT(); asm volatile("" ::: "memory");
    float sc[16]; int ix[16]; float mx = -3.0e38f;
#pragma unroll
    for (int w = 0; w < 16; ++w) { const unsigned id = __float_as_uint(c[0][w]) & 0xFFu; const unsigned u0 = __float_as_uint(sl[fr * 32 + (id >> 4)]), u1 = __float_as_uint(sl[fr * 32 + 16 + (id & 15)]);
        sc[w] = __uint_as_float(u0 & ~0x7Fu) + __uint_as_float(u1 & ~0x7Fu); ix[w] = (int)((u0 & 0x7Fu) * NKEYS + (u1 & 0x7Fu)); mx = fmaxf(mx, sc[w]); }
    float sum = 0.f;
#pragma unroll
    for (int w = 0; w < 16; ++w) { sc[w] = __builtin_amdgcn_exp2f((sc[w] - mx) * 1.4426950409f); sum += sc[w]; }
    const float rs = __builtin_amdgcn_rcpf(sum);
    if (fq == 0) { int* ti = TOPI + (size_t)(t0 + fr) * 128 + h * 16; float* tgp = TOPG + (size_t)(t0 + fr) * 128 + h * 16;
#pragma unroll
        for (int w = 0; w < 16; ++w) { ti[w] = ix[w]; tgp[w] = sc[w] * rs; } }
    LDS_WAIT(); asm volatile("" ::: "memory");
}

typedef float f32x2 __attribute__((ext_vector_type(2)));
struct PeerIdx { int i0, i1; float a0, a1; };
struct PeerRow { v4u x; float xs; };
__device__ __forceinline__ void pu_gather(int t, int sl, int lane, const PeerIdx& I, v4u (&wu)[16], PeerRow& R, const unsigned char* XQ, const float* XS, const unsigned char* PU8) {
    const int r = lane & 7, g = lane >> 3;
    const unsigned char* sb = PU8 + (size_t)sl * NEXP * 128;
#pragma unroll
    for (int k = 0; k < 16; ++k) { const int e = __shfl(k < 8 ? I.i0 : I.i1, (8 * k + g) & 63); unsigned o_ = (unsigned)(e * 128 + 16 * r); asm volatile("" : "+v"(o_)); wu[k] = *(const v4u*)(sb + o_); }
    R.x = NTL((const v4u*)(XQ + (size_t)t * D_MODEL + 128 * sl + 16 * r)); R.xs = XS[(size_t)t * 16 + sl];
}
__device__ __forceinline__ void pu_compute(int t, int sl, int lane, const v4u (&wu)[16], const PeerRow& R, bf16* PART) {
    const int r = lane & 7, g = lane >> 3;
    float d[16];
#pragma unroll
    for (int k = 0; k < 16; ++k) { int a_ = __builtin_amdgcn_sdot4((int)wu[k].x, (int)R.x.x, 0, false); a_ = __builtin_amdgcn_sdot4((int)wu[k].y, (int)R.x.y, a_, false);
        a_ = __builtin_amdgcn_sdot4((int)wu[k].z, (int)R.x.z, a_, false); a_ = __builtin_amdgcn_sdot4((int)wu[k].w, (int)R.x.w, a_, false); d[k] = (float)a_; }
    const bool b0 = lane & 1, b1 = lane & 2, b2 = lane & 4;
    float res[2];
#pragma unroll
    for (int hf = 0; hf < 2; ++hf) { float e1[4], f1[2];
#pragma unroll
        for (int m = 0; m < 4; ++m) e1[m] = (b0 ? d[8 * hf + 2 * m + 1] : d[8 * hf + 2 * m]) + shx(b0 ? d[8 * hf + 2 * m] : d[8 * hf + 2 * m + 1], 1, lane);
#pragma unroll
        for (int n = 0; n < 2; ++n) f1[n] = (b1 ? e1[2 * n + 1] : e1[2 * n]) + shx(b1 ? e1[2 * n] : e1[2 * n + 1], 2, lane);
        res[hf] = (b2 ? f1[1] : f1[0]) + shx(b2 ? f1[0] : f1[1], 4, lane); }
    *(unsigned*)(PART + ((size_t)t * 16 + sl) * 128 + 16 * r + 2 * g) = cvt_pk_bf16(res[0] * R.xs, res[1] * R.xs);
}
__device__ __forceinline__ void peer_fin_token(int t, int lane, const bf16* PART, const int* TOPI, float* TOPG, const float* USC, const float* VSC, const u64* sqx) {
    const float r2 = __builtin_amdgcn_rsqf(fx_get(sqx + t) * (1.f / D_MODEL) + EPS);
    float s0 = 0.f, s1 = 0.f;
#pragma unroll
    for (int sl = 0; sl < 16; ++sl) { const unsigned w = NTL((const unsigned*)(PART + ((size_t)t * 16 + sl) * 128 + 16 * (lane >> 3) + 2 * (lane & 7))); s0 += bf_lo(w); s1 += bf_hi(w); }
    const int e0 = TOPI[(size_t)t * 128 + lane], e1 = TOPI[(size_t)t * 128 + 64 + lane];
    float* gp = TOPG + (size_t)t * 128;
    gp[lane] = gelu_t(s0 * USC[e0] * r2) * gp[lane] * VSC[e0]; gp[64 + lane] = gelu_t(s1 * USC[e1] * r2) * gp[64 + lane] * VSC[e1];
}
__device__ __forceinline__ void pv_gather(int t, int sl, int lane, const PeerIdx& I, v4u (&wv)[16], float (&xv)[2], const bf16* X, const unsigned char* PV8) {
    const int r = lane & 7, g = lane >> 3;
    const unsigned char* sb = PV8 + (size_t)sl * NEXP * 128;
#pragma unroll
    for (int k = 0; k < 16; ++k) { const int e = __shfl(k < 8 ? I.i0 : I.i1, (8 * k + g) & 63); unsigned o_ = (unsigned)(e * 128 + 16 * r); asm volatile("" : "+v"(o_)); wv[k] = *(const v4u*)(sb + o_); }
    const int cb = 16 * r + ((lane & 8) ? 8 : 0) + ((lane & 16) ? 4 : 0) + ((lane & 32) ? 2 : 0);
    const unsigned xw = *(const unsigned*)(X + (size_t)t * D_MODEL + 128 * sl + cb); xv[0] = bf_lo(xw); xv[1] = bf_hi(xw);
}
__device__ __forceinline__ void pv_compute(int t, int sl, int lane, const PeerIdx& I, const v4u (&wv)[16], const float (&xv)[2], bf16* X, u64* ssq2) {
    const int r = lane & 7, g = lane >> 3;
    float oa[16];
    { f32x2 o2[8]; float ak[16];
#pragma unroll
      for (int e = 0; e < 8; ++e) o2[e] = (f32x2){0.f, 0.f};
#pragma unroll
      for (int k = 0; k < 16; ++k) ak[k] = __shfl(k < 8 ? I.a0 : I.a1, (8 * k + g) & 63);
#pragma unroll
      for (int k = 0; k < 16; ++k) { const f32x2 a2 = {ak[k], ak[k]};
#pragma unroll
          for (int q = 0; q < 4; ++q) { const int w_ = (int)(q == 0 ? wv[k].x : q == 1 ? wv[k].y : q == 2 ? wv[k].z : wv[k].w);
              o2[2 * q] += __builtin_amdgcn_cvt_pk_f32_fp8(w_, false) * a2; o2[2 * q + 1] += __builtin_amdgcn_cvt_pk_f32_fp8(w_, true) * a2; } }
#pragma unroll
      for (int e = 0; e < 8; ++e) { oa[2 * e] = o2[e][0]; oa[2 * e + 1] = o2[e][1]; } }
    const bool c0 = lane & 8, c1 = lane & 16, c2 = lane & 32;
    float p1[8], p2[4], p3[2];
#pragma unroll
    for (int m = 0; m < 8; ++m) { const float keep = c0 ? oa[m + 8] : oa[m], send = c0 ? oa[m] : oa[m + 8];
        p1[m] = keep + __builtin_bit_cast(float, __builtin_amdgcn_update_dpp(0, __builtin_bit_cast(int, send), 0x128, 0xF, 0xF, true)); }
#pragma unroll
    for (int n = 0; n < 4; ++n) { auto sw = __builtin_amdgcn_permlane16_swap(__float_as_uint(p1[n]), __float_as_uint(p1[n + 4]), false, false); p2[n] = __uint_as_float(sw[0]) + __uint_as_float(sw[1]); }
#pragma unroll
    for (int q = 0; q < 2; ++q) { auto sw = __builtin_amdgcn_permlane32_swap(__float_as_uint(p2[q]), __float_as_uint(p2[q + 2]), false, false); p3[q] = __uint_as_float(sw[0]) + __uint_as_float(sw[1]); }
    const int cb = 16 * r + (c0 ? 8 : 0) + (c1 ? 4 : 0) + (c2 ? 2 : 0);
    const float y0 = xv[0] + p3[0], y1 = xv[1] + p3[1];
    *(unsigned*)(X + (size_t)t * D_MODEL + 128 * sl + cb) = cvt_pk_bf16(y0, y1);
    const float ss = wave_sum(y0 * y0 + y1 * y1, lane);
    if (lane == 0) fx_add(ssq2 + t, ss);
}
__device__ __forceinline__ void row8_load(f32x4 (&v)[8], const float* src, int lane) {
    const f32x4* xr = (const f32x4*)src + lane;
#pragma unroll
    for (int j = 0; j < 8; ++j) v[j] = __builtin_nontemporal_load(xr + 64 * j);
}
__device__ __forceinline__ unsigned pack_i8x4(f32x4 v) {
    int i[4];
#pragma unroll
    for (int e = 0; e < 4; ++e) i[e] = (int)__builtin_rintf(__builtin_amdgcn_fmed3f(v[e], -127.f, 127.f));
    const unsigned lo = __builtin_amdgcn_perm((unsigned)i[1], (unsigned)i[0], 0x0c0c0400u), hi = __builtin_amdgcn_perm((unsigned)i[3], (unsigned)i[2], 0x0c0c0400u);
    return __builtin_amdgcn_perm(hi, lo, 0x05040100u); }
template <bool I8>
__device__ __forceinline__ void row_to_fp8(f32x4 (&v)[8], unsigned char* tab, int e, float* inv_scale, int lane, const f32x4* colmul) {
    float am = 0.f;
#pragma unroll
    for (int j = 0; j < 8; ++j) { if (colmul) v[j] = v[j] * colmul[j];
        am = fmaxf(am, fmaxf(fmaxf(fabsf(v[j][0]), fabsf(v[j][1])), fmaxf(fabsf(v[j][2]), fabsf(v[j][3])))); }
#pragma unroll
    for (int o = 1; o < 64; o <<= 1) am = fmaxf(am, shx(am, o, lane));
    am = fmaxf(am, 1e-30f); const float sc = (I8 ? 127.f : 256.f) / am;
#pragma unroll
    for (int j = 0; j < 8; ++j) { int w = 0; if constexpr (I8) w = (int)pack_i8x4(v[j] * sc); else { w = __builtin_amdgcn_cvt_pk_fp8_f32(v[j][0] * sc, v[j][1] * sc, w, false); w = __builtin_amdgcn_cvt_pk_fp8_f32(v[j][2] * sc, v[j][3] * sc, w, true); } const int dw = lane + 64 * j; unsigned o_ = (unsigned)(dw >> 5) * (unsigned)(NEXP * 128) + (unsigned)(dw & 31) * 4u; asm volatile("" : "+v"(o_)); *(unsigned*)(tab + (size_t)e * 128 + o_) = (unsigned)w; }
    if (lane == 0) *inv_scale = am * (I8 ? 1.f / 127.f : 1.f / 256.f);
}

__global__ void __launch_bounds__(512, 2) mk_fwd(Args args) {
    extern __shared__ __attribute__((aligned(16))) unsigned char lds[];
    Frame F;
    F.lds = (LAS unsigned char*)lds;
    F.wave = __builtin_amdgcn_readfirstlane((int)threadIdx.x >> 6); F.lane = lane_id(); F.tid = F.wave * 64 + F.lane;
    F.G = gridDim.x; { const int bx = blockIdx.x; F.vcu = (F.G % 8 == 0) ? (bx % 8) * (F.G / 8) + bx / 8 : bx; }
    unsigned char* ws = args.ws;
    gu32* ctl = (gu32*)(ws + WS_CTL);
    volatile LAS unsigned* MISC = (volatile LAS unsigned*)(F.lds + MISC_OFF);
    for (int u = F.tid; u < (LDS_BYTES - LDSCTL_OFF) / 4; u += 512) ((LAS unsigned*)(F.lds + LDSCTL_OFF))[u] = 0u;
    __syncthreads();
    XcdBarrier bar; bar.bar = (unsigned*)(ctl + CW_BAR); bar.x = 0; bar.st = nullptr;
    bar = xcd_barrier_post((unsigned*)(ctl + CW_BAR), MISC + 8, F.wave);
#define GRID_BAR() xcd_barrier(bar)
#define PHASE_BEGIN() do { F.lane = lane_id(); asm volatile("" : "+v"(F.lane)); F.tid = F.wave * 64 + F.lane; } while (0)
    const float* x = args.in[0]; const int* positions = (const int*)args.in[1]; const float* g_norm1 = args.in[2]; const float* w_in = args.in[3];
    const float* g_q_a = args.in[4]; const float* w_uq = args.in[5]; const float* g_kv_a = args.in[6]; const float* w_ukv = args.in[7];
    const float* sgu_ln_g = args.in[8]; const float* sgu_ln_b = args.in[9]; const float* w_spatial = args.in[10]; const float* b_spatial = args.in[11];
    const float* b_gate = args.in[12]; const float* w_out = args.in[13]; const float* g_norm2 = args.in[14]; const float* w_peer_q = args.in[15];
    const float* peer_keys = args.in[16]; const float* peer_u = args.in[17]; const float* peer_v = args.in[18]; const float* g_final = args.in[19];
    float* out = args.out;
    bf16* KEYS = (bf16*)(ws + WS_KEYS); bf16* WSP = (bf16*)(ws + WS_WSP); bf16* WUQ = (bf16*)(ws + WS_WUQ); bf16* WUKV = (bf16*)(ws + WS_WUKV);
    bf16* WOUT = (bf16*)(ws + WS_WOUT); bf16* WPQ = (bf16*)(ws + WS_WPQ); float* ROPE = (float*)(ws + WS_ROPE);
    unsigned char* XN8 = ws + WS_XN8; unsigned char* WIN8 = ws + WS_WIN8; unsigned char* CQKV = ws + WS_CQKV; bf16* U = (bf16*)(ws + WS_U); bf16* VG = (bf16*)(ws + WS_VG);
    unsigned char* Vb = ws + WS_V; unsigned char* Kb = ws + WS_K; unsigned char* KR = ws + WS_KR; unsigned char* Qb = ws + WS_Q; bf16* GA = (bf16*)(ws + WS_GA); bf16* X2 = (bf16*)(ws + WS_X2);
    bf16* X1B = (bf16*)(ws + WS_X1B); unsigned char* PU = ws + WS_PU; unsigned char* PV = ws + WS_PV; float* USC = (float*)(ws + WS_PSC); float* VSC = USC + NEXP; bf16* PART = (bf16*)(ws + WS_PART); bf16* QP = (bf16*)(ws + WS_QP);
    int* TOPI = (int*)(ws + WS_TOPI); float* TOPG = (float*)(ws + WS_TOPG); unsigned char* X1Q = ws + WS_X1Q; float* XS = (float*)(ws + WS_XS);
    u64* SQQ = (u64*)(ws + CTL_STATS); u64* SQKV = SQQ + MTOK; u64* SSUM = SQKV + MTOK; u64* SSQ = SSUM + MTOK; u64* SQX1 = SSQ + MTOK;
    const int gw = F.vcu * 8 + F.wave, NGW = F.G * 8;

    {
        LAS float* scr = (LAS float*)(F.lds + RING_OFF + F.wave * 16384);
        constexpr int I_IN8 = (D_MODEL / 64) * (IN8_ROWS / 32), I_UQ = (QL / 64) * (NQ_COLS / 32), I_UKV = (QL / 64) * (NKV_COLS / 32), I_O = (D_MODEL / 64) * (D_MODEL / 32);
        constexpr int NITEMS = I_IN8 + I_UQ + I_UKV + 2 * I_O;
        for (int it = gw; it < NITEMS; it += NGW) {
            int r = it;
            if (r < I_IN8) { p0_transpose_item<true>(w_in, D_MODEL, IN_COLS, (bf16*)WIN8, IN8_ROWS, 3, nullptr, scr, r, F.lane); continue; } r -= I_IN8;
            if (r < I_UQ) { p0_transpose_item<true>(w_uq, QL, NQ_COLS, WUQ, NQ_COLS, 2, g_q_a, scr, r, F.lane); continue; } r -= I_UQ;
            if (r < I_UKV) { p0_transpose_item<true>(w_ukv, QL, NKV_COLS, WUKV, NKV_COLS, 0, g_kv_a, scr, r, F.lane); continue; } r -= I_UKV;
            if (r < I_O) { p0_transpose_item(w_out, D_MODEL, D_MODEL, WOUT, D_MODEL, 0, nullptr, scr, r, F.lane); continue; } r -= I_O;
            p0_transpose_item(w_peer_q, D_MODEL, D_MODEL, WPQ, D_MODEL, 0, g_norm2, scr, r, F.lane);
        }
        {
#define XN_LOAD(v, m_) do { const f32x4* xr_ = (const f32x4*)(x + (size_t)(m_) * D_MODEL) + F.lane; _Pragma("unroll") for (int j = 0; j < 8; ++j) v[j] = __builtin_nontemporal_load(xr_ + 64 * j); } while (0)
#define XN_DO(v, m_) do { float s_ = 0.f; _Pragma("unroll") for (int j = 0; j < 8; ++j) s_ += (v[j][0] * v[j][0] + v[j][1] * v[j][1]) + (v[j][2] * v[j][2] + v[j][3] * v[j][3]); \
            const float r_ = __builtin_amdgcn_rsqf(wave_sum(s_, F.lane) * (1.f / D_MODEL) + EPS); \
            _Pragma("unroll") for (int j = 0; j < 8; ++j) { const f32x4 h_ = v[j] * r_ * gn[j]; \
                const f32x4 h8_ = __builtin_elementwise_min(__builtin_elementwise_max(h_ * XN8_SCALE, (f32x4){-448.f, -448.f, -448.f, -448.f}), (f32x4){448.f, 448.f, 448.f, 448.f}); \
                int p_ = 0; p_ = __builtin_amdgcn_cvt_pk_fp8_f32(h8_[0], h8_[1], p_, false); p_ = __builtin_amdgcn_cvt_pk_fp8_f32(h8_[2], h8_[3], p_, true); ((unsigned*)(XN8 + (size_t)(m_) * D_MODEL))[F.lane + 64 * j] = (unsigned)p_; } } while (0)
            f32x4 gn[8];
#pragma unroll
            for (int j = 0; j < 8; ++j) gn[j] = *((const f32x4*)g_norm1 + F.lane + 64 * j);
            f32x4 va[8], vb[8]; int m = gw; if (m < MTOK) XN_LOAD(va, m);
#pragma unroll 1
            for (; m < MTOK; m += 2 * NGW) {
                if (m + NGW < MTOK) XN_LOAD(vb, m + NGW);
                XN_DO(va, m);
                if (m + NGW < MTOK) { if (m + 2 * NGW < MTOK) XN_LOAD(va, m + 2 * NGW); XN_DO(vb, m + NGW); } }
#undef XN_LOAD
#undef XN_DO
        }
        for (int it = gw; it < MTOK / 2; it += NGW) { const int row = 2 * it + (F.lane >> 5), i = F.lane & 31;
            const float freq = exp2f(-(float)i * (13.287712379549449f / 32.f)); const float ang = (float)positions[row] * freq;
            const double ad = (double)ang; const double k = __builtin_rint(ad * 0.15915494309189535); const float red = (float)(ad - k * 6.283185307179586);
            ROPE[(size_t)row * 32 + i] = __cosf(red); ROPE[(size_t)MTOK * 32 + (size_t)row * 32 + i] = __sinf(red); }
        for (int it = gw; it < (PHEADS * 2 * NKEYS * KD) / 512; it += NGW) { const size_t e = (size_t)it * 512 + 8 * F.lane; const f32x4 a = *(const f32x4*)(peer_keys + e), b = *(const f32x4*)(peer_keys + e + 4);
            v4u w; w.x = cvt_pk_bf16(a[0], a[1]); w.y = cvt_pk_bf16(a[2], a[3]); w.z = cvt_pk_bf16(b[0], b[1]); w.w = cvt_pk_bf16(b[2], b[3]); *(v4u*)(KEYS + e) = w; }
        for (int it = gw; it < (8 * 128 * 128) / 512; it += NGW) { const size_t e = (size_t)it * 512 + 8 * F.lane; const int t = (int)((e >> 7) & 127), s0 = (int)(e & 127);
            const f32x4 a = *(const f32x4*)(w_spatial + e), b = *(const f32x4*)(w_spatial + e + 4); float v[8] = {a[0], a[1], a[2], a[3], b[0], b[1], b[2], b[3]};
#pragma unroll
            for (int j = 0; j < 8; ++j) if (s0 + j > t) v[j] = 0.f;
            v4u w; w.x = cvt_pk_bf16(v[0], v[1]); w.y = cvt_pk_bf16(v[2], v[3]); w.z = cvt_pk_bf16(v[4], v[5]); w.w = cvt_pk_bf16(v[6], v[7]); *(v4u*)(WSP + e) = w; }
        for (size_t it = (size_t)gw * 64 + F.lane; it < (size_t)5 * MTOK; it += (size_t)NGW * 64) SQQ[it] = 0ull;
        GRID_BAR();
    }
    {
        PHASE_BEGIN();
        pg8::EpiIn E{0, IN8_DESCALE, U, GA, VG, CQKV, KR, b_gate, ROPE, SQQ, SQKV, SSUM, SSQ};
        { pg8::Gemm g{(const bf16*)XN8, (const bf16*)WIN8, MTOK, IN8_ROWS, D_MODEL / 2, D_MODEL / 2}; pg8::StaticOrder S; S.init(MTOK, IN8_ROWS, F.G, (int)blockIdx.x);
          pg8::gemm_phase<pg8::EpiIn, pg8::StaticOrder, true, true, true>(F.lds + RING_OFF, g, S, E, F.wave); }
        GRID_BAR();
    }
    {
        PHASE_BEGIN();
        { pg8::Gemm g{(const bf16*)CQKV, WUQ, MTOK, NQ_COLS, QL / 2, 512}; pg8::StaticOrder S; S.init(MTOK, NQ_COLS, F.G, (int)blockIdx.x);
          pg8::EpiQ E{Qb, SQQ, ROPE}; pg8::gemm_phase<pg8::EpiQ, pg8::StaticOrder, true, true, true>(F.lds + RING_OFF, g, S, E, F.wave); }
        { pg8::Gemm g{(const bf16*)(CQKV + QL), WUKV, MTOK, NKV_COLS, QL / 2, 512}; pg8::StaticOrder S; S.init(MTOK, NKV_COLS, F.G, (int)blockIdx.x);
          pg8::EpiKV E{Kb, Vb, SQKV}; pg8::gemm_phase<pg8::EpiKV, pg8::StaticOrder, true, true, true, true>(F.lds + RING_OFF, g, S, E, F.wave); }
        PHASE_BEGIN();
        for (int un = F.vcu; un < (MTOK / 128) * 8; un += F.G) sgu_unit(F, un, VG, U, WSP, sgu_ln_g, sgu_ln_b, b_spatial, SSUM, SSQ);
        GRID_BAR();
    }
    {
        PHASE_BEGIN();
        if (F.G == 256) { const int s = F.vcu & 7, bh = F.vcu >> 3;
#pragma unroll 1
            for (int i = 0; i < 4; ++i) { const int qb = (i == 0) ? s : (i == 1) ? 15 - s : (i == 2) ? 16 + s : 31 - s; att::attn_unit(bh, qb, Qb, Kb, KR, Vb, GA, U, (char*)lds + RING_OFF, F.lds + RING_OFF, F.wave); }
        } else {
#pragma unroll 1
            for (int un = F.vcu; un < 1024; un += F.G) att::attn_unit(un >> 5, 31 - (un & 31), Qb, Kb, KR, Vb, GA, U, (char*)lds + RING_OFF, F.lds + RING_OFF, F.wave);
        }
        GRID_BAR();
    }
    {
        PHASE_BEGIN();
        for (int it = gw * 64 + F.lane; it < MTOK; it += NGW * 64) SQQ[it] = 0ull;
        { f32x4 va[8], vb[8];
#define CONV_ROWS(SRC, TAB, SC, I8_, CM) do { int e = gw; if (e < NEXP) row8_load(va, SRC + (size_t)e * D_MODEL, F.lane); \
          _Pragma("unroll 1") for (; e < NEXP; e += 2 * NGW) { \
              if (e + NGW < NEXP) row8_load(vb, SRC + (size_t)(e + NGW) * D_MODEL, F.lane); \
              row_to_fp8<I8_>(va, TAB, e, SC + e, F.lane, CM); \
              if (e + NGW < NEXP) { if (e + 2 * NGW < NEXP) row8_load(va, SRC + (size_t)(e + 2 * NGW) * D_MODEL, F.lane); row_to_fp8<I8_>(vb, TAB, e + NGW, SC + e + NGW, F.lane, CM); } } } while (0)
          f32x4 gn2[8];
#pragma unroll
          for (int j = 0; j < 8; ++j) gn2[j] = *((const f32x4*)g_norm2 + F.lane + 64 * j);
          CONV_ROWS(peer_u, PU, USC, true, gn2);
          CONV_ROWS(peer_v, PV, VSC, false, (const f32x4*)nullptr);
#undef CONV_ROWS
        }
        VM_WAIT(); __syncthreads();
        pg8::Gemm g{U, WOUT, MTOK, D_MODEL, D_MODEL, D_MODEL}; pg8::StaticOrder S; S.init(MTOK, D_MODEL, F.G, (int)blockIdx.x);
        pg8::EpiOut E{x, X1B, SQX1}; pg8::gemm_phase<pg8::EpiOut, pg8::StaticOrder, true, true>(F.lds + RING_OFF, g, S, E, F.wave);
        GRID_BAR();
    }
    {
        PHASE_BEGIN();
        pg8::Gemm g{X1B, WPQ, MTOK, D_MODEL, D_MODEL, D_MODEL}; pg8::StaticOrder S; S.init(MTOK, D_MODEL, F.G, (int)blockIdx.x);
        pg8::EpiPQ E{QP, SQX1}; pg8::gemm_phase<pg8::EpiPQ, pg8::StaticOrder, true, true>(F.lds + RING_OFF, g, S, E, F.wave);
        GRID_BAR();
    }
    {
        PHASE_BEGIN();
#pragma unroll 1
        for (int t = gw; t < MTOK; t += NGW) { const bf16* xp = X1B + (size_t)t * D_MODEL + 32 * F.lane; v4u xw[4];
#pragma unroll
            for (int j = 0; j < 4; ++j) xw[j] = *(const v4u*)(xp + 8 * j);
            float xf[32]; float am = 0.f;
#pragma unroll
            for (int j = 0; j < 4; ++j) { const unsigned w4[4] = {xw[j].x, xw[j].y, xw[j].z, xw[j].w};
#pragma unroll
                for (int q = 0; q < 4; ++q) { xf[8 * j + 2 * q] = bf_lo(w4[q]); xf[8 * j + 2 * q + 1] = bf_hi(w4[q]); am = fmaxf(am, fmaxf(fabsf(xf[8 * j + 2 * q]), fabsf(xf[8 * j + 2 * q + 1]))); } }
            am = fmaxf(am, shx(am, 1, F.lane)); am = fmaxf(am, shx(am, 2, F.lane)); am = fmaxf(am, 1e-30f);
            const float sc = 127.f / am; v4u q0, q1;
            q0.x = pack_i8x4((f32x4){xf[0], xf[1], xf[2], xf[3]} * sc); q0.y = pack_i8x4((f32x4){xf[4], xf[5], xf[6], xf[7]} * sc); q0.z = pack_i8x4((f32x4){xf[8], xf[9], xf[10], xf[11]} * sc); q0.w = pack_i8x4((f32x4){xf[12], xf[13], xf[14], xf[15]} * sc);
            q1.x = pack_i8x4((f32x4){xf[16], xf[17], xf[18], xf[19]} * sc); q1.y = pack_i8x4((f32x4){xf[20], xf[21], xf[22], xf[23]} * sc); q1.z = pack_i8x4((f32x4){xf[24], xf[25], xf[26], xf[27]} * sc); q1.w = pack_i8x4((f32x4){xf[28], xf[29], xf[30], xf[31]} * sc);
            unsigned char* qp = X1Q + (size_t)t * D_MODEL + 32 * F.lane; *(v4u*)qp = q0; *(v4u*)(qp + 16) = q1;
            if ((F.lane & 3) == 0) XS[(size_t)t * 16 + (F.lane >> 2)] = am * (1.f / 127.f); }
        { const int NH8 = (F.G % 8 == 0) ? 8 : 1, grp = (int)blockIdx.x % NH8, bi = (int)blockIdx.x / NH8, nbl = F.G / NH8;
#pragma unroll 1
          for (int h = grp; h < PHEADS; h += NH8) {
#pragma unroll
              for (int it = 0; it < 8; ++it) { const int id = it * 512 + F.tid, c = id & 15, n = (id >> 4) & 127, pp = id >> 11;
                  const v4u w = *(const v4u*)(KEYS + ((size_t)(h * 2 + pp) * NKEYS + n) * KD + 8 * c);
                  *(LAS v4u*)(F.lds + pp * 32768 + n * 256 + ((c ^ (n & 15)) << 4)) = w; }
              __syncthreads();
#pragma unroll 1
              for (int tg = bi * 8 + F.wave; tg < MTOK / 16; tg += nbl * 8) topk_unit(F, tg, h, QP, TOPI, TOPG);
              __syncthreads(); } }
        GRID_BAR();
    }
    {
        PHASE_BEGIN();
        const int NG = (F.G % 8 == 0) ? 8 : 1, grp = (int)blockIdx.x % NG, li = (int)blockIdx.x / NG, nl = F.G / NG;
        const int t0 = li * 8 + F.wave, ts = nl * 8, NTW = (MTOK - t0 + ts - 1) / ts;
#define LOAD_IDX(I, n) do { const int t_ = t0 + (n) * ts; I.i0 = NTL(TOPI + (size_t)t_ * 128 + F.lane); I.i1 = NTL(TOPI + (size_t)t_ * 128 + 64 + F.lane); } while (0)
#pragma unroll 1
        for (int sl = grp; sl < 16; sl += NG) {
            PeerIdx IA, IB; PeerRow RA, RB; v4u wA[16], wB[16];
            LOAD_IDX(IA, 0); pu_gather(t0, sl, F.lane, IA, wA, RA, X1Q, XS, PU); if (NTW > 1) LOAD_IDX(IB, 1);
#pragma unroll 1
            for (int n = 0; n < NTW; n += 2) {
                if (n + 2 < NTW) LOAD_IDX(IA, n + 2);
                if (n + 1 < NTW) pu_gather(t0 + (n + 1) * ts, sl, F.lane, IB, wB, RB, X1Q, XS, PU);
                pu_compute(t0 + n * ts, sl, F.lane, wA, RA, PART);
                if (n + 1 < NTW) {
                    if (n + 3 < NTW) LOAD_IDX(IB, n + 3);
                    if (n + 2 < NTW) pu_gather(t0 + (n + 2) * ts, sl, F.lane, IA, wA, RA, X1Q, XS, PU);
                    pu_compute(t0 + (n + 1) * ts, sl, F.lane, wB, RB, PART); }
            } }
#undef LOAD_IDX
        GRID_BAR();
#pragma unroll 1
        for (int t = gw; t < MTOK; t += NGW) peer_fin_token(t, F.lane, PART, TOPI, TOPG, USC, VSC, SQX1);
        GRID_BAR();
#define LOAD_IDXA(I, n) do { const int t_ = t0 + (n) * ts; I.i0 = NTL(TOPI + (size_t)t_ * 128 + F.lane); I.i1 = NTL(TOPI + (size_t)t_ * 128 + 64 + F.lane); \
            I.a0 = NTL(TOPG + (size_t)t_ * 128 + F.lane); I.a1 = NTL(TOPG + (size_t)t_ * 128 + 64 + F.lane); } while (0)
#pragma unroll 1
        for (int sl = grp; sl < 16; sl += NG) {
            PeerIdx IA, IB, IC; float xA[2], xB[2]; v4u wA[16], wB[16];
            LOAD_IDXA(IA, 0); pv_gather(t0, sl, F.lane, IA, wA, xA, X1B, PV); if (NTW > 1) LOAD_IDXA(IB, 1);
#pragma unroll 1
            for (int n = 0; n < NTW; n += 2) {
                if (n + 2 < NTW) LOAD_IDXA(IC, n + 2);
                if (n + 1 < NTW) pv_gather(t0 + (n + 1) * ts, sl, F.lane, IB, wB, xB, X1B, PV);
                pv_compute(t0 + n * ts, sl, F.lane, IA, wA, xA, X2, SQQ);
                IA = IC;
                if (n + 1 < NTW) {
                    if (n + 3 < NTW) LOAD_IDXA(IC, n + 3);
                    if (n + 2 < NTW) pv_gather(t0 + (n + 2) * ts, sl, F.lane, IA, wA, xA, X1B, PV);
                    pv_compute(t0 + (n + 1) * ts, sl, F.lane, IB, wB, xB, X2, SQQ);
                    IB = IC; }
            } }
#undef LOAD_IDXA
        GRID_BAR();
#pragma unroll 1
        for (int t = gw; t < MTOK; t += NGW) { const float rf = __builtin_amdgcn_rsqf(fx_get(SQQ + t) * (1.f / D_MODEL) + EPS);
            const v2u* xr = (const v2u*)(X2 + (size_t)t * D_MODEL) + F.lane; f32x4* orow = (f32x4*)(out + (size_t)t * D_MODEL) + F.lane;
#pragma unroll
            for (int j = 0; j < 8; ++j) { const v2u xw = NTL(xr + 64 * j); const f32x4 v = {bf_lo(xw.x), bf_hi(xw.x), bf_lo(xw.y), bf_hi(xw.y)}, gg = *((const f32x4*)g_final + F.lane + 64 * j); f32x4 o4;
#pragma unroll
                for (int e = 0; e < 4; ++e) o4[e] = v[e] * rf * gg[e];
                __builtin_nontemporal_store(o4, orow + 64 * j); } }
    }
#undef GRID_BAR
}

extern "C" void kernel_launch(void* const* d_in, const int* in_sizes, int n_in, void* d_out, int out_size, void* d_ws, size_t ws_size, hipStream_t stream) {
    static int grid = 0;
    if (grid == 0) {
        if (n_in != 20 || in_sizes[0] != MTOK * D_MODEL || out_size != MTOK * D_MODEL || ws_size < WS_END) {
            fprintf(stderr, "kernel_launch: unexpected shapes (n_in %d, in0 %d, out %d, ws %zu); nothing launched\n", n_in, n_in > 0 ? in_sizes[0] : -1, out_size, ws_size); grid = -1; return; }
        int dev = 0, cus = 0;
        if (hipGetDevice(&dev) != hipSuccess || hipDeviceGetAttribute(&cus, hipDeviceAttributeMultiprocessorCount, dev) != hipSuccess) { fprintf(stderr, "kernel_launch: device query failed\n"); grid = -1; return; }
        if (hipFuncSetAttribute((const void*)mk_fwd, hipFuncAttributeMaxDynamicSharedMemorySize, LDS_BYTES) != hipSuccess) { fprintf(stderr, "kernel_launch: hipFuncSetAttribute failed\n"); grid = -1; return; }
        (void)hipGetLastError();
        grid = cus;
    }
    if (grid < 0) return;
    (void)hipMemsetAsync((char*)d_ws + WS_CTL, 0, CTL_ZERO_BYTES, stream);
    Args a{};
    for (int i = 0; i < 20; ++i) a.in[i] = (const float*)d_in[i];
    a.out = (float*)d_out; a.ws = (unsigned char*)d_ws;
    hipLaunchKernelGGL(mk_fwd, dim3(grid), dim3(512), LDS_BYTES, stream, a);
    const hipError_t le = hipPeekAtLastError();
    if (le != hipSuccess) fprintf(stderr, "kernel_launch: launch failed: %s\n", hipGetErrorName(le));
}
```
